# Optimizing an MI355X kernel written in HIP

```python
import math
import jax, jax.numpy as jnp
from jax import lax
import numpy as np

D_MODEL = 2048
BATCH = 1
SEQ = 8192
DEPTH = 4

GRID_W = 64
CTX_LEN = 256
HEAD_DIM = 128
N_HEADS_TOTAL = D_MODEL // HEAD_DIM
A_HEADS = N_HEADS_TOTAL // 2
A_KV_HEADS = A_HEADS // 4
B_HEADS = N_HEADS_TOTAL // 4
C_HEADS = N_HEADS_TOTAL // 4
C_HALF = HEAD_DIM // 2
NA_KH_MAX = 8
NA_KW = 16
D_FF = int(math.ceil(8 * D_MODEL / 3 / 128)) * 128
CONV_W = 3
Q_BLOCK = 128
ROPE_THETA = 10000.0
EPS = 1e-6
N_BRANCH = 3

A_Q = A_HEADS * HEAD_DIM
A_KV = A_KV_HEADS * HEAD_DIM
B_W = B_HEADS * HEAD_DIM
C_QK = C_HEADS * 2 * C_HALF
C_V = C_HEADS * HEAD_DIM
PART_SIZES = (A_Q, A_KV, A_KV, B_W, B_W, B_W, C_QK, C_QK, C_V)
SPLITS = tuple(int(v) for v in np.cumsum(PART_SIZES))
D_IN = SPLITS[-1] + N_BRANCH * D_MODEL

kernel_name = "hybrid_gqa_natten_diffattn_convffn_dit"


def rms_norm(x, g):
    xf = x.astype(jnp.float32)
    y = xf * lax.rsqrt(jnp.mean(xf * xf, axis=-1, keepdims=True) + EPS)
    return (y * g.astype(jnp.float32)).astype(x.dtype)


def modulate(x, shift, scale):
    return x * (1 + scale) + shift


def axial_rope_tables(n_tokens, dim):
    n_freq = dim // 4
    inv_freq = ROPE_THETA ** (-jnp.arange(n_freq, dtype=jnp.float32) / n_freq)
    t = jnp.arange(n_tokens, dtype=jnp.int32)
    pos = jnp.stack([t // GRID_W, t % GRID_W], axis=-1).astype(jnp.float32)
    ang = (pos[:, :, None] * inv_freq).reshape(n_tokens, 2 * n_freq)
    return jnp.cos(ang), jnp.sin(ang)


def apply_axial_rope(x, cos, sin):
    S, dim = x.shape[1], x.shape[-1]
    nf = dim // 4
    xr = x.astype(jnp.float32).reshape(x.shape[:-1] + (2, 2, nf))
    bshape = (S,) + (1,) * (x.ndim - 3) + (2, 1, nf)
    c = cos.reshape(bshape)
    s = sin.reshape(bshape)
    x1, x2 = xr[..., 0:1, :], xr[..., 1:2, :]
    out = jnp.concatenate([x1 * c - x2 * s, x2 * c + x1 * s], axis=-2)
    return out.reshape(x.shape).astype(x.dtype)


def project_heads(u, w_in, gq_a, gk_a, gq_b, gk_b, gq_c, gk_c, rope_a, rope_c):
    B, T, _ = u.shape
    parts = jnp.split(u @ w_in, SPLITS, axis=-1)
    qa = rms_norm(parts[0].reshape(B, T, A_HEADS, HEAD_DIM), gq_a)
    ka = rms_norm(parts[1].reshape(B, T, A_KV_HEADS, HEAD_DIM), gk_a)
    va = parts[2].reshape(B, T, A_KV_HEADS, HEAD_DIM)
    qb = rms_norm(parts[3].reshape(B, T, B_HEADS, HEAD_DIM), gq_b)
    kb = rms_norm(parts[4].reshape(B, T, B_HEADS, HEAD_DIM), gk_b)
    vb = parts[5].reshape(B, T, B_HEADS, HEAD_DIM)
    qc = rms_norm(parts[6].reshape(B, T, C_HEADS, 2, C_HALF), gq_c)
    kc = rms_norm(parts[7].reshape(B, T, C_HEADS, 2, C_HALF), gk_c)
    vc = parts[8].reshape(B, T, C_HEADS, HEAD_DIM)
    gates = jax.nn.sigmoid(parts[9].astype(jnp.float32)).astype(u.dtype).reshape(B, T, N_BRANCH, D_MODEL)
    if rope_a is not None:
        qa = apply_axial_rope(qa, *rope_a)
        ka = apply_axial_rope(ka, *rope_a)
        qc = apply_axial_rope(qc, *rope_c)
        kc = apply_axial_rope(kc, *rope_c)
    return qa, ka, va, qb, kb, vb, qc, kc, vc, gates


def sweep_query_blocks(attend, q):
    B, S = q.shape[:2]
    nb = S // Q_BLOCK
    qb = jnp.moveaxis(q.reshape((B, nb, Q_BLOCK) + q.shape[2:]), 1, 0)
    o = lax.map(attend, qb)
    return jnp.moveaxis(o, 0, 1).reshape((B, S) + o.shape[3:])


def gqa_attend(q, k, v):
    B, Q, H, dh = q.shape
    hkv = k.shape[2]
    qg = q.reshape(B, Q, hkv, H // hkv, dh)
    s = jnp.einsum('bqkgd,btkd->bkgqt', qg, k).astype(jnp.float32) * (dh ** -0.5)
    p = jax.nn.softmax(s, axis=-1).astype(v.dtype)
    o = jnp.einsum('bkgqt,btkd->bqkgd', p, v)
    return o.reshape(B, Q, H * dh)


def diff_attend(q, k, v, lam):
    dc = q.shape[-1]
    s = jnp.einsum('bqhcd,bthcd->bhcqt', q, k).astype(jnp.float32) * (dc ** -0.5)
    p = jax.nn.softmax(s, axis=-1)
    a = (p[:, :, 0] - lam * p[:, :, 1]).astype(v.dtype)
    return jnp.einsum('bhqt,bthd->bqhd', a, v)


def neighbourhood_attention(q, k, v, k_ctx, v_ctx, rpb):
    B, S, H, dh = q.shape
    rows = S // GRID_W
    kh = min(NA_KH_MAX, rows)
    kw = NA_KW
    scale = dh ** -0.5
    col = jnp.arange(GRID_W)
    col_start = jnp.clip(col - kw // 2, 0, GRID_W - kw)
    col_idx = col_start[:, None] + jnp.arange(kw)[None, :]
    dc = col_idx - col[:, None] + (NA_KW - 1)
    qg = jnp.moveaxis(q.reshape(B, rows, GRID_W, H, dh), 1, 0)
    kg = k.reshape(B, rows, GRID_W, H, dh)
    vg = v.reshape(B, rows, GRID_W, H, dh)

    def one_row(args):
        r, q_row = args
        rs = jnp.clip(r - kh // 2, 0, rows - kh)
        k_rows = lax.dynamic_slice_in_dim(kg, rs, kh, axis=1)
        v_rows = lax.dynamic_slice_in_dim(vg, rs, kh, axis=1)
        k_win = k_rows[:, :, col_idx]
        v_win = v_rows[:, :, col_idx]
        dr = rs + jnp.arange(kh) - r + (NA_KH_MAX - 1)
        bias = rpb[:, dr[:, None, None], dc[None, :, :]]
        bias = jnp.transpose(bias, (0, 2, 1, 3)).astype(jnp.float32)
        s_win = jnp.einsum('bqhd,bjqwhd->bhqjw', q_row, k_win).astype(jnp.float32) * scale + bias[None]
        s_win = s_win.reshape(B, H, GRID_W, kh * kw)
        s_ctx = jnp.einsum('bqhd,blhd->bhql', q_row, k_ctx).astype(jnp.float32) * scale
        p = jax.nn.softmax(jnp.concatenate([s_win, s_ctx], axis=-1), axis=-1).astype(v.dtype)
        p_win = p[..., :kh * kw].reshape(B, H, GRID_W, kh, kw)
        p_ctx = p[..., kh * kw:]
        return (jnp.einsum('bhqjw,bjqwhd->bqhd', p_win, v_win)
                + jnp.einsum('bhql,blhd->bqhd', p_ctx, v_ctx))

    o = lax.map(one_row, (jnp.arange(rows), qg))
    return jnp.moveaxis(o, 0, 1).reshape(B, S, H * dh)


def merge_branches(oa, ob, oc, gates, w_br_a, w_br_b, w_br_c, w_o):
    merged = (gates[:, :, 0] * (oa @ w_br_a)
              + gates[:, :, 1] * (ob @ w_br_b)
              + gates[:, :, 2] * (oc @ w_br_c))
    return merged @ w_o


def conv_ffn(u, w_up, conv_w, conv_b, w_down):
    T = u.shape[1]
    h = u @ w_up
    pad = CONV_W // 2
    hp = jnp.pad(h, ((0, 0), (pad, pad), (0, 0)))
    h = conv_b + sum(hp[:, j:j + T] * conv_w[j] for j in range(CONV_W))
    a, g = jnp.split(h, 2, axis=-1)
    return (jax.nn.silu(g) * a) @ w_down


def setup_inputs(seed: int = 0) -> dict:
    key = jax.random.key(seed)
    ks = jax.random.split(key, 32)

    def nrm(k, shape, scale):
        return jax.random.normal(k, shape, jnp.float32) * scale

    D = D_MODEL
    return {
        "x": nrm(ks[0], (BATCH, SEQ, D), 1.0),
        "c": nrm(ks[1], (BATCH, D), 1.0),
        "ctx": nrm(ks[2], (BATCH, CTX_LEN, D), 1.0),
        "c_ctx": nrm(ks[3], (D,), 1.0),
        "w_mod": nrm(ks[4], (DEPTH, D, 6 * D), 0.5 * D ** -0.5),
        "b_mod": nrm(ks[5], (DEPTH, 6 * D), 0.02),
        "g_norm1": 1.0 + nrm(ks[6], (DEPTH, D), 0.05),
        "w_in": nrm(ks[7], (DEPTH, D, D_IN), D ** -0.5),
        "gq_a": 1.0 + nrm(ks[8], (DEPTH, HEAD_DIM), 0.05),
        "gk_a": 1.0 + nrm(ks[9], (DEPTH, HEAD_DIM), 0.05),
        "gq_b": 1.0 + nrm(ks[10], (DEPTH, HEAD_DIM), 0.05),
        "gk_b": 1.0 + nrm(ks[11], (DEPTH, HEAD_DIM), 0.05),
        "rpb_b": nrm(ks[12], (DEPTH, B_HEADS, 2 * NA_KH_MAX - 1, 2 * NA_KW - 1), 0.5),
        "gq_c": 1.0 + nrm(ks[13], (DEPTH, C_HALF), 0.05),
        "gk_c": 1.0 + nrm(ks[14], (DEPTH, C_HALF), 0.05),
        "lam_q1": nrm(ks[15], (DEPTH, C_HALF), 0.1),
        "lam_k1": nrm(ks[16], (DEPTH, C_HALF), 0.1),
        "lam_q2": nrm(ks[17], (DEPTH, C_HALF), 0.1),
        "lam_k2": nrm(ks[18], (DEPTH, C_HALF), 0.1),
        "g_subln_c": 1.0 + nrm(ks[19], (DEPTH, HEAD_DIM), 0.05),
        "w_br_a": nrm(ks[20], (DEPTH, A_Q, D), A_Q ** -0.5),
        "w_br_b": nrm(ks[21], (DEPTH, B_W, D), B_W ** -0.5),
        "w_br_c": nrm(ks[22], (DEPTH, C_V, D), C_V ** -0.5),
        "w_o": nrm(ks[23], (DEPTH, D, D), D ** -0.5),
        "g_norm2": 1.0 + nrm(ks[24], (DEPTH, D), 0.05),
        "w_up": nrm(ks[25], (DEPTH, D, 2 * D_FF), D ** -0.5),
        "conv_w": nrm(ks[26], (DEPTH, CONV_W, 2 * D_FF), CONV_W ** -0.5),
        "conv_b": nrm(ks[27], (DEPTH, 2 * D_FF), 0.02),
        "w_down": nrm(ks[28], (DEPTH, D_FF, D), D_FF ** -0.5),
    }


def reference(x, c, ctx, c_ctx, w_mod, b_mod, g_norm1, w_in, gq_a, gk_a, gq_b, gk_b, rpb_b,
              gq_c, gk_c, lam_q1, lam_k1, lam_q2, lam_k2, g_subln_c, w_br_a, w_br_b, w_br_c,
              w_o, g_norm2, w_up, conv_w, conv_b, w_down):
    B, S, D = x.shape
    rope_a = axial_rope_tables(S, HEAD_DIM)
    rope_c = axial_rope_tables(S, C_HALF)
    hx, hc = x, ctx
    for l in range(DEPTH):
        last = l == DEPTH - 1
        mod_x = (jax.nn.silu(c) @ w_mod[l] + b_mod[l]).reshape(B, 1, 6, D)
        mod_c = (jax.nn.silu(c_ctx) @ w_mod[l] + b_mod[l]).reshape(6, D)
        lam_init = 0.8 - 0.6 * math.exp(-0.3 * l)
        lam = (jnp.exp(jnp.sum(lam_q1[l].astype(jnp.float32) * lam_k1[l].astype(jnp.float32)))
               - jnp.exp(jnp.sum(lam_q2[l].astype(jnp.float32) * lam_k2[l].astype(jnp.float32)))
               + lam_init)

        ux = modulate(rms_norm(hx, g_norm1[l]), mod_x[:, :, 0], mod_x[:, :, 1])
        uc = modulate(rms_norm(hc, g_norm1[l]), mod_c[0], mod_c[1])
        qa, ka, va, qb, kb, vb, qc, kc, vc, gx = project_heads(
            ux, w_in[l], gq_a[l], gk_a[l], gq_b[l], gk_b[l], gq_c[l], gk_c[l], rope_a, rope_c)
        qa_t, ka_t, va_t, qb_t, kb_t, vb_t, qc_t, kc_t, vc_t, gt = project_heads(
            uc, w_in[l], gq_a[l], gk_a[l], gq_b[l], gk_b[l], gq_c[l], gk_c[l], None, None)

        k_all_a = jnp.concatenate([ka, ka_t], axis=1)
        v_all_a = jnp.concatenate([va, va_t], axis=1)
        oa = sweep_query_blocks(lambda qblk: gqa_attend(qblk, k_all_a, v_all_a), qa)
        ob = neighbourhood_attention(qb, kb, vb, kb_t, vb_t, rpb_b[l])
        k_all_c = jnp.concatenate([kc, kc_t], axis=1)
        v_all_c = jnp.concatenate([vc, vc_t], axis=1)
        oc = sweep_query_blocks(lambda qblk: diff_attend(qblk, k_all_c, v_all_c, lam), qc)
        oc = (rms_norm(oc, g_subln_c[l]) * (1 - lam_init)).reshape(B, S, C_V)
        hx = hx + mod_x[:, :, 2] * merge_branches(oa, ob, oc, gx, w_br_a[l], w_br_b[l], w_br_c[l], w_o[l])

        if not last:
            T = hc.shape[1]
            oa_t = gqa_attend(qa_t, ka_t, va_t)
            ob_t = gqa_attend(qb_t, kb_t, vb_t)
            oc_t = diff_attend(qc_t, kc_t, vc_t, lam)
            oc_t = (rms_norm(oc_t, g_subln_c[l]) * (1 - lam_init)).reshape(B, T, C_V)
            hc = hc + mod_c[2] * merge_branches(oa_t, ob_t, oc_t, gt, w_br_a[l], w_br_b[l], w_br_c[l], w_o[l])

        vx = modulate(rms_norm(hx, g_norm2[l]), mod_x[:, :, 3], mod_x[:, :, 4])
        hx = hx + mod_x[:, :, 5] * conv_ffn(vx, w_up[l], conv_w[l], conv_b[l], w_down[l])
        if not last:
            vt = modulate(rms_norm(hc, g_norm2[l]), mod_c[3], mod_c[4])
            hc = hc + mod_c[5] * conv_ffn(vt, w_up[l], conv_w[l], conv_b[l], w_down[l])
    return hx
```

```cpp
#include <hip/hip_runtime.h>
#include <cstdio>
#include <cstdint>
#include <cstddef>

#define LAS __attribute__((address_space(3)))
typedef unsigned short bf16_t;
typedef short bf16x8 __attribute__((ext_vector_type(8)));
typedef short s16x4 __attribute__((ext_vector_type(4)));
typedef float f32x4 __attribute__((ext_vector_type(4)));
typedef float f32x16 __attribute__((ext_vector_type(16)));
typedef unsigned u32x4 __attribute__((ext_vector_type(4)));
typedef unsigned u32x2 __attribute__((ext_vector_type(2)));

#ifndef MK_FAST_GEMM
#define MK_FAST_GEMM 1
#endif
#ifndef MK_PROBE
#define MK_PROBE 0
#endif
#ifndef MK_ATT_VARIANT
#define MK_ATT_VARIANT 0
#endif
#ifndef MK_GATE_FP8
#define MK_GATE_FP8 1
#endif
#ifndef MK_SPLIT_S
#define MK_SPLIT_S 18
#endif
#ifndef MK_ONE_LAUNCH
#define MK_ONE_LAUNCH 1
#endif

constexpr int DM = 2048, SEQ = 8192, CTX = 256, MT = SEQ + CTX, DEPTH = 4;
constexpr int DIN = 10752, DFF = 5504, DUP = 2 * DFF, NMOD = 6 * DM;
constexpr int RW = 3328;
constexpr int C_QA = 0, C_KA = 1024, C_VA = 1280, C_QB = 1536, C_KB = 2048, C_VB = 2560, C_QC = 3072, C_KC = 3584, C_VC = 4096, C_G = 4608;
constexpr float EPS = 1e-6f;

constexpr size_t O_WIN = 0, O_BRA = O_WIN + (size_t)DIN * DM, O_BRB = O_BRA + (size_t)DM * 1024, O_BRC = O_BRB + (size_t)DM * 512,
                 O_WO = O_BRC + (size_t)DM * 512, O_WUP = O_WO + (size_t)DM * DM, O_WDN = O_WUP + (size_t)DUP * DM, LAYER_ELEMS = O_WDN + (size_t)DM * DFF;

constexpr size_t al256(size_t x) { return (x + 255) / 256 * 256; }
constexpr size_t WS_CTL = 0, CTL_BYTES = 65536;
constexpr size_t WS_MOD = WS_CTL + CTL_BYTES;
constexpr size_t WS_LAM = al256(WS_MOD + (size_t)DEPTH * 2 * NMOD * 4);
constexpr size_t WS_H = al256(WS_LAM + 256);
constexpr size_t WS_U = al256(WS_H + (size_t)MT * DM * 4);
constexpr size_t WS_WT = al256(WS_U + (size_t)MT * DM * 2);
constexpr size_t WS_P = al256(WS_WT + (size_t)DEPTH * LAYER_ELEMS * 2);
constexpr size_t WS_R = al256(WS_P + (size_t)MT * DIN * 2);
constexpr size_t WS_U8 = WS_R;
constexpr size_t WS_WG8 = al256(WS_U8 + (size_t)MT * DM);
constexpr int NGATE = 3 * DM;
static_assert(WS_WG8 + (size_t)DEPTH * NGATE * DM <= WS_R + (size_t)MT * RW * 4, "fp8 buffers fit the R region");
constexpr size_t WS_OA = al256(WS_R + (size_t)MT * RW * 4);
constexpr size_t WS_OB = al256(WS_OA + (size_t)MT * 1024 * 2);
constexpr size_t WS_OC = al256(WS_OB + (size_t)MT * 512 * 2);
constexpr size_t WS_OCS = al256(WS_OC + (size_t)MT * 512 * 2);
constexpr size_t WS_MF = al256(WS_OCS + (size_t)MT * 512 * 4);
constexpr size_t WS_MB = al256(WS_MF + (size_t)MT * DM * 4);
constexpr size_t WS_PEND = al256(WS_MB + (size_t)MT * DM * 2);
constexpr size_t WS_Y = WS_P;
static_assert(WS_Y + (size_t)MT * DUP * 4 <= WS_PEND, "Y alias");
constexpr int NBLK64 = MT / 64;
constexpr size_t WS_EDGE = WS_P;
constexpr size_t WS_ACT = WS_PEND;
constexpr size_t WS_END = al256(WS_ACT + (size_t)MT * DFF * 2);

constexpr int LDS_BYTES = 147456;

__device__ __forceinline__ unsigned cvt_pk_bf16(float lo, float hi) { unsigned r; asm volatile("v_cvt_pk_bf16_f32 %0, %1, %2" : "=v"(r) : "v"(lo), "v"(hi)); return r; }
__device__ __forceinline__ bf16_t f2bf(float x) { return (bf16_t)(cvt_pk_bf16(x, 0.f) & 0xffffu); }
__device__ __forceinline__ unsigned pk4_fp8(float a, float b, float c, float d) { unsigned w = __builtin_amdgcn_cvt_pk_fp8_f32(a, b, 0u, false); return __builtin_amdgcn_cvt_pk_fp8_f32(c, d, w, true); }
__device__ __forceinline__ float bf2f(bf16_t b) { return __uint_as_float(((unsigned)b) << 16); }
template <int O> __device__ __forceinline__ float swz_xor(float v) { return __int_as_float(__builtin_amdgcn_ds_swizzle(__float_as_int(v), (O << 10) | 0x1f)); }
__device__ __forceinline__ float half_sum(float v) { v += swz_xor<16>(v); v += swz_xor<8>(v); v += swz_xor<4>(v); v += swz_xor<2>(v); v += swz_xor<1>(v); return v; }
__device__ __forceinline__ float wave_sum(float v) {
    v = half_sum(v);
    auto rr = __builtin_amdgcn_permlane32_swap(__float_as_uint(v), __float_as_uint(v), false, false);
    return __uint_as_float(rr[0]) + __uint_as_float(rr[1]);
}
__device__ __forceinline__ float wave_max(float v) {
    v = fmaxf(v, swz_xor<16>(v)); v = fmaxf(v, swz_xor<8>(v)); v = fmaxf(v, swz_xor<4>(v)); v = fmaxf(v, swz_xor<2>(v)); v = fmaxf(v, swz_xor<1>(v));
    auto rr = __builtin_amdgcn_permlane32_swap(__float_as_uint(v), __float_as_uint(v), false, false);
    return fmaxf(__uint_as_float(rr[0]), __uint_as_float(rr[1]));
}
__device__ __forceinline__ float vmax_abs(const float* v, int n, int lane) {
    float m = 0.f; for (int i = lane; i < n; i += 64) m = fmaxf(m, fabsf(v[i]));
    return __uint_as_float(__builtin_amdgcn_readfirstlane(__float_as_uint(wave_max(m))));
}
__device__ __forceinline__ float siluf(float x) { return x / (1.0f + __expf(-x)); }
__device__ __forceinline__ float sigmoidf(float x) { return 1.0f / (1.0f + __expf(-x)); }

__device__ __forceinline__ int tid_of(int wid_k) { int z; asm volatile("s_mov_b32 %0, 0" : "=s"(z)); return wid_k * 64 + (int)__builtin_amdgcn_mbcnt_hi(~0u, __builtin_amdgcn_mbcnt_lo(~0u, (unsigned)z)); }

#define XB_TMO      128
#define XB_XCNT(j)  (256  + 64 * (j))
#define XB_XSUB(j)  (1280 + 64 * (j))
#define XB_XGEN(j)  (2304 + 64 * (j))
#define XB_TOP      3328
#define XB_TOPGEN   3392
#define XCD_BAR_WORDS 3456
#define XB_SPIN_CAP (1u << 18)
__device__ __forceinline__ unsigned xb_ld(unsigned* p)              { return __hip_atomic_load(p, __ATOMIC_RELAXED, __HIP_MEMORY_SCOPE_AGENT); }
__device__ __forceinline__ unsigned xb_add(unsigned* p, unsigned v) { return __hip_atomic_fetch_add(p, v, __ATOMIC_RELAXED, __HIP_MEMORY_SCOPE_AGENT); }
__device__ __forceinline__ unsigned xb_xcc_id() { return (unsigned)__builtin_amdgcn_s_getreg((3 << 11) | 20) & 0xFu; }
#define XB_SPIN(cond, bar) do { unsigned _sp = 0; while (cond) { __builtin_amdgcn_s_sleep(1); \
    if ((++_sp & 255u) == 0u) { if (xb_ld(&(bar)[XB_TMO])) break; if (_sp > XB_SPIN_CAP) { atomicAdd(&(bar)[XB_TMO], 1u); break; } } } } while (0)
struct XcdBarrier { unsigned* bar; unsigned x; volatile LAS unsigned* st; };
__device__ __forceinline__ XcdBarrier xcd_barrier_post(unsigned* bar, volatile LAS unsigned* st, int tid) {
    XcdBarrier b; b.bar = bar; b.x = xb_xcc_id(); b.st = st;
    if (tid == 0) (void)xb_add(&bar[XB_XCNT(b.x)], 1u);
    return b;
}
__device__ __forceinline__ void xcd_barrier_complete(unsigned* bar, unsigned x, unsigned& nloc, unsigned& nx) {
    const unsigned G = gridDim.x * gridDim.y * gridDim.z;
    unsigned sum, cnt, mine, sp = 0u;
    for (;;) {
        sum = 0u; cnt = 0u; mine = 0u;
#pragma unroll
        for (unsigned j = 0; j < 16; ++j) { const unsigned c = xb_ld(&bar[XB_XCNT(j)]); sum += c; cnt += (c > 0u) ? 1u : 0u; }
        mine = xb_ld(&bar[XB_XCNT(x)]);
        if (sum == G) break;
        __builtin_amdgcn_s_sleep(1);
        if ((++sp & 255u) == 0u) { if (xb_ld(&bar[XB_TMO])) break; if (sp > XB_SPIN_CAP) { atomicAdd(&bar[XB_TMO], 1u); break; } }
    }
    nloc = mine > 0u ? mine : 1u; nx = cnt > 0u ? cnt : 1u;
}
__device__ __forceinline__ void xcd_barrier(const XcdBarrier& b, int tid) {
    asm volatile("s_waitcnt vmcnt(0)" ::: "memory");
    __syncthreads();
    if (tid == 0) {
        unsigned* bar = b.bar;
        __builtin_amdgcn_s_waitcnt(0);
        unsigned nloc = b.st[0], nx = b.st[1];
        if (nloc == 0u) { xcd_barrier_complete(bar, b.x, nloc, nx); b.st[0] = nloc; b.st[1] = nx; }
        const unsigned old = xb_add(&bar[XB_XSUB(b.x)], 1u);
        const unsigned gen = old / nloc;
        if (old + 1u == (gen + 1u) * nloc) {
            __builtin_amdgcn_fence(__ATOMIC_RELEASE, "agent");
            asm volatile("s_waitcnt vmcnt(0)" ::: "memory");
            const unsigned og = xb_add(&bar[XB_TOP], 1u);
            const unsigned tg = og / nx;
            if (og + 1u == (tg + 1u) * nx) xb_add(&bar[XB_TOPGEN], 1u);
            else XB_SPIN(xb_ld(&bar[XB_TOPGEN]) == tg, bar);
            __builtin_amdgcn_fence(__ATOMIC_ACQUIRE, "agent");
            xb_add(&bar[XB_XGEN(b.x)], 1u);
            asm volatile("s_waitcnt vmcnt(0)" ::: "memory");
        } else {
            XB_SPIN(xb_ld(&bar[XB_XGEN(b.x)]) == gen, bar);
            __builtin_amdgcn_fence(__ATOMIC_ACQUIRE, "agent");
            asm volatile("s_waitcnt vmcnt(0)" ::: "memory");
        }
    }
    __syncthreads();
}

template <class T> __device__ __forceinline__ T* launder_uniform(T* p) {
    const unsigned long long v = (unsigned long long)p; unsigned lo = (unsigned)v, hi = (unsigned)(v >> 32);
    asm volatile("" : "+v"(lo), "+v"(hi));
    lo = __builtin_amdgcn_readfirstlane(lo); hi = __builtin_amdgcn_readfirstlane(hi);
    return (T*)(((unsigned long long)hi << 32) | lo);
}
struct Args { const float* in[29]; float* out; unsigned char* ws; int ph_lo, ph_hi; };
enum { I_X = 0, I_C, I_CTX, I_CCTX, I_WMOD, I_BMOD, I_GN1, I_WIN, I_GQA, I_GKA, I_GQB, I_GKB, I_RPB, I_GQC, I_GKC, I_LQ1, I_LK1, I_LQ2, I_LK2, I_GSUB,
       I_WBRA, I_WBRB, I_WBRC, I_WO, I_GN2, I_WUP, I_CONVW, I_CONVB, I_WDN };
struct Ctx {
    const float* const* in; float* out; unsigned char* ws;
    __device__ __forceinline__ float* mod() const { return (float*)(ws + WS_MOD); }
    __device__ __forceinline__ float* lam() const { return (float*)(ws + WS_LAM); }
    __device__ __forceinline__ float* h() const { return (float*)(ws + WS_H); }
    __device__ __forceinline__ bf16_t* u() const { return (bf16_t*)(ws + WS_U); }
    __device__ __forceinline__ bf16_t* wt() const { return (bf16_t*)(ws + WS_WT); }
    __device__ __forceinline__ bf16_t* P() const { return (bf16_t*)(ws + WS_P); }
    __device__ __forceinline__ float* R() const { return (float*)(ws + WS_R); }
    __device__ __forceinline__ bf16_t* oa() const { return (bf16_t*)(ws + WS_OA); }
    __device__ __forceinline__ bf16_t* ob() const { return (bf16_t*)(ws + WS_OA) + 1024; }
    __device__ __forceinline__ bf16_t* oc() const { return (bf16_t*)(ws + WS_OA) + 1536; }
    __device__ __forceinline__ float* ocs() const { return (float*)(ws + WS_OCS); }
    __device__ __forceinline__ float* mf() const { return (float*)(ws + WS_MF); }
    __device__ __forceinline__ bf16_t* mb() const { return (bf16_t*)(ws + WS_MB); }
    __device__ __forceinline__ float* Y() const { return (float*)(ws + WS_Y); }
    __device__ __forceinline__ float* edge() const { return (float*)(ws + WS_EDGE); }
    __device__ __forceinline__ bf16_t* act() const { return (bf16_t*)(ws + WS_ACT); }
};
__device__ __forceinline__ unsigned long long kernarg_u64(int off) {
    unsigned long long v; auto kp = __builtin_amdgcn_kernarg_segment_ptr();
    asm volatile("s_load_dwordx2 %0, %1, %2\n\ts_waitcnt lgkmcnt(0)" : "=s"(v) : "s"(kp), "i"(off));
    return v;
}
__device__ __forceinline__ Ctx make_ctx() {
    Ctx c; c.in = (const float* const*)__builtin_amdgcn_kernarg_segment_ptr();
    c.out = (float*)kernarg_u64(29 * 8); c.ws = (unsigned char*)kernarg_u64(30 * 8);
    return c;
}
#define PHASE_ENTER(cin) Ctx c = make_ctx(); int tid_ = tid_of(wid_k);

__device__ __forceinline__ int win_src_col(int j) {
    if (j < C_VA) { const int s = j & 127, hb = j - s, grp = s >> 6, sp = s & 63, i = sp >> 3, jj = sp & 7; return hb + 64 * grp + (jj < 4 ? 4 * i + jj : 32 + 4 * i + (jj - 4)); }
    if (j >= C_QC && j < C_VC) { const int s = j & 63, hb = j - s, grp = s >> 5, sp = s & 31, i = sp >> 3, jj = sp & 7; return hb + 32 * grp + (jj < 4 ? 4 * i + jj : 16 + 4 * i + (jj - 4)); }
    return j;
}
__device__ __forceinline__ int wup_src_col(int j) { const int pn = j >> 8, bj = (j >> 7) & 1, s = j & 127; return bj * DFF + 128 * pn + s; }

__device__ __forceinline__ void phase_prologue(int wid_k, char* lds) {
    PHASE_ENTER(cin)
    const int tid = tid_, lane = tid & 63, wid = tid >> 6, G = gridDim.x, b = blockIdx.x;
    if (!MK_FAST_GEMM) {
        const f32x4* x4 = (const f32x4*)c.in[I_X]; const f32x4* c4 = (const f32x4*)c.in[I_CTX]; f32x4* h4 = (f32x4*)c.h();
        const size_t nx = (size_t)SEQ * DM / 4, nc = (size_t)CTX * DM / 4;
        for (size_t i = (size_t)b * 512 + tid; i < nx + nc; i += (size_t)G * 512) h4[i] = i < nx ? x4[i] : c4[i - nx];
    }
    if (b == 0 && wid < DEPTH) {
        const int l = wid;
        const float p1 = wave_sum(c.in[I_LQ1][l * 64 + lane] * c.in[I_LK1][l * 64 + lane]);
        const float p2 = wave_sum(c.in[I_LQ2][l * 64 + lane] * c.in[I_LK2][l * 64 + lane]);
        if (lane == 0) c.lam()[l] = expf(p1) - expf(p2) + (0.8f - 0.6f * expf(-0.3f * (float)l));
    }
    {
        float* sc0 = (float*)lds; float* sc1 = sc0 + DM; float* part = sc1 + DM;
        for (int k = tid; k < DM; k += 512) { sc0[k] = siluf(c.in[I_C][k]); sc1[k] = siluf(c.in[I_CCTX][k]); }
        __syncthreads();
        for (int blk = b; blk < DEPTH * NMOD / 64; blk += G) {
            const int l = blk / (NMOD / 64), j = (blk % (NMOD / 64)) * 64 + lane;
            const float* w = c.in[I_WMOD] + (size_t)l * DM * NMOD + j;
            float a0 = 0.f, a1 = 0.f;
            const int kb = wid * 256;
#pragma unroll 32
            for (int k = 0; k < 256; ++k) { const float wv = w[(size_t)(kb + k) * NMOD]; a0 += sc0[kb + k] * wv; a1 += sc1[kb + k] * wv; }
            part[(wid * 64 + lane) * 2 + 0] = a0; part[(wid * 64 + lane) * 2 + 1] = a1;
            __syncthreads();
            if (wid < 2) {
                float s = c.in[I_BMOD][l * NMOD + j];
#pragma unroll
                for (int w8 = 0; w8 < 8; ++w8) s += part[(w8 * 64 + lane) * 2 + wid];
                c.mod()[((size_t)l * 2 + wid) * NMOD + j] = s;
            }
            __syncthreads();
        }
    }
    {
        float* tile = (float*)lds;
        constexpr int T_WIN = (DIN / 256) * (DM / 64), T_BRA = (DM / 256) * (1024 / 64), T_BRB = (DM / 256) * (512 / 64), T_WO = (DM / 256) * (DM / 64), T_WUP = (DUP / 256) * (DM / 64), T_WDN = (DM / 256) * (DFF / 64);
        constexpr int T_LAYER = T_WIN + T_BRA + 2 * T_BRB + T_WO + T_WUP + T_WDN;
        for (int t = b; t < DEPTH * T_LAYER; t += G) {
            const int l = t / T_LAYER; int r = t % T_LAYER;
            const float* src; bf16_t* dst; int K, N, kind = 0, ldd = 0;
            bf16_t* wl = c.wt() + (size_t)l * LAYER_ELEMS;
            if (r < T_WIN) { src = c.in[I_WIN] + (size_t)l * DM * DIN; dst = wl + O_WIN; K = DM; N = DIN; kind = 1; }
            else if ((r -= T_WIN) < T_BRA) { src = c.in[I_WBRA] + (size_t)l * 1024 * DM; dst = wl + O_BRA; K = 1024; N = DM; ldd = DM; }
            else if ((r -= T_BRA) < T_BRB) { src = c.in[I_WBRB] + (size_t)l * 512 * DM; dst = wl + O_BRA + 1024; K = 512; N = DM; ldd = DM; }
            else if ((r -= T_BRB) < T_BRB) { src = c.in[I_WBRC] + (size_t)l * 512 * DM; dst = wl + O_BRA + 1536; K = 512; N = DM; ldd = DM; }
            else if ((r -= T_BRB) < T_WO) { src = c.in[I_WO] + (size_t)l * DM * DM; dst = wl + O_WO; K = DM; N = DM; }
            else if ((r -= T_WO) < T_WUP) { src = c.in[I_WUP] + (size_t)l * DM * DUP; dst = wl + O_WUP; K = DM; N = DUP; kind = 2; }
            else { r -= T_WUP; src = c.in[I_WDN] + (size_t)l * DFF * DM; dst = wl + O_WDN; K = DFF; N = DM; }
            const int nkt = K / 64, j0 = (r / nkt) * 256, k0 = (r % nkt) * 64;
            {
                const int j4 = (tid & 15) * 4; f32x4 v[4][2];
#pragma unroll
                for (int s = 0; s < 4; ++s) { const int j = j0 + 64 * s + j4; const int sc = kind == 1 ? win_src_col(j) : (kind == 2 ? wup_src_col(j) : j);
#pragma unroll
                    for (int i = 0; i < 2; ++i) v[s][i] = *(const f32x4*)(src + (size_t)(k0 + (tid >> 4) + 32 * i) * N + sc); }
#pragma unroll
                for (int s = 0; s < 4; ++s)
#pragma unroll
                    for (int i = 0; i < 2; ++i) { float* tp = tile + s * (64 * 65) + ((tid >> 4) + 32 * i) * 65 + j4; tp[0] = v[s][i][0]; tp[1] = v[s][i][1]; tp[2] = v[s][i][2]; tp[3] = v[s][i][3]; }
            }
            __syncthreads();
            {
                const int jj = tid >> 3, kk = (tid & 7) * 8;
#pragma unroll
                for (int s = 0; s < 4; ++s) { const float* ts = tile + s * (64 * 65);
                    if (MK_GATE_FP8 && MK_FAST_GEMM && kind == 1 && j0 + 64 * s >= C_G) {
                        u32x2 w8;
                        w8.x = pk4_fp8(ts[(kk + 0) * 65 + jj] * 32.f, ts[(kk + 1) * 65 + jj] * 32.f, ts[(kk + 2) * 65 + jj] * 32.f, ts[(kk + 3) * 65 + jj] * 32.f);
                        w8.y = pk4_fp8(ts[(kk + 4) * 65 + jj] * 32.f, ts[(kk + 5) * 65 + jj] * 32.f, ts[(kk + 6) * 65 + jj] * 32.f, ts[(kk + 7) * 65 + jj] * 32.f);
                        *(u32x2*)(c.ws + WS_WG8 + ((size_t)l * NGATE + (j0 + 64 * s + jj - C_G)) * DM + k0 + kk) = w8;
                        continue; }
                    u32x4 w;
                    w.x = cvt_pk_bf16(ts[(kk + 0) * 65 + jj], ts[(kk + 1) * 65 + jj]); w.y = cvt_pk_bf16(ts[(kk + 2) * 65 + jj], ts[(kk + 3) * 65 + jj]);
                    w.z = cvt_pk_bf16(ts[(kk + 4) * 65 + jj], ts[(kk + 5) * 65 + jj]); w.w = cvt_pk_bf16(ts[(kk + 6) * 65 + jj], ts[(kk + 7) * 65 + jj]);
                    *(u32x4*)(dst + (size_t)(j0 + 64 * s + jj) * (ldd ? ldd : K) + k0 + kk) = w; }
            }
            __syncthreads();
        }
    }
}

__device__ __forceinline__ void phase_norm(int wid_k, int l, int which) {
    PHASE_ENTER(cin)
    const int lane = tid_ & 63, wid = tid_ >> 6;
    const float* g = c.in[which ? I_GN2 : I_GN1] + l * DM;
    for (int row = blockIdx.x * 8 + wid; row < MT; row += gridDim.x * 8) {
        const float* hr = (MK_FAST_GEMM && l == 0 && which == 0) ? (row < SEQ ? c.in[I_X] + (size_t)row * DM : c.in[I_CTX] + (size_t)(row - SEQ) * DM) : c.h() + (size_t)row * DM;
        const float* md = c.mod() + ((size_t)l * 2 + (row >= SEQ ? 1 : 0)) * NMOD;
        const float* sh = md + (which ? 3 : 0) * DM; const float* sc = md + (which ? 4 : 1) * DM;
        f32x4 v[8]; float ss = 0.f;
#pragma unroll
        for (int i = 0; i < 8; ++i) { v[i] = *(const f32x4*)(hr + i * 256 + lane * 4); ss += v[i][0] * v[i][0] + v[i][1] * v[i][1] + v[i][2] * v[i][2] + v[i][3] * v[i][3]; }
        ss = wave_sum(ss);
        const float rstd = 1.0f / sqrtf(ss * (1.0f / DM) + EPS);
#pragma unroll
        for (int i = 0; i < 8; ++i) {
            const int col = i * 256 + lane * 4;
            const f32x4 gg = *(const f32x4*)(g + col), s1 = *(const f32x4*)(sc + col), s0 = *(const f32x4*)(sh + col);
            f32x4 o;
#pragma unroll
            for (int e = 0; e < 4; ++e) o[e] = (v[i][e] * rstd * gg[e]) * (1.0f + s1[e]) + s0[e];
            u32x2 w; w.x = cvt_pk_bf16(o[0], o[1]); w.y = cvt_pk_bf16(o[2], o[3]);
            *(u32x2*)(c.u() + (size_t)row * DM + col) = w;
            if (MK_GATE_FP8 && MK_FAST_GEMM && which == 0) *(unsigned*)(c.ws + WS_U8 + (size_t)row * DM + col) = pk4_fp8(o[0], o[1], o[2], o[3]);
        }
    }
}

__device__ __forceinline__ void rope_cs(float pos, int f, float inv_nf, float& cs, float& sn) {
    const float inv = __builtin_amdgcn_exp2f(-(float)f * inv_nf * 13.287712379549449f);
    const float ang = pos * inv;
    float rev = ang * 0.15915494309189535f; rev -= floorf(rev);
    cs = __builtin_amdgcn_cosf(rev); sn = __builtin_amdgcn_sinf(rev);
}
__device__ __forceinline__ void phase_qknorm(int wid_k, int l) {
    PHASE_ENTER(cin)
    const int lane = tid_ & 63, wid = tid_ >> 6;
    const int i = lane >> 2, j = lane & 3;
    const long nitems = (long)MT * 26;
    for (long it = (long)blockIdx.x * 8 + wid; it < nitems; it += (long)gridDim.x * 8) {
        const int row = (int)(it / 26), g = (int)(it % 26);
        const int rc = g * 128, pc = rc < 1280 ? rc : (rc < 2304 ? rc + 256 : rc + 768);
        const float* rp = c.R() + (size_t)row * RW + rc;
        const float x1 = rp[8 * i + j], x2 = rp[8 * i + 4 + j];
        float ss = x1 * x1 + x2 * x2;
        int type; const float* gv;
        if (g < 8) { type = 0; gv = c.in[I_GQA] + l * 128; } else if (g < 10) { type = 0; gv = c.in[I_GKA] + l * 128; }
        else if (g < 14) { type = 1; gv = c.in[I_GQB] + l * 128; } else if (g < 18) { type = 1; gv = c.in[I_GKB] + l * 128; }
        else if (g < 22) { type = 2; gv = c.in[I_GQC] + l * 64; } else { type = 2; gv = c.in[I_GKC] + l * 64; }
        ss = half_sum(ss);
        if (type != 2) { auto rr = __builtin_amdgcn_permlane32_swap(__float_as_uint(ss), __float_as_uint(ss), false, false); ss = __uint_as_float(rr[0]) + __uint_as_float(rr[1]); }
        const float rstd = 1.0f / sqrtf(ss * (type == 2 ? 1.0f / 64.0f : 1.0f / 128.0f) + EPS);
        float y1, y2;
        if (type == 1) { y1 = x1 * rstd * gv[8 * i + j]; y2 = x2 * rstd * gv[8 * i + 4 + j]; }
        else {
            int d1, d2, f; float inv_nf; int grp;
            if (type == 0) { grp = i >> 3; f = 4 * (i & 7) + j; d1 = 64 * grp + f; d2 = d1 + 32; inv_nf = 1.0f / 32.0f; }
            else { const int ip = i & 7; grp = ip >> 2; f = 4 * (ip & 3) + j; d1 = 32 * grp + f; d2 = d1 + 16; inv_nf = 1.0f / 16.0f; }
            y1 = x1 * rstd * gv[d1]; y2 = x2 * rstd * gv[d2];
            if (row < SEQ) {
                const float pos = (float)(grp ? (row & 63) : (row >> 6));
                float cs, sn; rope_cs(pos, f, inv_nf, cs, sn);
                const float o1 = y1 * cs - y2 * sn, o2 = y2 * cs + y1 * sn; y1 = o1; y2 = o2;
            }
        }
        const float qs = (g < 8 || (g >= 10 && g < 14)) ? 0.12751743f : ((g >= 18 && g < 22) ? 0.18033688f : 1.0f);
        bf16_t* pp = c.P() + (size_t)row * DIN + pc;
        pp[8 * i + j] = f2bf(y1 * qs); pp[8 * i + 4 + j] = f2bf(y2 * qs);
    }
}

__device__ __forceinline__ void phase_conv(int wid_k, int l) {
    PHASE_ENTER(cin)
    const float* cw = c.in[I_CONVW] + (size_t)l * 3 * DUP; const float* cb = c.in[I_CONVB] + (size_t)l * DUP;
    const long n = (long)MT * DFF;
    for (long idx = (long)blockIdx.x * 512 + tid_; idx < n; idx += (long)gridDim.x * 512) {
        const int row = (int)(idx / DFF), col = (int)(idx % DFF);
        const int ya = 256 * (col >> 7) + (col & 127), yg = ya + 128;
        const bool up = (row != 0 && row != SEQ), dn = (row != SEQ - 1 && row != MT - 1);
        const float* y = c.Y() + (size_t)row * DUP;
        float ha = cb[col] + cw[DUP + col] * y[ya], hg = cb[DFF + col] + cw[DUP + DFF + col] * y[yg];
        if (up) { ha += cw[col] * y[ya - DUP]; hg += cw[DFF + col] * y[yg - DUP]; }
        if (dn) { ha += cw[2 * DUP + col] * y[ya + DUP]; hg += cw[2 * DUP + DFF + col] * y[yg + DUP]; }
        c.act()[idx] = f2bf(siluf(hg) * ha);
    }
}


__device__ __forceinline__ void phase_convfix(int wid_k, int l) {
    PHASE_ENTER(cin)
    const float* cw = c.in[I_CONVW] + (size_t)l * 3 * DUP; const float* cb = c.in[I_CONVB] + (size_t)l * DUP; const float* E = c.edge();
    const int nrows = (l == DEPTH - 1 ? SEQ / 64 : NBLK64) * 2;
    const long n = (long)nrows * (DFF / 4);
    for (long idx = (long)blockIdx.x * 512 + tid_; idx < n; idx += (long)gridDim.x * 512) {
        const int br = (int)(idx / (DFF / 4)), ch = (int)(idx % (DFF / 4)) * 4, b = br >> 1, lastrow = br & 1, row = 64 * b + (lastrow ? 63 : 0);
        const int ya = 256 * (ch >> 7) + (ch & 127), yg = ya + 128;
        const float* eb = E + (size_t)b * 4 * DUP;
        f32x4 ua = {0.f, 0.f, 0.f, 0.f}, ug = ua, da = ua, dg = ua, ma, mg;
        if (!lastrow) {
            if (row != 0 && row != SEQ) { ua = *(const f32x4*)(eb - DUP + ya); ug = *(const f32x4*)(eb - DUP + yg); }
            ma = *(const f32x4*)(eb + ya); mg = *(const f32x4*)(eb + yg); da = *(const f32x4*)(eb + DUP + ya); dg = *(const f32x4*)(eb + DUP + yg);
        } else {
            ua = *(const f32x4*)(eb + 2 * DUP + ya); ug = *(const f32x4*)(eb + 2 * DUP + yg); ma = *(const f32x4*)(eb + 3 * DUP + ya); mg = *(const f32x4*)(eb + 3 * DUP + yg);
            if (row != SEQ - 1 && row != MT - 1) { da = *(const f32x4*)(eb + 4 * DUP + ya); dg = *(const f32x4*)(eb + 4 * DUP + yg); }
        }
        const f32x4 wa0 = *(const f32x4*)(cw + ch), wa1 = *(const f32x4*)(cw + DUP + ch), wa2 = *(const f32x4*)(cw + 2 * DUP + ch), ba = *(const f32x4*)(cb + ch);
        const f32x4 wg0 = *(const f32x4*)(cw + DFF + ch), wg1 = *(const f32x4*)(cw + DUP + DFF + ch), wg2 = *(const f32x4*)(cw + 2 * DUP + DFF + ch), bg = *(const f32x4*)(cb + DFF + ch);
        f32x4 o;
#pragma unroll
        for (int e = 0; e < 4; ++e) { const float ha = ba[e] + wa0[e] * ua[e] + wa1[e] * ma[e] + wa2[e] * da[e], hg = bg[e] + wg0[e] * ug[e] + wg1[e] * mg[e] + wg2[e] * dg[e]; o[e] = siluf(hg) * ha; }
        u32x2 w; w.x = cvt_pk_bf16(o[0], o[1]); w.y = cvt_pk_bf16(o[2], o[3]);
        *(u32x2*)(c.act() + (size_t)row * DFF + ch) = w;
    }
}

__device__ __forceinline__ void phase_copy_out(int wid_k) {
    PHASE_ENTER(cin)
    const f32x4* h4 = (const f32x4*)c.h(); f32x4* o4 = (f32x4*)c.out; const size_t n = (size_t)SEQ * DM / 4;
    for (size_t i = (size_t)blockIdx.x * 512 + tid_; i < n; i += (size_t)gridDim.x * 512) o4[i] = h4[i];
}

template <class Epi>
__device__ __forceinline__ void simple_gemm(int wid_k, const bf16_t* A, const bf16_t* Bt, int M, int N, int K, const Epi& epi) {
    int tid_ = tid_of(wid_k); A = launder_uniform(A); Bt = launder_uniform(Bt);
    const int lane = tid_ & 63, wid = tid_ >> 6, wm = wid >> 2, wn = wid & 3, fr = lane & 15, fq = lane >> 4;
    const int ntn = N / 128, ntiles = (M / 128) * ntn;
    for (int t = blockIdx.x; t < ntiles; t += gridDim.x) {
        const int tm = t / ntn, tn = t % ntn, row0 = tm * 128 + wm * 64, col0 = tn * 128 + wn * 32;
        f32x4 acc[4][2];
#pragma unroll
        for (int m = 0; m < 4; ++m)
#pragma unroll
            for (int n = 0; n < 2; ++n) acc[m][n] = (f32x4){0.f, 0.f, 0.f, 0.f};
        const bf16_t* ap = A + (size_t)(row0 + fr) * K + fq * 8; const bf16_t* bp = Bt + (size_t)(col0 + fr) * K + fq * 8;
        for (int k0 = 0; k0 < K; k0 += 32) {
            bf16x8 a[4], b[2];
#pragma unroll
            for (int m = 0; m < 4; ++m) a[m] = *(const bf16x8*)(ap + (size_t)m * 16 * K + k0);
#pragma unroll
            for (int n = 0; n < 2; ++n) b[n] = *(const bf16x8*)(bp + (size_t)n * 16 * K + k0);
#pragma unroll
            for (int m = 0; m < 4; ++m)
#pragma unroll
                for (int n = 0; n < 2; ++n) acc[m][n] = __builtin_amdgcn_mfma_f32_16x16x32_bf16(a[m], b[n], acc[m][n], 0, 0, 0);
        }
#pragma unroll
        for (int m = 0; m < 4; ++m)
#pragma unroll
            for (int n = 0; n < 2; ++n)
#pragma unroll
                for (int j = 0; j < 4; ++j) epi(row0 + m * 16 + fq * 4 + j, col0 + n * 16 + fr, acc[m][n][j]);
    }
}

template <class Epi>
__device__ __forceinline__ void slab_gemm(int wid_k, const bf16_t* A, int lda, const bf16_t* Bt, int ldb, int row_base, int M, int N, int K, const Epi& epi) {
    int tid_ = tid_of(wid_k); A = launder_uniform(A); Bt = launder_uniform(Bt);
    const int lane = tid_ & 63, wid = tid_ >> 6, fr = lane & 15, fq = lane >> 4;
    const int ntn = N / 16, ntiles = (M / 128) * ntn;
    for (int t = blockIdx.x; t < ntiles; t += gridDim.x) {
        const int tm = t / ntn, tn = t % ntn, row0 = row_base + tm * 128 + wid * 16, col0 = tn * 16;
        f32x4 acc0 = {0.f, 0.f, 0.f, 0.f}, acc1 = acc0;
        const bf16_t* ap = A + (size_t)(row0 + fr) * lda + fq * 8; const bf16_t* bp = Bt + (size_t)(col0 + fr) * ldb + fq * 8;
#pragma unroll 8
        for (int k0 = 0; k0 < K; k0 += 64) {
            const bf16x8 a0 = *(const bf16x8*)(ap + k0), b0 = *(const bf16x8*)(bp + k0), a1 = *(const bf16x8*)(ap + k0 + 32), b1 = *(const bf16x8*)(bp + k0 + 32);
            acc0 = __builtin_amdgcn_mfma_f32_16x16x32_bf16(a0, b0, acc0, 0, 0, 0);
            acc1 = __builtin_amdgcn_mfma_f32_16x16x32_bf16(a1, b1, acc1, 0, 0, 0);
        }
#pragma unroll
        for (int j = 0; j < 4; ++j) epi(row0 + fq * 4 + j, col0 + fr, acc0[j] + acc1[j]);
    }
}

template <class Epi4>
__device__ __forceinline__ void slab_gemm4(int wid_k, char* lds, const bf16_t* A, int lda, const bf16_t* Bt, int ldb, int row_base, int M, int N, int K, const Epi4& epi) {
    int tid_ = tid_of(wid_k); A = launder_uniform(A); Bt = launder_uniform(Bt);
    const int lane = tid_ & 63, wid = __builtin_amdgcn_readfirstlane(tid_ >> 6), r32 = lane & 31, hi = lane >> 5, ch = wid & 1, kq = wid >> 1, kl = K >> 2;
    float* part = (float*)lds;
    const int ntn = N / 64, ntiles = (M / 32) * ntn;
    typedef const __attribute__((address_space(1))) bf16x8 gfrag;
    for (int t = blockIdx.x; t < ntiles; t += gridDim.x) {
        const int tm = t / ntn, tn = t % ntn, row0 = row_base + tm * 32, col0 = tn * 64 + ch * 32;
        const bf16_t* ap = A + (size_t)(row0 + r32) * lda + kq * kl + hi * 8; const bf16_t* bp = Bt + (size_t)(col0 + r32) * ldb + kq * kl + hi * 8;
        f32x16 acc = {};
#pragma unroll 8
        for (int k0 = 0; k0 < kl; k0 += 16) { const bf16x8 a = *(gfrag*)(ap + k0), b = *(gfrag*)(bp + k0); acc = __builtin_amdgcn_mfma_f32_32x32x16_bf16(a, b, acc, 0, 0, 0); }
        float* pw = part + ((kq * 2 + ch) * 32) * 32 + r32;
#pragma unroll
        for (int i = 0; i < 16; ++i) pw[((i & 3) + 8 * (i >> 2) + 4 * hi) * 32] = acc[i];
        __syncthreads();
#pragma unroll
        for (int j = 0; j < 4; ++j) { const int o = (tid_ & 255) + 256 * j, c2 = tid_ >> 8, rr = o >> 5, cc = o & 31;
            const float* pp = part + (c2 * 32 + rr) * 32 + cc;
            epi(row_base + tm * 32 + rr, tn * 64 + c2 * 32 + cc, pp[0], pp[2 * 1024], pp[4 * 1024], pp[6 * 1024]); }
        __syncthreads();
    }
}
struct SEpiRes4 {
    float* h; const float* gx; const float* gc; const float* src;
    __device__ __forceinline__ void operator()(int row, int col, float p0, float p1, float p2, float p3) const { const size_t o = (size_t)row * DM + col; h[o] = src[o] + (row < SEQ ? gx[col] : gc[col]) * ((p0 + p1) + (p2 + p3)); }
};
struct SEpiBr4 {
    bf16_t* mb; const bf16_t* P;
    __device__ __forceinline__ void operator()(int row, int col, float p0, float p1, float p2, float p3) const { const bf16_t* g = P + (size_t)row * DIN + C_G + col;
        mb[(size_t)row * DM + col] = f2bf(bf2f(g[0]) * (p0 + p1) + bf2f(g[DM]) * p2 + bf2f(g[2 * DM]) * p3); }
};
struct SEpiWin {
    float* R; bf16_t* P;
    __device__ __forceinline__ void operator()(int row, int col, float v) const {
        const bool isv = (col >= C_VA && col < C_QB) || (col >= C_VB && col < C_QC) || (col >= C_VC);
        if (!isv) { const int rc = col < C_VA ? col : (col < C_VB ? col - 256 : col - 768); R[(size_t)row * RW + rc] = v; }
        else P[(size_t)row * DIN + col] = f2bf(col >= C_G ? sigmoidf(v) : v);
    }
};
template <int STEP> struct SEpiBr {
    float* mf; bf16_t* mb; const bf16_t* P;
    __device__ __forceinline__ void operator()(int row, int col, float v) const {
        const float g = bf2f(P[(size_t)row * DIN + C_G + STEP * DM + col]);
        const size_t o = (size_t)row * DM + col;
        if (STEP == 0) mf[o] = g * v; else if (STEP == 1) mf[o] += g * v; else mb[o] = f2bf(mf[o] + g * v);
    }
};
struct SEpiRes {
    float* h; const float* gx; const float* gc; const float* src;
    __device__ __forceinline__ void operator()(int row, int col, float v) const { const size_t o = (size_t)row * DM + col; h[o] = src[o] + (row < SEQ ? gx[col] : gc[col]) * v; }
};
struct SEpiY { float* Y; __device__ __forceinline__ void operator()(int row, int col, float v) const { Y[(size_t)row * DUP + col] = v; } };

namespace pg8 {
#define PG8_LAS __attribute__((address_space(3)))
constexpr int BM = 256, BK = 64, HALF = 128, HTB = HALF * BK * 2  , STAGE_BYTES = 8 * HTB, NXCD = 8, WGM = 8;
__host__ __device__ __forceinline__ int lds_byte(int r, int c) { const int st = (r >> 4) * 2 + (c >> 5), rr = r & 15, cc = c & 31, ob = rr * 64 + cc * 2; return st * 1024 + (ob ^ (((ob >> 9) & 1) << 5)); }
__host__ __device__ __forceinline__ void stage_rc(int b, int& R, int& C) { const int st = b / 1024, sb = b % 1024, swz = sb ^ (((sb >> 9) & 1) << 5); R = (st >> 1) * 16 + swz / 64; C = (st & 1) * 32 + (swz % 64) / 2; }
__host__ __device__ __forceinline__ int perm32(int rho) { const int n = rho >> 4, i = rho & 15; return 8 * (i >> 2) + 4 * n + (i & 3); }
struct Unit { int pm, pn; };
struct Gemm { const bf16_t* A; const bf16_t* Bt; int M, N, K; int lda = 0, ldb = 0; };
struct OneUnit { Unit u; __device__ __forceinline__ bool next(int i, Unit& o) const { o = u; return i == 0; } __device__ __forceinline__ void a_ready(const Unit&) const {} __device__ __forceinline__ void done(const Unit&) const {} };
struct StaticOrder {
    int nM, nN, nwg, G, c;
    __host__ __device__ void init(int M, int N, int G_, int c_) { nM = M / BM; nN = N / BM; nwg = nM * nN; G = G_; c = c_; }
    __host__ __device__ bool next(int i, Unit& u) const {
        const long L = (long)i * G + c; if (L >= nwg) return false;
        int wgid = (int)L; { const int q = nwg / NXCD, r = nwg % NXCD, xcd = wgid % NXCD, off = wgid / NXCD; wgid = (xcd < r ? xcd * (q + 1) : r * (q + 1) + (xcd - r) * q) + off; }
        const int nig = WGM * nN, gid = wgid / nig, fm = gid * WGM, gsz = (nM - fm) < WGM ? (nM - fm) : WGM;
        u.pm = fm + ((wgid % nig) % gsz); u.pn = (wgid % nig) / gsz; return true;
    }
    __device__ __forceinline__ void a_ready(const Unit&) const {}
    __device__ __forceinline__ void done(const Unit&) const {}
};
template <class Epi, class Sched, bool KEEP_IN, bool KEEP_OUT, bool F8 = false>
__device__ __forceinline__ void gemm_phase_core(PG8_LAS unsigned char* lds, const Gemm g, const Sched& S, const Epi& E, int tid, f32x4 (&acc)[2][2][4][2]) {
    asm volatile("" : "+v"(tid));
    const int wid = __builtin_amdgcn_readfirstlane(tid >> 6), lane = tid & 63, wr = wid >> 2, wc = wid & 3, fr = lane & 15, fq = lane >> 4;
    const int K = g.K, nt = K / BK, lda = g.lda ? g.lda : K, ldb = g.ldb ? g.ldb : K;
    unsigned voffA[2], voffB[2];
#pragma unroll
    for (int i = 0; i < 2; ++i) { int R, C; stage_rc(tid * 16 + i * 8192, R, C); const int Rb = Epi::PERM ? ((R & ~31) + perm32(R & 31)) : R;
        voffA[i] = (unsigned)(R * lda + C) * 2u; voffB[i] = (unsigned)(Rb * ldb + C) * 2u; }
    const size_t kstep = (size_t)(BK * 2);
    const size_t hstepA = (size_t)HALF * lda * 2, hstepB = (size_t)HALF * ldb * 2;
    const size_t tstepA = 2 * hstepA, tstepB = 2 * hstepB;
    const unsigned ldsw = (unsigned)wid * 1024u;
    const int aoff = lds_byte(wr * 64 + fr, fq * 8), boff = lds_byte(wc * 32 + fr, fq * 8);
#define PG8_SA(b, h) (((b) * 2 + (h)) * HTB)
#define PG8_SB(b, h) ((4 + (b) * 2 + (h)) * HTB)
#define PG8_STAGE(bufoff, gbase, voff) do { _Pragma("unroll") for (int _i = 0; _i < 2; ++_i) \
        __builtin_amdgcn_global_load_lds((const unsigned*)((const char*)(gbase) + (voff)[_i]), (PG8_LAS unsigned*)(lds + (bufoff) + ldsw + _i * 8192), 16, 0, 0); } while (0)
#define PG8_LDA(dst, b, h) do { _Pragma("unroll") for (int m = 0; m < 4; ++m) _Pragma("unroll") for (int k = 0; k < 2; ++k) dst[m][k] = *(const PG8_LAS bf16x8*)(lds + PG8_SA(b, h) + aoff + m * 2048 + k * 1024); } while (0)
#define PG8_LDB(dst, b, h) do { _Pragma("unroll") for (int n = 0; n < 2; ++n) _Pragma("unroll") for (int k = 0; k < 2; ++k) dst[n][k] = *(const PG8_LAS bf16x8*)(lds + PG8_SB(b, h) + boff + n * 2048 + k * 1024); } while (0)
#define PG8_MMA(ai, bj, At, Bt) do { __builtin_amdgcn_s_setprio(1); _Pragma("unroll") for (int m = 0; m < 4; ++m) _Pragma("unroll") for (int n = 0; n < 2; ++n) { \
        if constexpr (F8) { typedef int v4i_ __attribute__((ext_vector_type(4))); typedef int v8i_ __attribute__((ext_vector_type(8))); \
            const v8i_ b8_ = __builtin_shufflevector(__builtin_bit_cast(v4i_, Bt[n][0]), __builtin_bit_cast(v4i_, Bt[n][1]), 0, 1, 2, 3, 4, 5, 6, 7); \
            const v8i_ a8_ = __builtin_shufflevector(__builtin_bit_cast(v4i_, At[m][0]), __builtin_bit_cast(v4i_, At[m][1]), 0, 1, 2, 3, 4, 5, 6, 7); \
            asm volatile("v_mfma_scale_f32_16x16x128_f8f6f4 %0, %1, %2, %0, %3, %3 op_sel_hi:[0,0,0]" : "+v"(acc[ai][bj][m][n]) : "v"(b8_), "v"(a8_), "v"(sc8_)); } \
        else { _Pragma("unroll") for (int k = 0; k < 2; ++k) acc[ai][bj][m][n] = __builtin_amdgcn_mfma_f32_16x16x32_bf16(Bt[n][k], At[m][k], acc[ai][bj][m][n], 0, 0, 0); } } \
        __builtin_amdgcn_s_setprio(0); } while (0)
#define PG8_WAIT_V(n) asm volatile("s_waitcnt vmcnt(" #n ")" ::: "memory")
#define PG8_WAIT_L(n) asm volatile("s_waitcnt lgkmcnt(" #n ")" ::: "memory")
#define PG8_BAR __builtin_amdgcn_s_barrier()
#define PG8_SCHED __builtin_amdgcn_sched_barrier(0)
    int sc8_ = 127; if constexpr (F8) asm volatile("" : "+v"(sc8_));
    Unit cur, nxt; int ui = 0;
    if (!S.next(0, cur)) return;
    if constexpr (!KEEP_IN) {
#pragma unroll
    for (int a = 0; a < 2; ++a)
#pragma unroll
        for (int b = 0; b < 2; ++b)
#pragma unroll
            for (int m = 0; m < 4; ++m)
#pragma unroll
                for (int n = 0; n < 2; ++n) acc[a][b][m][n] = (f32x4){0.f, 0.f, 0.f, 0.f};
    }
    bf16x8 At[4][2], B0[2][2], B1[2][2];
    const char* cA = (const char*)g.A + (size_t)cur.pm * tstepA; const char* cB = (const char*)g.Bt + (size_t)cur.pn * tstepB;
    S.a_ready(cur);
    PG8_STAGE(PG8_SB(0, 0), cB, voffB); PG8_STAGE(PG8_SA(0, 0), cA, voffA); PG8_STAGE(PG8_SB(0, 1), cB + hstepB, voffB); PG8_STAGE(PG8_SA(0, 1), cA + hstepA, voffA);
    if (wr == 1) PG8_BAR;
    PG8_WAIT_V(4); PG8_BAR;
    PG8_STAGE(PG8_SB(1, 0), cB + kstep, voffB); PG8_STAGE(PG8_SA(1, 0), cA + kstep, voffA); PG8_STAGE(PG8_SB(1, 1), cB + hstepB + kstep, voffB);
    PG8_WAIT_V(6); PG8_BAR;
    for (;;) {
        const bool has_next = S.next(ui + 1, nxt);
        const char* nA = has_next ? (const char*)g.A + (size_t)nxt.pm * tstepA : cA; const char* nB = has_next ? (const char*)g.Bt + (size_t)nxt.pn * tstepB : cB;
        for (int t = 0; t < nt; t += 2) {
            const bool last = (t == nt - 2);
            const char* a1 = cA + (size_t)(t + 1) * kstep;
            const char* a2 = last ? nA : cA + (size_t)(t + 2) * kstep; const char* b2 = last ? nB : cB + (size_t)(t + 2) * kstep;
            const char* a3 = a2 + kstep; const char* b3 = b2 + kstep;
            if (last && has_next) S.a_ready(nxt);
            PG8_LDB(B0, 0, 0); PG8_SCHED; PG8_LDA(At, 0, 0); PG8_STAGE(PG8_SA(1, 1), a1 + hstepA, voffA);
            PG8_WAIT_L(8); PG8_BAR; PG8_WAIT_L(0); PG8_MMA(0, 0, At, B0); PG8_BAR; PG8_SCHED;
            PG8_LDB(B1, 0, 1); PG8_STAGE(PG8_SB(0, 0), b2, voffB);
            PG8_BAR; PG8_WAIT_L(0); PG8_MMA(0, 1, At, B1); PG8_BAR;
            PG8_LDA(At, 0, 1); PG8_STAGE(PG8_SA(0, 0), a2, voffA);
            PG8_BAR; PG8_WAIT_L(0); PG8_MMA(1, 0, At, B0); PG8_BAR; PG8_SCHED;
            PG8_STAGE(PG8_SB(0, 1), b2 + hstepB, voffB);
            PG8_WAIT_V(6); PG8_BAR; PG8_MMA(1, 1, At, B1); PG8_BAR;
            PG8_LDB(B0, 1, 0); PG8_SCHED; PG8_LDA(At, 1, 0); PG8_STAGE(PG8_SA(0, 1), a2 + hstepA, voffA);
            PG8_WAIT_L(8); PG8_BAR; PG8_WAIT_L(0); PG8_MMA(0, 0, At, B0); PG8_BAR; PG8_SCHED;
            PG8_LDB(B1, 1, 1); PG8_STAGE(PG8_SB(1, 0), b3, voffB);
            PG8_BAR; PG8_WAIT_L(0); PG8_MMA(0, 1, At, B1); PG8_BAR;
            PG8_LDA(At, 1, 1); PG8_STAGE(PG8_SA(1, 0), a3, voffA);
            PG8_BAR; PG8_WAIT_L(0); PG8_MMA(1, 0, At, B0); PG8_BAR; PG8_SCHED;
            PG8_STAGE(PG8_SB(1, 1), b3 + hstepB, voffB);
            PG8_WAIT_V(6); PG8_BAR; PG8_MMA(1, 1, At, B1); PG8_BAR;
        }
        if constexpr (F8) asm volatile("s_nop 15\n\ts_nop 15" ::: "memory");
        if constexpr (!Epi::AFTER_DRAIN && !KEEP_OUT) { E(acc, cur, wr, wc, fr, fq); S.done(cur); }
        if (!has_next) break;
#pragma unroll
        for (int a = 0; a < 2; ++a)
#pragma unroll
            for (int b = 0; b < 2; ++b)
#pragma unroll
                for (int m = 0; m < 4; ++m)
#pragma unroll
                    for (int n = 0; n < 2; ++n) acc[a][b][m][n] = (f32x4){0.f, 0.f, 0.f, 0.f};
        cur = nxt; cA = nA; cB = nB; ++ui;
    }
    PG8_WAIT_V(0);
    if (wr == 0) PG8_BAR;
    PG8_BAR;
    if constexpr (Epi::AFTER_DRAIN && !KEEP_OUT) { E.fused(acc, cur, wr, wc, fr, fq, lds, wid, lane); S.done(cur); }
#undef PG8_SA
#undef PG8_SB
#undef PG8_STAGE
#undef PG8_LDA
#undef PG8_LDB
#undef PG8_MMA
#undef PG8_WAIT_V
#undef PG8_WAIT_L
#undef PG8_BAR
#undef PG8_SCHED
}
template <class Epi, class Sched, bool F8 = false>
__device__ __forceinline__ void gemm_phase(PG8_LAS unsigned char* lds, const Gemm g, const Sched& S, const Epi& E, int tid) {
    f32x4 acc[2][2][4][2];
    gemm_phase_core<Epi, Sched, false, false, F8>(lds, g, S, E, tid, acc);
}
}

namespace pg8 {
typedef const f32x4 (&AccRef)[2][2][4][2];
__device__ __forceinline__ u32x4 pack8(const f32x4 a, const f32x4 b) { u32x4 w; w.x = cvt_pk_bf16(a[0], a[1]); w.y = cvt_pk_bf16(a[2], a[3]); w.z = cvt_pk_bf16(b[0], b[1]); w.w = cvt_pk_bf16(b[2], b[3]); return w; }
__device__ __forceinline__ void unpack8(const u32x4 w, f32x4& a, f32x4& b) {
    a[0] = __uint_as_float(w.x << 16); a[1] = __uint_as_float(w.x & 0xffff0000u); a[2] = __uint_as_float(w.y << 16); a[3] = __uint_as_float(w.y & 0xffff0000u);
    b[0] = __uint_as_float(w.z << 16); b[1] = __uint_as_float(w.z & 0xffff0000u); b[2] = __uint_as_float(w.w << 16); b[3] = __uint_as_float(w.w & 0xffff0000u); }
struct EpiWin {
    static constexpr bool PERM = true, AFTER_DRAIN = false;
    bf16_t* P; const float* gqa; const float* gka; const float* gqb; const float* gkb; const float* gqc; const float* gkc; LAS float* part; float zs = 1.0f;
    __device__ __forceinline__ void operator()(AccRef acc, const Unit& u, int wr, int wc, int fr_, int fq_) const {
        int fr = fr_, fq = fq_; asm volatile("" : "+v"(fr), "+v"(fq));
        const int row0 = u.pm * BM + wr * 64 + fr, pn = u.pn, colt = pn * BM, cw = wc * 32 + 8 * fq;
        const bool isv = (pn == 5) || (pn == 10) || (pn == 11) || (pn >= 16);
        if (isv) {
            const bool gate = pn >= 18;
#pragma unroll
            for (int ai = 0; ai < 2; ++ai)
#pragma unroll
                for (int m = 0; m < 4; ++m) { bf16_t* pp = P + (size_t)(row0 + ai * HALF + m * 16) * DIN + colt + cw;
#pragma unroll
                    for (int bj = 0; bj < 2; ++bj) { f32x4 v0 = acc[ai][bj][m][0], v1 = acc[ai][bj][m][1];
                        if (gate) {
#pragma unroll
                            for (int e = 0; e < 4; ++e) { v0[e] = sigmoidf(v0[e] * zs); v1[e] = sigmoidf(v1[e] * zs); } }
                        *(u32x4*)(pp + bj * HALF) = pack8(v0, v1); } }
            return;
        }
        int type; float qs; f32x4 g1, g2; const int grpA = wc >> 1, fA = 16 * (wc & 1) + 4 * fq, grpC = wc & 1, fC = 4 * fq;
        if (pn < 4) { type = 0; qs = 0.12751743f; g1 = *(const f32x4*)(gqa + 64 * grpA + fA); g2 = *(const f32x4*)(gqa + 64 * grpA + 32 + fA); }
        else if (pn == 4) { type = 0; qs = 1.f; g1 = *(const f32x4*)(gka + 64 * grpA + fA); g2 = *(const f32x4*)(gka + 64 * grpA + 32 + fA); }
        else if (pn < 8) { type = 1; qs = 0.12751743f; g1 = *(const f32x4*)(gqb + cw); g2 = *(const f32x4*)(gqb + cw + 4); }
        else if (pn < 10) { type = 1; qs = 1.f; g1 = *(const f32x4*)(gkb + cw); g2 = *(const f32x4*)(gkb + cw + 4); }
        else if (pn < 14) { type = 2; qs = 0.18033688f; g1 = *(const f32x4*)(gqc + 32 * grpC + fC); g2 = *(const f32x4*)(gqc + 32 * grpC + 16 + fC); }
        else { type = 2; qs = 1.f; g1 = *(const f32x4*)(gkc + 32 * grpC + fC); g2 = *(const f32x4*)(gkc + 32 * grpC + 16 + fC); }
        const int prow = wr * 64 + fr;
#pragma unroll
        for (int ai = 0; ai < 2; ++ai)
#pragma unroll
            for (int m = 0; m < 4; ++m)
#pragma unroll
                for (int bj = 0; bj < 2; ++bj) { const f32x4 a = acc[ai][bj][m][0], b = acc[ai][bj][m][1];
                    float s = (a[0] * a[0] + a[1] * a[1]) + (a[2] * a[2] + a[3] * a[3]) + (b[0] * b[0] + b[1] * b[1]) + (b[2] * b[2] + b[3] * b[3]);
                    s += swz_xor<16>(s);
                    { auto rr = __builtin_amdgcn_permlane32_swap(__float_as_uint(s), __float_as_uint(s), false, false); s = __uint_as_float(rr[0]) + __uint_as_float(rr[1]); }
                    if (fq == 0) part[((ai * HALF + m * 16 + prow) * 2 + bj) * 4 + wc] = s; }
        asm volatile("s_waitcnt lgkmcnt(0)" ::: "memory"); __builtin_amdgcn_s_barrier(); asm volatile("" ::: "memory");
        f32x4 inv = {0.f, 0.f, 0.f, 0.f}; const int grp = type == 0 ? grpA : grpC;
        if (type != 1) { const int f0 = type == 0 ? fA : fC; const float kf = type == 0 ? (13.287712379549449f / 32.0f) : (13.287712379549449f / 16.0f);
#pragma unroll
            for (int e = 0; e < 4; ++e) inv[e] = __builtin_amdgcn_exp2f(-(float)(f0 + e) * kf); }
        const bool rope = (type != 1) && (u.pm * BM < SEQ);
        const float invn = type == 2 ? (1.0f / 64.0f) : (1.0f / 128.0f);
#pragma unroll
        for (int ai = 0; ai < 2; ++ai)
#pragma unroll
            for (int m = 0; m < 4; ++m) {
                f32x4 cs = {1.f, 1.f, 1.f, 1.f}, sn = {0.f, 0.f, 0.f, 0.f};
                if (rope) { const float pos = grp ? (float)(m * 16 + fr) : (float)(4 * u.pm + 2 * ai + wr);
#pragma unroll
                    for (int e = 0; e < 4; ++e) { float rev = pos * inv[e] * 0.15915494309189535f; rev -= floorf(rev); cs[e] = __builtin_amdgcn_cosf(rev); sn[e] = __builtin_amdgcn_sinf(rev); } }
                bf16_t* pp = P + (size_t)(row0 + ai * HALF + m * 16) * DIN + colt + cw;
#pragma unroll
                for (int bj = 0; bj < 2; ++bj) {
                    const f32x4 pq = *(const LAS f32x4*)(part + ((ai * HALF + m * 16 + prow) * 2 + bj) * 4);
                    const float tot = type == 2 ? ((wc & 2) ? pq[2] + pq[3] : pq[0] + pq[1]) : (pq[0] + pq[1]) + (pq[2] + pq[3]);
                    const float rstd = qs / sqrtf(tot * invn + EPS);
                    f32x4 v0, v1;
#pragma unroll
                    for (int e = 0; e < 4; ++e) { const float y1 = acc[ai][bj][m][0][e] * rstd * g1[e], y2 = acc[ai][bj][m][1][e] * rstd * g2[e];
                        v0[e] = y1 * cs[e] - y2 * sn[e]; v1[e] = y2 * cs[e] + y1 * sn[e]; }
                    *(u32x4*)(pp + bj * HALF) = pack8(v0, v1); }
                asm volatile("" ::: "memory"); }
    }
};
struct EpiGate {
    static constexpr bool PERM = true, AFTER_DRAIN = false;
    bf16_t* P;
    __device__ __forceinline__ void operator()(AccRef acc, const Unit& u, int wr, int wc, int fr, int fq) const {
        const int row0 = u.pm * BM + wr * 64 + fr, col0 = C_G + u.pn * BM + wc * 32 + 8 * fq;
#pragma unroll
        for (int ai = 0; ai < 2; ++ai)
#pragma unroll
            for (int m = 0; m < 4; ++m) { bf16_t* pp = P + (size_t)(row0 + ai * HALF + m * 16) * DIN + col0;
#pragma unroll
                for (int bj = 0; bj < 2; ++bj) { f32x4 v0 = acc[ai][bj][m][0], v1 = acc[ai][bj][m][1];
#pragma unroll
                    for (int e = 0; e < 4; ++e) { v0[e] = sigmoidf(v0[e] * (1.0f / 32.0f)); v1[e] = sigmoidf(v1[e] * (1.0f / 32.0f)); }
                    *(u32x4*)(pp + bj * HALF) = pack8(v0, v1); } }
    }
};
struct GateOrder {
    int first, count, stride;
    __device__ __forceinline__ void init(int c, int G) { stride = 1; if (G != 256) { first = c; stride = G; count = (33 * 24 - c + G - 1) / G; } else if (c < 82) { first = 2 * c; count = 2; } else if (c < 188) { first = 164 + 4 * (c - 82); count = 4; } else { first = 588 + 3 * (c - 188); count = 3; } }
    __device__ __forceinline__ bool next(int i, Unit& u) const { if (i >= count) return false; const int g = first + i * stride; u.pm = g / 24; u.pn = g % 24; return true; }
    __device__ __forceinline__ void a_ready(const Unit&) const {}
    __device__ __forceinline__ void done(const Unit&) const {}
};
template <int STEP> struct EpiBr {
    static constexpr bool PERM = true, AFTER_DRAIN = false;
    float* mf; bf16_t* mb; const bf16_t* P;
    __device__ __forceinline__ void operator()(AccRef acc, const Unit& u, int wr, int wc, int fr, int fq) const {
        const int row0 = u.pm * BM + wr * 64 + fr, col0 = u.pn * BM + wc * 32 + 8 * fq;
#pragma unroll
        for (int am = 0; am < 4; ++am) { const int ai = am >> 1, m0 = (am & 1) * 2;
            u32x4 gw[2][2]; f32x4 old0[2][2], old1[2][2];
#pragma unroll
            for (int mm = 0; mm < 2; ++mm)
#pragma unroll
                for (int bj = 0; bj < 2; ++bj) { const size_t row = (size_t)(row0 + ai * HALF + (m0 + mm) * 16); const int col = col0 + bj * HALF;
                    gw[mm][bj] = *(const u32x4*)(P + row * DIN + C_G + STEP * DM + col);
                    if (STEP > 0) { old0[mm][bj] = *(const f32x4*)(mf + row * DM + col); old1[mm][bj] = *(const f32x4*)(mf + row * DM + col + 4); } }
#pragma unroll
            for (int mm = 0; mm < 2; ++mm)
#pragma unroll
                for (int bj = 0; bj < 2; ++bj) { const size_t row = (size_t)(row0 + ai * HALF + (m0 + mm) * 16); const int col = col0 + bj * HALF;
                    f32x4 g0, g1; unpack8(gw[mm][bj], g0, g1);
                    f32x4 v0 = g0 * acc[ai][bj][m0 + mm][0], v1 = g1 * acc[ai][bj][m0 + mm][1];
                    if (STEP > 0) { v0 += old0[mm][bj]; v1 += old1[mm][bj]; }
                    float* mp = mf + row * DM + col;
                    if (STEP < 2) { *(f32x4*)mp = v0; *(f32x4*)(mp + 4) = v1; } else *(u32x4*)(mb + row * DM + col) = pack8(v0, v1); }
            asm volatile("" ::: "memory");
        }
    }
};

struct EpiBrChain {
    static constexpr bool PERM = true, AFTER_DRAIN = false;
    bf16_t* mb; const bf16_t* P;
    template <int GS> __device__ __forceinline__ void scale(f32x4 (&acc)[2][2][4][2], const Unit& u, int tid) const {
        asm volatile("" : "+v"(tid));
        const int wid = __builtin_amdgcn_readfirstlane(tid >> 6), lane = tid & 63, wr = wid >> 2, wc = wid & 3, fr = lane & 15, fq = lane >> 4;
        const bf16_t* gp0 = P + (size_t)(u.pm * BM + wr * 64 + fr) * DIN + C_G + GS * DM + u.pn * BM + wc * 32 + 8 * fq;
        typedef const __attribute__((address_space(1))) u32x4 gq;
        u32x4 cn[2], cd[2], nn[2], nd[2];
#define GLD(n_, d_, g_) do { const bf16_t* gp_ = gp0 + (size_t)(((g_) >> 2) * HALF + ((g_) & 3) * 16) * DIN; _Pragma("unroll") for (int bj = 0; bj < 2; ++bj) { n_[bj] = *(gq*)(gp_ + bj * HALF); d_[bj] = *(gq*)(gp_ + DM + bj * HALF); } } while (0)
        GLD(cn, cd, 0);
#pragma unroll
        for (int g = 0; g < 8; ++g) { const int ai = g >> 2, m = g & 3;
            if (g < 7) GLD(nn, nd, g + 1);
#pragma unroll
            for (int bj = 0; bj < 2; ++bj) { f32x4 n0, n1, d0, d1; unpack8(cn[bj], n0, n1); unpack8(cd[bj], d0, d1);
#pragma unroll
                for (int e = 0; e < 4; ++e) { const float a0 = GS ? fmaxf(n0[e], 1e-15f) : n0[e], a1 = GS ? fmaxf(n1[e], 1e-15f) : n1[e];
                    acc[ai][bj][m][0][e] *= a0 * __builtin_amdgcn_rcpf(fmaxf(d0[e], 1e-15f)); acc[ai][bj][m][1][e] *= a1 * __builtin_amdgcn_rcpf(fmaxf(d1[e], 1e-15f)); } }
            asm volatile("" : "+v"(acc[ai][0][m][0]), "+v"(acc[ai][0][m][1]), "+v"(acc[ai][1][m][0]), "+v"(acc[ai][1][m][1]) :: "memory");
#pragma unroll
            for (int bj = 0; bj < 2; ++bj) { cn[bj] = nn[bj]; cd[bj] = nd[bj]; }
        }
#undef GLD
    }
    __device__ __forceinline__ void operator()(AccRef acc, const Unit& u, int wr, int wc, int fr_, int fq) const {
        int fr = fr_; asm volatile("" : "+v"(fr));
        const int row0 = u.pm * BM + wr * 64 + fr, col0 = u.pn * BM + wc * 32 + 8 * fq;
#pragma unroll
        for (int am = 0; am < 4; ++am) { const int ai = am >> 1, m0 = (am & 1) * 2;
            u32x4 gw[2][2];
#pragma unroll
            for (int mm = 0; mm < 2; ++mm)
#pragma unroll
                for (int bj = 0; bj < 2; ++bj) gw[mm][bj] = *(const __attribute__((address_space(1))) u32x4*)(P + (size_t)(row0 + ai * HALF + (m0 + mm) * 16) * DIN + C_G + 2 * DM + col0 + bj * HALF);
#pragma unroll
            for (int mm = 0; mm < 2; ++mm)
#pragma unroll
                for (int bj = 0; bj < 2; ++bj) { f32x4 g0, g1; unpack8(gw[mm][bj], g0, g1);
#pragma unroll
                    for (int e = 0; e < 4; ++e) { g0[e] = fmaxf(g0[e], 1e-15f); g1[e] = fmaxf(g1[e], 1e-15f); }
                    *(u32x4*)(mb + (size_t)(row0 + ai * HALF + (m0 + mm) * 16) * DM + col0 + bj * HALF) = pack8(g0 * acc[ai][bj][m0 + mm][0], g1 * acc[ai][bj][m0 + mm][1]); }
            asm volatile("" ::: "memory"); }
    }
};
struct EpiRes {
    static constexpr bool PERM = false, AFTER_DRAIN = false;
    const float* h; const float* gx; const float* gc; float* dst;
    __device__ __forceinline__ void operator()(AccRef acc, const Unit& u, int wr, int wc, int fr, int fq) const {
        const int row0 = u.pm * BM + wr * 64 + fr, col0 = u.pn * BM + wc * 32 + 4 * fq;
        const float* gp = (u.pm * BM < SEQ ? gx : gc) + col0;
        f32x4 gv[2][2];
#pragma unroll
        for (int bj = 0; bj < 2; ++bj)
#pragma unroll
            for (int n = 0; n < 2; ++n) gv[bj][n] = *(const f32x4*)(gp + bj * HALF + n * 16);
#pragma unroll
        for (int am = 0; am < 4; ++am) { const int ai = am >> 1, m0 = (am & 1) * 2;
            f32x4 old[2][2][2];
#pragma unroll
            for (int mm = 0; mm < 2; ++mm)
#pragma unroll
                for (int bj = 0; bj < 2; ++bj)
#pragma unroll
                    for (int n = 0; n < 2; ++n) old[mm][bj][n] = *(const f32x4*)(h + (size_t)(row0 + ai * HALF + (m0 + mm) * 16) * DM + col0 + bj * HALF + n * 16);
#pragma unroll
            for (int mm = 0; mm < 2; ++mm)
#pragma unroll
                for (int bj = 0; bj < 2; ++bj)
#pragma unroll
                    for (int n = 0; n < 2; ++n) *(f32x4*)(dst + (size_t)(row0 + ai * HALF + (m0 + mm) * 16) * DM + col0 + bj * HALF + n * 16) = old[mm][bj][n] + gv[bj][n] * acc[ai][bj][m0 + mm][n];
            asm volatile("" ::: "memory"); }
    }
};
__device__ __forceinline__ float dpp_ror1(float v)  { return __int_as_float(__builtin_amdgcn_update_dpp(0, __float_as_int(v), 0x121, 0xf, 0xf, false)); }
__device__ __forceinline__ float dpp_ror15(float v) { return __int_as_float(__builtin_amdgcn_update_dpp(0, __float_as_int(v), 0x12f, 0xf, 0xf, false)); }
struct EpiUp {
    static constexpr bool PERM = true, AFTER_DRAIN = false;
    bf16_t* act; float* E; const float* cw; const float* cb;
    __device__ __forceinline__ void operator()(AccRef acc, const Unit& u, int wr, int wc, int fr, int fq) const {
        const int ch0 = u.pn * 128 + wc * 32 + 8 * fq, ycol0 = u.pn * BM + wc * 32 + 8 * fq;
#pragma unroll
        for (int nn = 0; nn < 2; ++nn) {
            const int ch = ch0 + 4 * nn;
            const f32x4 wa0 = *(const f32x4*)(cw + ch), wa1 = *(const f32x4*)(cw + DUP + ch), wa2 = *(const f32x4*)(cw + 2 * DUP + ch), ba = *(const f32x4*)(cb + ch);
            const f32x4 wg0 = *(const f32x4*)(cw + DFF + ch), wg1 = *(const f32x4*)(cw + DUP + DFF + ch), wg2 = *(const f32x4*)(cw + 2 * DUP + DFF + ch), bg = *(const f32x4*)(cb + DFF + ch);
#pragma unroll
            for (int ai = 0; ai < 2; ++ai) {
                const int blk = 4 * u.pm + 2 * ai + wr;
#pragma unroll
                for (int m = 0; m < 4; ++m) {
                    const f32x4 ya = acc[ai][0][m][nn], yg = acc[ai][1][m][nn];
                    const f32x4 pa = acc[ai][0][m > 0 ? m - 1 : 0][nn], pg = acc[ai][1][m > 0 ? m - 1 : 0][nn];
                    const f32x4 na = acc[ai][0][m < 3 ? m + 1 : 3][nn], ng = acc[ai][1][m < 3 ? m + 1 : 3][nn];
                    f32x4 o;
#pragma unroll
                    for (int e = 0; e < 4; ++e) {
                        const float ua = dpp_ror1(fr == 15 ? pa[e] : ya[e]), ug = dpp_ror1(fr == 15 ? pg[e] : yg[e]);
                        const float da = dpp_ror15(fr == 0 ? na[e] : ya[e]), dg = dpp_ror15(fr == 0 ? ng[e] : yg[e]);
                        const float ha = ba[e] + wa0[e] * ua + wa1[e] * ya[e] + wa2[e] * da;
                        const float hg = bg[e] + wg0[e] * ug + wg1[e] * yg[e] + wg2[e] * dg;
                        o[e] = siluf(hg) * ha;
                    }
                    const int row = u.pm * BM + ai * HALF + wr * 64 + m * 16 + fr;
                    const bool edge = (m == 0 && fr == 0) || (m == 3 && fr == 15);
                    if (!edge) { u32x2 w; w.x = cvt_pk_bf16(o[0], o[1]); w.y = cvt_pk_bf16(o[2], o[3]); *(u32x2*)(act + (size_t)row * DFF + ch) = w; }
                    if ((m == 0 && fr < 2) || (m == 3 && fr >= 14)) {
                        const int slot = (m == 0) ? fr : fr - 12;
                        float* ep = E + ((size_t)blk * 4 + slot) * DUP + ycol0 + 4 * nn; *(f32x4*)ep = ya; *(f32x4*)(ep + HALF) = yg;
                    }
                }
            }
        }
    }
};
struct EpiY {
    static constexpr bool PERM = false, AFTER_DRAIN = false;
    float* Y;
    __device__ __forceinline__ void operator()(AccRef acc, const Unit& u, int wr, int wc, int fr, int fq) const {
        const int row0 = u.pm * BM + wr * 64 + fr, col0 = u.pn * BM + wc * 32 + 4 * fq;
#pragma unroll
        for (int ai = 0; ai < 2; ++ai)
#pragma unroll
            for (int m = 0; m < 4; ++m) { float* yp = Y + (size_t)(row0 + ai * HALF + m * 16) * DUP + col0;
#pragma unroll
                for (int bj = 0; bj < 2; ++bj)
#pragma unroll
                    for (int n = 0; n < 2; ++n) *(f32x4*)(yp + bj * HALF + n * 16) = acc[ai][bj][m][n]; }
    }
};
}

namespace att {
constexpr int D = 128, NW = 8, QBLK = 32, KVBLK = 64, LDP = DIN;
constexpr int SHM_V = KVBLK * D * 2, SHM_K = SHM_V;
constexpr int TILE_B = SHM_K + SHM_V, NRING = 4;
constexpr int OFF_WS = NRING * TILE_B, OFF_BIAS = OFF_WS + NW * 64 * 4, BIAS_PAD = 64, BIAS_N = 15 * 31, SHM_TOTAL = OFF_BIAS + (2 * BIAS_PAD + 480) * 4;
#define KSWZ(row, colB) ((row) * 256 + ((colB) ^ (((row) & 7) << 4)))
#define SBAR() __builtin_amdgcn_sched_barrier(0)
#define LAUNDER(p) asm volatile("" : "+v"(p))
__device__ __forceinline__ int crow(int r, int hi) { return (r & 3) + 8 * (r >> 2) + 4 * hi; }

struct Unit {
    const bf16_t* Q;
    const bf16_t* K;
    const bf16_t* V;
    int nt, key0;
    int rsA, r0;
    bf16_t* O; int ldo;
    float* S;
    const float* gsub; float lam, osc;
    float shift;
    int tmask;
    float* part; unsigned* flag; int pmode;
    int var;
};

__device__ __forceinline__ void halfSM(f32x16& p, float& l_reg, bf16x8& paX, bf16x8& paY) {
#pragma unroll
    for (int r = 0; r < 16; ++r) p[r] = __builtin_amdgcn_exp2f(p[r]);
    float ps = 0;
#pragma unroll
    for (int r = 0; r < 16; ++r) ps += p[r];
    l_reg += ps;
#define PK4(P, BASE, OUT) do { unsigned a0 = cvt_pk_bf16(P[BASE + 0], P[BASE + 1]), a1 = cvt_pk_bf16(P[BASE + 2], P[BASE + 3]);   \
    unsigned b0 = cvt_pk_bf16(P[BASE + 4], P[BASE + 5]), b1 = cvt_pk_bf16(P[BASE + 6], P[BASE + 7]);                              \
    auto r0 = __builtin_amdgcn_permlane32_swap(a0, b0, false, false); auto r1 = __builtin_amdgcn_permlane32_swap(a1, b1, false, false); \
    u32x4 w = {r0[0], r1[0], r0[1], r1[1]}; OUT = *reinterpret_cast<bf16x8*>(&w); } while (0)
    PK4(p, 0, paX); PK4(p, 8, paY);
#undef PK4
}
template <int NDQ, int DB, bool SHIFT>
__device__ __forceinline__ void qkt(f32x16& p0, f32x16& p1, const char* Ks, const bf16x8* qr, int r32, int hi, float shift) {
    p0 = f32x16{}; p1 = f32x16{};
#pragma unroll
    for (int d0 = 0; d0 < NDQ; ++d0) { const int cb = ((DB + d0) * 16 + hi * 8) * 2;
        const bf16x8 b0 = *reinterpret_cast<const bf16x8*>(Ks + KSWZ(r32, cb));
        const bf16x8 b1 = *reinterpret_cast<const bf16x8*>(Ks + KSWZ(32 + r32, cb));
        p0 = __builtin_amdgcn_mfma_f32_32x32x16_bf16(b0, qr[d0], p0, 0, 0, 0);
        p1 = __builtin_amdgcn_mfma_f32_32x32x16_bf16(b1, qr[d0], p1, 0, 0, 0); }
    if (SHIFT && shift != 0.f) {
        const short one = hi == 0 ? (short)0x3f80 : (short)0, ms = hi == 0 ? (short)f2bf(-shift) : (short)0;
        const bf16x8 af = {one, 0, 0, 0, 0, 0, 0, 0}, bf = {ms, 0, 0, 0, 0, 0, 0, 0};
        p0 = __builtin_amdgcn_mfma_f32_32x32x16_bf16(af, bf, p0, 0, 0, 0);
        p1 = __builtin_amdgcn_mfma_f32_32x32x16_bf16(af, bf, p1, 0, 0, 0); }
}
__device__ __forceinline__ int v_st(int k, int c) { const int kk = (k & ~0xC) | ((k & 4) << 1) | ((k & 8) >> 1); return ((kk >> 3) * 4 + (c >> 5)) * 512 + ((kk & 7) * 32 + (c & 31)) * 2; }
__device__ __forceinline__ int v_rd_base(int lane) { return ((lane & 3) << 3) | (((lane >> 2) & 3) << 6) | (((lane >> 4) & 1) << 5) | (((lane >> 5) & 1) << 8); }
constexpr int v_rd_off(int d0, int ks, int half) { return d0 * 512 + ks * 4096 + half * 2048; }
template <int OFF> __device__ __forceinline__ s16x4 tr_read(int vb) {
    s16x4 r; asm volatile("ds_read_b64_tr_b16 %0, %1 offset:%2" : "=&v"(r) : "v"(vb), "i"(OFF) : "memory"); return r;
}
template <int D0> __device__ __forceinline__ void pv_one(f32x16& od, int vb, bf16x8 pa0, bf16x8 pa1, bf16x8 pa2, bf16x8 pa3) {
    const s16x4 l0 = tr_read<v_rd_off(D0, 0, 0)>(vb), h0 = tr_read<v_rd_off(D0, 0, 1)>(vb), l1 = tr_read<v_rd_off(D0, 1, 0)>(vb), h1 = tr_read<v_rd_off(D0, 1, 1)>(vb);
    const s16x4 l2 = tr_read<v_rd_off(D0, 2, 0)>(vb), h2 = tr_read<v_rd_off(D0, 2, 1)>(vb), l3 = tr_read<v_rd_off(D0, 3, 0)>(vb), h3 = tr_read<v_rd_off(D0, 3, 1)>(vb);
    asm volatile("s_waitcnt lgkmcnt(0)" ::: "memory"); SBAR();
#define PK(L, H) (bf16x8){L[0], L[1], L[2], L[3], H[0], H[1], H[2], H[3]}
    od = __builtin_amdgcn_mfma_f32_32x32x16_bf16(pa0, PK(l0, h0), od, 0, 0, 0);
    od = __builtin_amdgcn_mfma_f32_32x32x16_bf16(pa1, PK(l1, h1), od, 0, 0, 0);
    od = __builtin_amdgcn_mfma_f32_32x32x16_bf16(pa2, PK(l2, h2), od, 0, 0, 0);
    od = __builtin_amdgcn_mfma_f32_32x32x16_bf16(pa3, PK(l3, h3), od, 0, 0, 0);
#undef PK
}
__device__ __forceinline__ void pv_d0(f32x16* o, int vb, bf16x8 pa0, bf16x8 pa1, bf16x8 pa2, bf16x8 pa3) {
    pv_one<0>(o[0], vb, pa0, pa1, pa2, pa3); pv_one<1>(o[1], vb, pa0, pa1, pa2, pa3); pv_one<2>(o[2], vb, pa0, pa1, pa2, pa3); pv_one<3>(o[3], vb, pa0, pa1, pa2, pa3);
}


template <int OFF> __device__ __forceinline__ bf16x8 k_read(int addr) { bf16x8 r; asm volatile("ds_read_b128 %0, %1 offset:%2" : "=&v"(r) : "v"(addr), "i"(OFF) : "memory"); return r; }
#define LWAIT(n) do { asm volatile("s_waitcnt lgkmcnt(" #n ")" ::: "memory"); SBAR(); } while (0)
template <int D0> __device__ __forceinline__ void v_read8(s16x4 (&v)[8], int vb) {
    v[0] = tr_read<v_rd_off(D0, 0, 0)>(vb); v[1] = tr_read<v_rd_off(D0, 0, 1)>(vb); v[2] = tr_read<v_rd_off(D0, 1, 0)>(vb); v[3] = tr_read<v_rd_off(D0, 1, 1)>(vb);
    v[4] = tr_read<v_rd_off(D0, 2, 0)>(vb); v[5] = tr_read<v_rd_off(D0, 2, 1)>(vb); v[6] = tr_read<v_rd_off(D0, 3, 0)>(vb); v[7] = tr_read<v_rd_off(D0, 3, 1)>(vb);
}
__device__ __forceinline__ void pv_mma(f32x16& od, const s16x4 (&v)[8], bf16x8 pa0, bf16x8 pa1, bf16x8 pa2, bf16x8 pa3) {
#define PK(L, H) (bf16x8){L[0], L[1], L[2], L[3], H[0], H[1], H[2], H[3]}
    od = __builtin_amdgcn_mfma_f32_32x32x16_bf16(pa0, PK(v[0], v[1]), od, 0, 0, 0);
    od = __builtin_amdgcn_mfma_f32_32x32x16_bf16(pa1, PK(v[2], v[3]), od, 0, 0, 0);
    od = __builtin_amdgcn_mfma_f32_32x32x16_bf16(pa2, PK(v[4], v[5]), od, 0, 0, 0);
    od = __builtin_amdgcn_mfma_f32_32x32x16_bf16(pa3, PK(v[6], v[7]), od, 0, 0, 0);
#undef PK
}
template <int NDQ, int DB, bool SHIFT>
__device__ __forceinline__ void x_phase(f32x16& p0, f32x16& p1, f32x16 (&o)[4], const bf16x8* qr, const int (&ka)[4], int kd, int vb, bool do_pv, s16x4 (&va)[8],
                                        bf16x8 pa0, bf16x8 pa1, bf16x8 pa2, bf16x8 pa3, float shift, int hi, int var) {
    bf16x8 kf[2 * NDQ]; s16x4 vbk[8];
    int kb[4];
#pragma unroll
    for (int b = 0; b < 4; ++b) kb[b] = ka[b] + (DB >= 4 ? kd : 0);
    asm volatile("s_waitcnt lgkmcnt(0)" ::: "memory");
    SBAR();
#pragma unroll
    for (int b = 0; b < 4; ++b) { kf[2 * b] = k_read<0>(kb[b]); kf[2 * b + 1] = k_read<8192>(kb[b]); }
    if (do_pv) {
        v_read8<1>(vbk, vb); LWAIT(8); pv_mma(o[0], va, pa0, pa1, pa2, pa3); SBAR();
        v_read8<2>(va, vb);  LWAIT(8); pv_mma(o[1], vbk, pa0, pa1, pa2, pa3); SBAR();
        v_read8<3>(vbk, vb); LWAIT(8); pv_mma(o[2], va, pa0, pa1, pa2, pa3); SBAR();
    }
    if constexpr (NDQ == 8) {
#pragma unroll
        for (int b = 0; b < 4; ++b) { kf[8 + 2 * b] = k_read<0>(ka[b] + kd); kf[8 + 2 * b + 1] = k_read<8192>(ka[b] + kd); }
        if (do_pv) { LWAIT(8); pv_mma(o[3], vbk, pa0, pa1, pa2, pa3); SBAR(); } else LWAIT(8);
    } else { if (do_pv) { LWAIT(0); pv_mma(o[3], vbk, pa0, pa1, pa2, pa3); SBAR(); } else LWAIT(0); }
    p0 = f32x16{}; p1 = f32x16{};
#pragma unroll
    for (int d0 = 0; d0 < 4; ++d0) { p0 = __builtin_amdgcn_mfma_f32_32x32x16_bf16(kf[2 * d0], qr[d0], p0, 0, 0, 0); p1 = __builtin_amdgcn_mfma_f32_32x32x16_bf16(kf[2 * d0 + 1], qr[d0], p1, 0, 0, 0); }
    SBAR();
    if constexpr (NDQ == 8) {
        LWAIT(0);
#pragma unroll
        for (int d0 = 4; d0 < 8; ++d0) { p0 = __builtin_amdgcn_mfma_f32_32x32x16_bf16(kf[2 * d0], qr[d0], p0, 0, 0, 0); p1 = __builtin_amdgcn_mfma_f32_32x32x16_bf16(kf[2 * d0 + 1], qr[d0], p1, 0, 0, 0); }
        SBAR();
    }
    if (SHIFT && shift != 0.f) {
        const short one = hi == 0 ? (short)0x3f80 : (short)0, ms = hi == 0 ? (short)f2bf(-shift) : (short)0;
        const bf16x8 af = {one, 0, 0, 0, 0, 0, 0, 0}, bfr = {ms, 0, 0, 0, 0, 0, 0, 0};
        p0 = __builtin_amdgcn_mfma_f32_32x32x16_bf16(af, bfr, p0, 0, 0, 0); p1 = __builtin_amdgcn_mfma_f32_32x32x16_bf16(af, bfr, p1, 0, 0, 0); SBAR();
    }
}

struct NaCtx { int rsA, rq, rsq, cq, csq; const float* bias; };
template <bool NA, int HALF_>
__device__ __forceinline__ void na_hook(f32x16& p, int t, const NaCtx& n, int hi) {
    if constexpr (NA) {
        if (t >= 4) {
            const int kr = n.rsA + t - 4;
            if (kr < n.rsq || kr >= n.rsq + 8) {
#pragma unroll
                for (int r = 0; r < 16; ++r) p[r] = -1e30f;
            } else {
                const float* brow = n.bias + (kr - n.rq + 7) * 31 + 15 - n.cq + 32 * HALF_;
#pragma unroll
                for (int rg = 0; rg < 16; rg += 8) {
                    float b[8];
#pragma unroll
                    for (int r = 0; r < 8; ++r) b[r] = brow[crow(rg + r, hi)];
                    asm volatile("s_waitcnt lgkmcnt(0)" ::: "memory");
#pragma unroll
                    for (int r = 0; r < 8; ++r) { const int kc = crow(rg + r, hi) + 32 * HALF_; p[rg + r] = (kc >= n.csq && kc < n.csq + 16) ? p[rg + r] + b[r] : -1e30f; }
                }
            }
        }
    }
}

template <int NDQ, int DB, bool NA, int EPI, bool SHIFT>
__device__ __forceinline__ void attn_body(const Unit& u, char* lds, int tid) {
    asm volatile("" : "+v"(tid));
    const int wid = __builtin_amdgcn_readfirstlane(tid >> 6), lane = tid & 63, r32 = lane & 31, hi = lane >> 5;
    const bool trail = wid >= 4;
    float* li_l = (float*)(lds + OFF_WS) + wid * 64;
    float l_reg = 0; f32x16 o[4] = {}; bf16x8 qr[NDQ]; const float shift = u.shift;
    typedef __attribute__((address_space(1))) const bf16x8 gbf16x8;
    const bf16_t* Qw = u.Q + (long)(wid * QBLK + r32) * LDP + hi * 8 + DB * 16;
#pragma unroll
    for (int d0 = 0; d0 < NDQ; ++d0) qr[d0] = *(gbf16x8*)(Qw + d0 * 16);
    const int vb0 = (int)(uintptr_t)lds + SHM_K + v_rd_base(lane);
    int ka0[4];
#pragma unroll
    for (int b = 0; b < 4; ++b) ka0[b] = (int)(uintptr_t)lds + r32 * 256 + 16 * ((2 * b) ^ (hi ^ (r32 & 7))) + 128 * ((r32 >> 3) & 1);
    const int kd = 128 - 256 * ((r32 >> 3) & 1);
    NaCtx na;
    if constexpr (NA) { na.rsA = u.rsA; na.rq = u.r0 + (wid >> 1); na.rsq = min(max(na.rq - 4, 0), 120); na.cq = 32 * (wid & 1) + r32; na.csq = min(max(na.cq - 8, 0), 48); na.bias = (const float*)(lds + OFF_BIAS) + BIAS_PAD; }
    unsigned koff[2], voff[2];
#pragma unroll
    for (int i = 0; i < 2; ++i) { const int G = wid * 128 + i * 64 + lane;
        { const int row = G >> 4, g = (G & 15) ^ (row & 15); koff[i] = (unsigned)(row * LDP + g * 8) * 2u; }
        { const int sub = G >> 5, r8 = (G >> 2) & 7, c4 = G & 3, kk = (sub >> 2) * 8 + r8, cg = (sub & 3) * 4 + c4, k = (kk & ~0xC) | ((kk & 4) << 1) | ((kk & 8) >> 1); voff[i] = (unsigned)(k * LDP + cg * 8) * 2u; } }
    const char* Kg = (const char*)u.K; const char* Vg = (const char*)u.V;
    LAS unsigned char* ldsL = (LAS unsigned char*)(unsigned)(uintptr_t)lds;
#define TROW(t) (NA ? ((t) < 4 ? SEQ + 64 * ((t) & u.tmask) : (u.rsA + (((t) - 4) & u.tmask)) * 64) : u.key0 + 64 * ((t) & u.tmask))
#define DMA_TILE(t, boff) do { const size_t rb_ = (size_t)(TROW(t)) * (LDP * 2); _Pragma("unroll") for (int i_ = 0; i_ < 2; ++i_) { \
        __builtin_amdgcn_global_load_lds((const __attribute__((address_space(1))) unsigned*)(Kg + rb_ + koff[i_]), (LAS unsigned*)(ldsL + (boff) + wid * 2048 + i_ * 1024), 16, 0, 0); \
        __builtin_amdgcn_global_load_lds((const __attribute__((address_space(1))) unsigned*)(Vg + rb_ + voff[i_]), (LAS unsigned*)(ldsL + (boff) + SHM_K + wid * 2048 + i_ * 1024), 16, 0, 0); } } while (0)
#define VWAIT() asm volatile("s_waitcnt vmcnt(0)" ::: "memory")
#define PBAR() do { asm volatile("s_waitcnt lgkmcnt(0)" ::: "memory"); __builtin_amdgcn_s_barrier(); asm volatile("" ::: "memory"); } while (0)
    bf16x8 pa0, pa1, pa2, pa3; f32x16 p0, p1; s16x4 va[8]; const int NT = u.nt;
    DMA_TILE(0, 0); DMA_TILE(1, TILE_B); VWAIT(); PBAR();
    if (trail) PBAR();
    int b_prev = 3 * TILE_B, b_cur = 0;
    for (int i = 0; i < NT; ++i) {
        { int ka[4];
#pragma unroll
          for (int b = 0; b < 4; ++b) ka[b] = ka0[b] + b_cur;
          x_phase<NDQ, DB, SHIFT>(p0, p1, o, qr, ka, kd, vb0 + b_prev, i >= 1, va, pa0, pa1, pa2, pa3, shift, hi, u.var); }
        VWAIT();
        PBAR();
        if (i + 2 < NT && !(u.var & 8)) DMA_TILE(i + 2, (b_cur + 2 * TILE_B) & (NRING * TILE_B - 1));
        if (!(u.var & 2)) { na_hook<NA, 0>(p0, i, na, hi); halfSM(p0, l_reg, pa0, pa1); SBAR();
        na_hook<NA, 1>(p1, i, na, hi); halfSM(p1, l_reg, pa2, pa3); }
        asm volatile("" : "+v"(l_reg));
        SBAR(); if (!(u.var & 16)) v_read8<0>(va, vb0 + b_cur);
        PBAR();
        b_prev = b_cur; b_cur = (b_cur + TILE_B) & (NRING * TILE_B - 1);
    }
    {
        s16x4 vbk[8];
        v_read8<1>(vbk, vb0 + b_prev); LWAIT(8); pv_mma(o[0], va, pa0, pa1, pa2, pa3); SBAR();
        v_read8<2>(va, vb0 + b_prev);  LWAIT(8); pv_mma(o[1], vbk, pa0, pa1, pa2, pa3); SBAR();
        v_read8<3>(vbk, vb0 + b_prev); LWAIT(8); pv_mma(o[2], va, pa0, pa1, pa2, pa3); SBAR();
        LWAIT(0); pv_mma(o[3], vbk, pa0, pa1, pa2, pa3); SBAR();
    }
    if (!trail) PBAR();
    { auto rr = __builtin_amdgcn_permlane32_swap(__float_as_uint(l_reg), __float_as_uint(l_reg), false, false); l_reg = __uint_as_float(rr[0]) + __uint_as_float(rr[1]); }
    bool fin = true;
    if constexpr (EPI == 0 && !NA) {
        if (u.pmode == 1) {
            typedef __attribute__((address_space(1))) float gf32; float* Pw_ = u.part + wid * (65 * 64) + lane; LAUNDER(Pw_); gf32* Pw = (gf32*)Pw_;
#pragma unroll
            for (int d0 = 0; d0 < 4; ++d0)
#pragma unroll
                for (int r = 0; r < 16; ++r) __hip_atomic_store(Pw + (d0 * 16 + r) * 64, o[d0][r], __ATOMIC_RELAXED, __HIP_MEMORY_SCOPE_AGENT);
            __hip_atomic_store(Pw + 64 * 64, l_reg, __ATOMIC_RELAXED, __HIP_MEMORY_SCOPE_AGENT);
            asm volatile("s_waitcnt vmcnt(0) lgkmcnt(0)" ::: "memory");
            if (lane == 0) (void)__hip_atomic_fetch_add(u.flag, 1u, __ATOMIC_RELAXED, __HIP_MEMORY_SCOPE_AGENT);
            fin = false;
        } else if (u.pmode == 2) {
            unsigned sp_ = 0;
            while (__hip_atomic_load(u.flag, __ATOMIC_RELAXED, __HIP_MEMORY_SCOPE_AGENT) < 8u && ++sp_ < (1u << 20)) __builtin_amdgcn_s_sleep(2);
            asm volatile("" ::: "memory");
            typedef __attribute__((address_space(1))) float gf32; float* Pr_ = u.part + wid * (65 * 64) + lane; LAUNDER(Pr_); gf32* Pr = (gf32*)Pr_;
            l_reg += __hip_atomic_load(Pr + 64 * 64, __ATOMIC_RELAXED, __HIP_MEMORY_SCOPE_AGENT);
#pragma unroll
            for (int d0 = 0; d0 < 4; ++d0)
#pragma unroll
                for (int r = 0; r < 16; ++r) o[d0][r] += __hip_atomic_load(Pr + (d0 * 16 + r) * 64, __ATOMIC_RELAXED, __HIP_MEMORY_SCOPE_AGENT);
        }
    }
    if (fin) {
    if (hi == 0) li_l[r32] = l_reg; asm volatile("s_waitcnt lgkmcnt(0)" ::: "memory");
    float rli[16];
#pragma unroll
    for (int r = 0; r < 16; ++r) rli[r] = __builtin_amdgcn_rcpf(li_l[crow(r, hi)]);
    if constexpr (EPI == 0) {
        bf16_t* Ow = u.O + (long)(wid * QBLK) * u.ldo + r32; LAUNDER(Ow);
#pragma unroll
        for (int r = 0; r < 16; ++r) { const int orow = crow(r, hi);
#pragma unroll
            for (int d0 = 0; d0 < 4; ++d0) Ow[(long)orow * u.ldo + d0 * 32] = f2bf(o[d0][r] * rli[r]); }
    } else if constexpr (EPI == 1) {
        float* Sw = u.S + (long)(wid * QBLK) * 512 + r32; LAUNDER(Sw);
#pragma unroll
        for (int r = 0; r < 16; ++r) { const int orow = crow(r, hi);
#pragma unroll
            for (int d0 = 0; d0 < 4; ++d0) Sw[(long)orow * 512 + d0 * 32] = o[d0][r] * rli[r]; }
    } else {
        const float* Sw = u.S + (long)(wid * QBLK) * 512 + r32; bf16_t* Ow = u.O + (long)(wid * QBLK) * u.ldo + r32; LAUNDER(Sw); LAUNDER(Ow);
        float gg[4];
#pragma unroll
        for (int d0 = 0; d0 < 4; ++d0) gg[d0] = u.gsub[d0 * 32 + r32] * u.osc;
#pragma unroll
        for (int r = 0; r < 16; ++r) { const int orow = crow(r, hi); float v[4]; float ss = 0.f;
#pragma unroll
            for (int d0 = 0; d0 < 4; ++d0) { v[d0] = Sw[(long)orow * 512 + d0 * 32] - u.lam * (o[d0][r] * rli[r]); ss += v[d0] * v[d0]; }
            ss = half_sum(ss);
            const float rstd = 1.0f / sqrtf(ss * (1.0f / 128.0f) + EPS);
#pragma unroll
            for (int d0 = 0; d0 < 4; ++d0) Ow[(long)orow * u.ldo + d0 * 32] = f2bf(v[d0] * rstd * gg[d0]); asm volatile("" ::: "memory"); }
    }
    }
    asm volatile("s_waitcnt vmcnt(0) lgkmcnt(0)" ::: "memory");
    __builtin_amdgcn_s_barrier();
    asm volatile("" ::: "memory");
#undef TROW
#undef DMA_TILE
#undef VWAIT
#undef PBAR
}
}

__device__ __forceinline__ int q_pop(unsigned* ctr, char* lds, int tid_) {
    volatile int* slot = (volatile int*)(lds + att::SHM_TOTAL);
    __syncthreads();
    if (tid_ == 0) *slot = (int)__hip_atomic_fetch_add(ctr, 1u, __ATOMIC_RELAXED, __HIP_MEMORY_SCOPE_AGENT);
    __syncthreads();
    return *slot;
}
__device__ __forceinline__ void phase_attn(int wid_k, int l, char* lds, int rep) {
    PHASE_ENTER(cin)
    unsigned* qctr = (unsigned*)(c.ws + WS_CTL + 16384) + (l + 4 * rep) * 256;
    bf16_t* const oa_ = rep ? (bf16_t*)(c.ws + WS_ACT) : c.oa(); bf16_t* const ob_ = oa_ + 1024; bf16_t* const oc_ = oa_ + 1536; float* const ocs_ = rep ? (float*)(c.ws + WS_ACT + (size_t)MT * 2048 * 2) : c.ocs();
    const bool last = (l == DEPTH - 1);
    const float lam = c.lam()[l], osc = 1.0f - (0.8f - 0.6f * expf(-0.3f * (float)l));
    float shA, shB, shC;
    {
        const int lane = tid_ & 63;
        const float mA = 11.313708f * vmax_abs(c.in[I_GQA] + l * 128, 128, lane) * vmax_abs(c.in[I_GKA] + l * 128, 128, lane) * 1.4426950f;
        const float mB = (11.313708f * vmax_abs(c.in[I_GQB] + l * 128, 128, lane) * vmax_abs(c.in[I_GKB] + l * 128, 128, lane) + vmax_abs(c.in[I_RPB] + (size_t)l * 4 * att::BIAS_N, 4 * att::BIAS_N, lane)) * 1.4426950f;
        const float mC = 8.0f * vmax_abs(c.in[I_GQC] + l * 64, 64, lane) * vmax_abs(c.in[I_GKC] + l * 64, 64, lane) * 1.4426950f;
        shA = fmaxf(0.f, mA - 100.f); shB = fmaxf(0.f, mB - 100.f); shC = fmaxf(0.f, mC - 100.f);
    }
    for (;;) {
        const int id = q_pop(qctr + 0, lds, tid_);
        if (id >= 128 + (last ? 0 : 4)) break;
        att::Unit u{}; u.tmask = (rep && MK_ATT_VARIANT == 1) ? 0 : ~0; u.var = rep ? MK_ATT_VARIANT : 0; int head, qrow0;
        if (id < 128) { head = id >> 5; qrow0 = (id & 31) * 256; u.nt = MT / 64; u.key0 = 0; }
        else { head = id - 128; qrow0 = SEQ; u.nt = CTX / 64; u.key0 = SEQ; }
        u.Q = c.P() + (size_t)qrow0 * DIN + C_QC + head * 128; u.K = c.P() + C_KC + head * 128; u.V = c.P() + C_VC + head * 128;
        u.O = oc_ + (size_t)qrow0 * 2048 + head * 128; u.ldo = 2048; u.S = ocs_ + (size_t)qrow0 * 512 + head * 128;
        u.gsub = c.in[I_GSUB] + l * 128; u.lam = lam; u.osc = osc; u.shift = shC;
        if (__builtin_expect(shC != 0.f, 0)) { att::attn_body<4, 0, false, 1, true>(u, lds, tid_); att::attn_body<4, 4, false, 2, true>(u, lds, tid_); }
        else { att::attn_body<4, 0, false, 1, false>(u, lds, tid_); att::attn_body<4, 4, false, 2, false>(u, lds, tid_); }
    }
    for (;;) {
        const int id = q_pop(qctr + 64, lds, tid_);
        constexpr int NSPL = MK_SPLIT_S > 0 ? 128 : 0;
        if (id >= 256 + NSPL + (last ? 0 : 12)) break;
        att::Unit u{}; u.tmask = (rep && MK_ATT_VARIANT == 1) ? 0 : ~0; u.var = rep ? MK_ATT_VARIANT : 0;
        if (id < 256 + NSPL) { const int un = id < 256 ? id : id - 256, head = un >> 5, qb = un & 31;
            u.Q = c.P() + (size_t)(qb * 256) * DIN + C_QA + head * 128; u.K = c.P() + C_KA + (head >> 2) * 128; u.V = c.P() + C_VA + (head >> 2) * 128;
            u.nt = MT / 64; u.key0 = 0; u.O = oa_ + (size_t)(qb * 256) * 2048 + head * 128; u.ldo = 2048;
            if (un < NSPL) { u.part = (float*)(c.ws + WS_MF) + (size_t)(l * 128 + un) * (8 * 65 * 64);     u.flag = (unsigned*)(c.ws + WS_CTL + 32768) + (l + 4 * rep) * 128 + un;
                if (id < 256) { u.nt = MT / 64 - MK_SPLIT_S; u.pmode = 1; } else { u.key0 = 64 * (MT / 64 - MK_SPLIT_S); u.nt = MK_SPLIT_S; u.pmode = 2; } } }
        else if (id < 264 + NSPL) { const int head = id - 256 - NSPL;
            u.Q = c.P() + (size_t)SEQ * DIN + C_QA + head * 128; u.K = c.P() + C_KA + (head >> 2) * 128; u.V = c.P() + C_VA + (head >> 2) * 128;
            u.nt = CTX / 64; u.key0 = SEQ; u.O = oa_ + (size_t)SEQ * 2048 + head * 128; u.ldo = 2048; }
        else { const int head = id - 264 - NSPL;
            u.Q = c.P() + (size_t)SEQ * DIN + C_QB + head * 128; u.K = c.P() + C_KB + head * 128; u.V = c.P() + C_VB + head * 128;
            u.nt = CTX / 64; u.key0 = SEQ; u.O = ob_ + (size_t)SEQ * 2048 + head * 128; u.ldo = 2048; }
        u.shift = id < 264 + NSPL ? shA : shB;
        if (__builtin_expect(u.shift != 0.f, 0)) att::attn_body<8, 0, false, 0, true>(u, lds, tid_); else att::attn_body<8, 0, false, 0, false>(u, lds, tid_);
    }
    for (;;) {
        const int id = q_pop(qctr + 128, lds, tid_);
        if (id >= 128) break;
        const int head = id >> 5, qb = id & 31, r0 = qb * 4;
        float* bt = (float*)(lds + att::OFF_BIAS);
        for (int i = tid_; i < 2 * att::BIAS_PAD + 480; i += 512) { const int k = i - att::BIAS_PAD; bt[i] = (k >= 0 && k < att::BIAS_N) ? c.in[I_RPB][((size_t)l * 4 + head) * att::BIAS_N + k] * 1.4426950408889634f : 0.f; }
        __syncthreads();
        att::Unit u{}; u.tmask = (rep && MK_ATT_VARIANT == 1) ? 0 : ~0; u.var = rep ? MK_ATT_VARIANT : 0;
        u.Q = c.P() + (size_t)(qb * 256) * DIN + C_QB + head * 128; u.K = c.P() + C_KB + head * 128; u.V = c.P() + C_VB + head * 128;
        u.nt = 16; u.r0 = r0; u.rsA = min(max(r0 - 4, 0), 116);
        u.O = ob_ + (size_t)(qb * 256) * 2048 + head * 128; u.ldo = 2048; u.shift = shB;
        att::attn_body<8, 0, true, 0, true>(u, lds, tid_);
    }
}

constexpr int PH_PER_LAYER = 10, PH_FINAL = 1 + DEPTH * PH_PER_LAYER, N_PHASES = PH_FINAL + 1;

__global__ void __launch_bounds__(512, 2) fwd(Args a) {
    extern __shared__ __attribute__((aligned(16))) unsigned char lds_raw[];
    char* lds = (char*)lds_raw;
    volatile LAS unsigned* xbw = (volatile LAS unsigned*)(LAS unsigned char*)(lds_raw) + (LDS_BYTES - 16) / 4;
    const int wid_k = __builtin_amdgcn_readfirstlane(threadIdx.x >> 6);
    if (tid_of(wid_k) == 0) { xbw[0] = 0u; xbw[1] = 0u; xbw[2] = 0u; xbw[3] = 0u; }
    __syncthreads();
    const int lo = a.ph_lo, hi = a.ph_hi;
    if (hi - lo > 1) { Ctx c = make_ctx(); (void)xcd_barrier_post((unsigned*)(c.ws + WS_CTL), xbw, tid_of(wid_k)); }
#define IN(k) (lo <= (k) && (k) < hi)
#define SEAM(k) do { if (IN((k) + 1)) { Ctx cb_ = make_ctx(); XcdBarrier b2_; b2_.bar = (unsigned*)(cb_.ws + WS_CTL); b2_.x = xb_xcc_id(); b2_.st = xbw; xcd_barrier(b2_, tid_of(wid_k)); if (MK_PROBE == 10) xcd_barrier(b2_, tid_of(wid_k)); } } while (0)

    if (IN(0)) { phase_prologue(wid_k, lds); if (MK_PROBE == 1) { __syncthreads(); phase_prologue(wid_k, lds); } SEAM(0); }
    for (int l = 0; l < DEPTH; ++l) {
        const int pb = 1 + l * PH_PER_LAYER; const bool lastl = (l == DEPTH - 1);
#define FRESH() Ctx c = make_ctx(); int tid_ = tid_of(wid_k); PG8_LAS unsigned char* ldsL = (PG8_LAS unsigned char*)lds_raw; (void)tid_; (void)ldsL; \
        const bf16_t* wl = c.wt() + (size_t)l * LAYER_ELEMS; const float* modx = c.mod() + ((size_t)l * 2 + 0) * NMOD; const float* modc = c.mod() + ((size_t)l * 2 + 1) * NMOD; (void)wl; (void)modx; (void)modc;
        if (IN(pb + 0)) { phase_norm(wid_k, l, 0); if (MK_PROBE == 4) phase_norm(wid_k, l, 0); SEAM(pb + 0); }
#define FASTG(Aptr, Bptr, MM, NN, KK, EPI) do { pg8::Gemm g_{Aptr, Bptr, MM, NN, KK}; pg8::StaticOrder S_; S_.init(MM, NN, (int)gridDim.x, (int)blockIdx.x); pg8::gemm_phase(ldsL, g_, S_, EPI, tid_); } while (0)
#if MK_FAST_GEMM
        if (IN(pb + 1)) { FRESH(); pg8::EpiWin e{c.P(), c.in[I_GQA] + l * 128, c.in[I_GKA] + l * 128, c.in[I_GQB] + l * 128, c.in[I_GKB] + l * 128, c.in[I_GQC] + l * 64, c.in[I_GKC] + l * 64, (LAS float*)(ldsL + pg8::STAGE_BYTES)};
#if MK_GATE_FP8
            {
                pg8::Gemm gq_{c.u(), wl + O_WIN, MT, C_G, DM}; pg8::StaticOrder Sq_; Sq_.init(MT, C_G, (int)gridDim.x, (int)blockIdx.x); pg8::gemm_phase(ldsL, gq_, Sq_, e, tid_);
                pg8::EpiGate eg{c.P()};
                pg8::Gemm gg_{(const bf16_t*)(c.ws + WS_U8), (const bf16_t*)(c.ws + WS_WG8 + (size_t)l * NGATE * DM), MT, NGATE, DM / 2};
                pg8::GateOrder Sg_; Sg_.init((int)blockIdx.x, (int)gridDim.x); pg8::gemm_phase<pg8::EpiGate, pg8::GateOrder, true>(ldsL, gg_, Sg_, eg, tid_);
            }
#else
            FASTG(c.u(), wl + O_WIN, MT, DIN, DM, e);
#endif
            if (IN(pb + 3)) SEAM(pb + 2); }
#else
        if (IN(pb + 1)) { FRESH(); SEpiWin e{c.R(), c.P()}; simple_gemm(wid_k, c.u(), wl + O_WIN, MT, DIN, DM, e); SEAM(pb + 1); }
#endif
#if !MK_FAST_GEMM
        if (IN(pb + 2)) { phase_qknorm(wid_k, l); SEAM(pb + 2); }
#endif
        if (IN(pb + 3)) { phase_attn(wid_k, l, lds, 0); if (MK_PROBE == 2) { __syncthreads(); phase_attn(wid_k, l, lds, 1); } SEAM(pb + 3); }
        if (IN(pb + 4)) {
            for (int rp_ = 0; rp_ < (MK_PROBE == 7 ? 2 : 1); ++rp_) { FRESH(); pg8::EpiBrChain e{c.mb(), c.P()};
                pg8::StaticOrder S_; S_.init(SEQ, DM, (int)gridDim.x, (int)blockIdx.x); pg8::Unit u_;
                for (int ui_ = 0; S_.next(ui_, u_); ++ui_) {
                    pg8::OneUnit O_{u_}; f32x4 acc_[2][2][4][2];
                    { pg8::Gemm g_{c.oa(), wl + O_BRA, SEQ, DM, 1024, DM, DM}; pg8::gemm_phase_core<pg8::EpiBrChain, pg8::OneUnit, false, true>(ldsL, g_, O_, e, tid_, acc_); }
                    e.scale<0>(acc_, u_, tid_);
                    { pg8::Gemm g_{c.ob(), wl + O_BRA + 1024, SEQ, DM, 512, DM, DM}; pg8::gemm_phase_core<pg8::EpiBrChain, pg8::OneUnit, true, true>(ldsL, g_, O_, e, tid_, acc_); }
                    e.scale<1>(acc_, u_, tid_);
                    { pg8::Gemm g_{c.oc(), wl + O_BRA + 1536, SEQ, DM, 512, DM, DM}; pg8::gemm_phase_core<pg8::EpiBrChain, pg8::OneUnit, true, false>(ldsL, g_, O_, e, tid_, acc_); }
                } }
            if (!lastl) { FRESH(); SEpiBr4 e{c.mb(), c.P()}; slab_gemm4(wid_k, lds, c.oa(), DM, wl + O_BRA, DM, SEQ, CTX, DM, DM, e); }
            SEAM(pb + 4);
        }
#if MK_FAST_GEMM
        if (IN(pb + 5)) { FRESH(); pg8::EpiRes e{l == 0 ? c.in[I_X] : c.h(), modx + 2 * DM, modc + 2 * DM, c.h()}; FASTG(c.mb(), wl + O_WO, SEQ, DM, DM, e); if (MK_PROBE == 8) { pg8::EpiRes e2{c.mf(), modx + 2 * DM, modc + 2 * DM, c.mf()}; FASTG(c.mb(), wl + O_WO, SEQ, DM, DM, e2); }
            if (!lastl) { SEpiRes4 es{c.h(), modx + 2 * DM, modc + 2 * DM, l == 0 ? c.in[I_CTX] - (size_t)SEQ * DM : c.h()}; slab_gemm4(wid_k, lds, c.mb(), DM, wl + O_WO, DM, SEQ, CTX, DM, DM, es); } SEAM(pb + 5); }
#else
        if (IN(pb + 5)) { FRESH(); SEpiRes e{c.h(), modx + 2 * DM, modc + 2 * DM, c.h()}; simple_gemm(wid_k, c.mb(), wl + O_WO, MT, DM, DM, e); SEAM(pb + 5); }
#endif
        if (IN(pb + 6)) { phase_norm(wid_k, l, 1); if (MK_PROBE == 4) phase_norm(wid_k, l, 1); SEAM(pb + 6); }
#if MK_FAST_GEMM
        if (IN(pb + 7)) { FRESH(); pg8::EpiUp e{c.act(), c.edge(), c.in[I_CONVW] + (size_t)l * 3 * DUP, c.in[I_CONVB] + (size_t)l * DUP}; FASTG(c.u(), wl + O_WUP, (lastl ? SEQ : MT), DUP, DM, e); if (MK_PROBE == 6) FASTG(c.u(), wl + O_WUP, (lastl ? SEQ : MT), DUP, DM, e); SEAM(pb + 7); }
#else
        if (IN(pb + 7)) { FRESH(); SEpiY e{c.Y()}; simple_gemm(wid_k, c.u(), wl + O_WUP, MT, DUP, DM, e); SEAM(pb + 7); }
#endif
#if MK_FAST_GEMM
        if (IN(pb + 8)) { phase_convfix(wid_k, l); if (MK_PROBE == 3) phase_convfix(wid_k, l); SEAM(pb + 8); }
#else
        if (IN(pb + 8)) { phase_conv(wid_k, l); SEAM(pb + 8); }
#endif
#if MK_FAST_GEMM
        if (IN(pb + 9)) { FRESH(); pg8::EpiRes e{c.h(), modx + 5 * DM, modc + 5 * DM, lastl ? c.out : c.h()}; FASTG(c.act(), wl + O_WDN, SEQ, DM, DFF, e); if (MK_PROBE == 9) { pg8::EpiRes e2{c.mf(), modx + 5 * DM, modc + 5 * DM, c.mf()}; FASTG(c.act(), wl + O_WDN, SEQ, DM, DFF, e2); }
            if (!lastl) { SEpiRes4 es{c.h(), modx + 5 * DM, modc + 5 * DM, c.h()}; slab_gemm4(wid_k, lds, c.act(), DFF, wl + O_WDN, DFF, SEQ, CTX, DM, DFF, es); SEAM(pb + 9); } }
#else
        if (IN(pb + 9)) { FRESH(); SEpiRes e{c.h(), modx + 5 * DM, modc + 5 * DM, c.h()}; simple_gemm(wid_k, c.act(), wl + O_WDN, MT, DM, DFF, e); SEAM(pb + 9); }
#endif
#undef FASTG
#undef FRESH
    }
#if !MK_FAST_GEMM
    if (IN(PH_FINAL)) phase_copy_out(wid_k);
#endif
#undef IN
#undef SEAM
}

extern "C" void kernel_launch(void* const* d_in, const int* in_sizes, int n_in, void* d_out, int out_size, void* d_ws, size_t ws_size, hipStream_t stream) {
    static int grid = 0;
    if (grid == 0) {
        if (n_in != 29 || out_size != SEQ * DM || ws_size < WS_END) { fprintf(stderr, "kernel_launch: unexpected shapes: n_in %d out %d ws %zu (need %zu)\n", n_in, out_size, ws_size, (size_t)WS_END); grid = -1; return; }
        int dev = 0, cus = 0, per_cu = 0;
        if (hipGetDevice(&dev) != hipSuccess || hipDeviceGetAttribute(&cus, hipDeviceAttributeMultiprocessorCount, dev) != hipSuccess) { grid = -1; return; }
        if (hipFuncSetAttribute((const void*)fwd, hipFuncAttributeMaxDynamicSharedMemorySize, LDS_BYTES) != hipSuccess) { fprintf(stderr, "kernel_launch: hipFuncSetAttribute failed\n"); grid = -1; return; }
        if (hipOccupancyMaxActiveBlocksPerMultiprocessor(&per_cu, (const void*)fwd, 512, LDS_BYTES) != hipSuccess || per_cu < 1) fprintf(stderr, "kernel_launch: occupancy query reports %d\n", per_cu);
        (void)hipGetLastError();
        grid = cus;
    }
    if (grid < 0) return;
    (void)hipMemsetAsync((char*)d_ws + WS_CTL, 0, CTL_BYTES, stream);
    Args a{};
    for (int i = 0; i < 29; ++i) a.in[i] = (const float*)d_in[i];
    a.out = (float*)d_out; a.ws = (unsigned char*)d_ws;
#if MK_ONE_LAUNCH
    a.ph_lo = 0; a.ph_hi = N_PHASES;
    hipLaunchKernelGGL(fwd, dim3(grid), dim3(512), LDS_BYTES, stream, a);
#else
    for (int p = 0; p < N_PHASES; ++p) { a.ph_lo = p; a.ph_hi = p + 1; hipLaunchKernelGGL(fwd, dim3(grid), dim3(512), LDS_BYTES, stream, a); }
#endif
    const hipError_t le = hipPeekAtLastError();
    if (le != hipSuccess) fprintf(stderr, "kernel_launch: launch failed: %s\n", hipGetErrorName(le));
}
```

```cpp
#include <hip/hip_runtime.h>
#include <cstdio>
#include <cstdint>
#include <cstddef>

#define LAS __attribute__((address_space(3)))
typedef unsigned short bf16_t;
typedef short bf16x8 __attribute__((ext_vector_type(8)));
typedef short s16x4 __attribute__((ext_vector_type(4)));
typedef float f32x4 __attribute__((ext_vector_type(4)));
typedef float f32x16 __attribute__((ext_vector_type(16)));
typedef unsigned u32x4 __attribute__((ext_vector_type(4)));
typedef unsigned u32x2 __attribute__((ext_vector_type(2)));

#ifndef MK_FAST_GEMM
#define MK_FAST_GEMM 1
#endif
#ifndef MK_PROBE
#define MK_PROBE 0
#endif
#ifndef MK_ATT_VARIANT
#define MK_ATT_VARIANT 0
#endif
#ifndef MK_GATE_FP8
#define MK_GATE_FP8 1
#endif
#ifndef MK_ATT_1BAR
#define MK_ATT_1BAR 1
#endif
#ifndef MK_ONE_LAUNCH
#define MK_ONE_LAUNCH 1
#endif

constexpr int DM = 2048, SEQ = 8192, CTX = 256, MT = SEQ + CTX, DEPTH = 4;
constexpr int DIN = 10752, DFF = 5504, DUP = 2 * DFF, NMOD = 6 * DM;
constexpr int RW = 3328;
constexpr int C_QA = 0, C_KA = 1024, C_VA = 1280, C_QB = 1536, C_KB = 2048, C_VB = 2560, C_QC = 3072, C_KC = 3584, C_VC = 4096, C_G = 4608;
constexpr float EPS = 1e-6f;

constexpr size_t O_WIN = 0, O_BRA = O_WIN + (size_t)DIN * DM, O_BRB = O_BRA + (size_t)DM * 1024, O_BRC = O_BRB + (size_t)DM * 512,
                 O_WO = O_BRC + (size_t)DM * 512, O_WUP = O_WO + (size_t)DM * DM, O_WDN = O_WUP + (size_t)DUP * DM, LAYER_ELEMS = O_WDN + (size_t)DM * DFF;

constexpr size_t al256(size_t x) { return (x + 255) / 256 * 256; }
constexpr size_t WS_CTL = 0, CTL_BYTES = 65536;
constexpr size_t WS_MOD = WS_CTL + CTL_BYTES;
constexpr size_t WS_LAM = al256(WS_MOD + (size_t)DEPTH * 2 * NMOD * 4);
constexpr size_t WS_H = al256(WS_LAM + 256);
constexpr size_t WS_U = al256(WS_H + (size_t)MT * DM * 4);
constexpr size_t WS_WT = al256(WS_U + (size_t)MT * DM * 2);
constexpr size_t WS_P = al256(WS_WT + (size_t)DEPTH * LAYER_ELEMS * 2);
constexpr size_t WS_R = al256(WS_P + (size_t)MT * DIN * 2);
constexpr size_t WS_U8 = WS_R;
constexpr size_t WS_WG8 = al256(WS_U8 + (size_t)MT * DM);
constexpr int NGATE = 3 * DM;
static_assert(WS_WG8 + (size_t)DEPTH * NGATE * DM <= WS_R + (size_t)MT * RW * 4, "fp8 buffers fit the R region");
constexpr size_t WS_OA = al256(WS_R + (size_t)MT * RW * 4);
constexpr size_t WS_OB = al256(WS_OA + (size_t)MT * 1024 * 2);
constexpr size_t WS_OC = al256(WS_OB + (size_t)MT * 512 * 2);
constexpr size_t WS_OCS = al256(WS_OC + (size_t)MT * 512 * 2);
constexpr size_t WS_MF = al256(WS_OCS + (size_t)MT * 512 * 4);
constexpr size_t WS_MB = al256(WS_MF + (size_t)MT * DM * 4);
constexpr size_t WS_PEND = al256(WS_MB + (size_t)MT * DM * 2);
constexpr size_t WS_Y = WS_P;
static_assert(WS_Y + (size_t)MT * DUP * 4 <= WS_PEND, "Y alias");
constexpr int NBLK64 = MT / 64;
constexpr size_t WS_EDGE = WS_P;
constexpr size_t WS_ACT = WS_PEND;
constexpr size_t WS_END = al256(WS_ACT + (size_t)MT * DFF * 2);

constexpr int LDS_BYTES = 147456;

__device__ __forceinline__ unsigned cvt_pk_bf16(float lo, float hi) { unsigned r; asm volatile("s_nop 0\n\tv_cvt_pk_bf16_f32 %0, %1, %2" : "=v"(r) : "v"(lo), "v"(hi)); return r; }
__device__ __forceinline__ bf16_t f2bf(float x) { return (bf16_t)(cvt_pk_bf16(x, 0.f) & 0xffffu); }
__device__ __forceinline__ float sat8(float x) { return __builtin_amdgcn_fmed3f(x, -448.0f, 448.0f); }
__device__ __forceinline__ unsigned pk4_fp8(float a, float b, float c, float d) { unsigned w = __builtin_amdgcn_cvt_pk_fp8_f32(sat8(a), sat8(b), 0u, false); return __builtin_amdgcn_cvt_pk_fp8_f32(sat8(c), sat8(d), w, true); }
__device__ __forceinline__ float bf2f(bf16_t b) { return __uint_as_float(((unsigned)b) << 16); }
template <int O> __device__ __forceinline__ float swz_xor(float v) { return __int_as_float(__builtin_amdgcn_ds_swizzle(__float_as_int(v), (O << 10) | 0x1f)); }
__device__ __forceinline__ float half_sum(float v) { v += swz_xor<16>(v); v += swz_xor<8>(v); v += swz_xor<4>(v); v += swz_xor<2>(v); v += swz_xor<1>(v); return v; }
__device__ __forceinline__ float wave_sum(float v) {
    v = half_sum(v);
    auto rr = __builtin_amdgcn_permlane32_swap(__float_as_uint(v), __float_as_uint(v), false, false);
    return __uint_as_float(rr[0]) + __uint_as_float(rr[1]);
}
__device__ __forceinline__ float wave_max(float v) {
    v = fmaxf(v, swz_xor<16>(v)); v = fmaxf(v, swz_xor<8>(v)); v = fmaxf(v, swz_xor<4>(v)); v = fmaxf(v, swz_xor<2>(v)); v = fmaxf(v, swz_xor<1>(v));
    auto rr = __builtin_amdgcn_permlane32_swap(__float_as_uint(v), __float_as_uint(v), false, false);
    return fmaxf(__uint_as_float(rr[0]), __uint_as_float(rr[1]));
}
__device__ __forceinline__ float vmax_abs(const float* v, int n, int lane) {
    float m = 0.f; for (int i = lane; i < n; i += 64) m = fmaxf(m, fabsf(v[i]));
    return __uint_as_float(__builtin_amdgcn_readfirstlane(__float_as_uint(wave_max(m))));
}
__device__ __forceinline__ float siluf(float x) { return x * __builtin_amdgcn_rcpf(1.0f + __builtin_amdgcn_exp2f(x * -1.4426950408889634f)); }
__device__ __forceinline__ float sigmoidf(float x) { return __builtin_amdgcn_rcpf(1.0f + __builtin_amdgcn_exp2f(x * -1.4426950408889634f)); }

__device__ __forceinline__ int tid_of(int wid_k) { int z; asm volatile("s_mov_b32 %0, 0" : "=s"(z)); return wid_k * 64 + (int)__builtin_amdgcn_mbcnt_hi(~0u, __builtin_amdgcn_mbcnt_lo(~0u, (unsigned)z)); }

#define XB_TMO      128
#define XB_XCNT(j)  (256  + 64 * (j))
#define XB_XSUB(j)  (1280 + 64 * (j))
#define XB_XGEN(j)  (2304 + 64 * (j))
#define XB_TOP      3328
#define XB_TOPGEN   3392
#define XCD_BAR_WORDS 3456
#define XB_SPIN_CAP (1u << 18)
__device__ __forceinline__ unsigned xb_ld(unsigned* p)              { return __hip_atomic_load(p, __ATOMIC_RELAXED, __HIP_MEMORY_SCOPE_AGENT); }
__device__ __forceinline__ unsigned xb_add(unsigned* p, unsigned v) { return __hip_atomic_fetch_add(p, v, __ATOMIC_RELAXED, __HIP_MEMORY_SCOPE_AGENT); }
__device__ __forceinline__ unsigned xb_xcc_id() { return (unsigned)__builtin_amdgcn_s_getreg((3 << 11) | 20) & 0xFu; }
#define XB_SPIN(cond, bar) do { unsigned _sp = 0; while (cond) { __builtin_amdgcn_s_sleep(1); \
    if ((++_sp & 255u) == 0u) { if (xb_ld(&(bar)[XB_TMO])) break; if (_sp > XB_SPIN_CAP) { atomicAdd(&(bar)[XB_TMO], 1u); break; } } } } while (0)
struct XcdBarrier { unsigned* bar; unsigned x; volatile LAS unsigned* st; };
__device__ __forceinline__ XcdBarrier xcd_barrier_post(unsigned* bar, volatile LAS unsigned* st, int tid) {
    XcdBarrier b; b.bar = bar; b.x = xb_xcc_id(); b.st = st;
    if (tid == 0) (void)xb_add(&bar[XB_XCNT(b.x)], 1u);
    return b;
}
__device__ __forceinline__ void xcd_barrier_complete(unsigned* bar, unsigned x, unsigned& nloc, unsigned& nx) {
    const unsigned G = gridDim.x * gridDim.y * gridDim.z;
    unsigned sum, cnt, mine, sp = 0u;
    for (;;) {
        sum = 0u; cnt = 0u; mine = 0u;
#pragma unroll
        for (unsigned j = 0; j < 16; ++j) { const unsigned c = xb_ld(&bar[XB_XCNT(j)]); sum += c; cnt += (c > 0u) ? 1u : 0u; }
        mine = xb_ld(&bar[XB_XCNT(x)]);
        if (sum == G) break;
        __builtin_amdgcn_s_sleep(1);
        if ((++sp & 255u) == 0u) { if (xb_ld(&bar[XB_TMO])) break; if (sp > XB_SPIN_CAP) { atomicAdd(&bar[XB_TMO], 1u); break; } }
    }
    nloc = mine > 0u ? mine : 1u; nx = cnt > 0u ? cnt : 1u;
}
__device__ __forceinline__ void xcd_barrier(const XcdBarrier& b, int tid) {
    asm volatile("s_waitcnt vmcnt(0)" ::: "memory");
    __syncthreads();
    if (tid == 0) {
        unsigned* bar = b.bar;
        __builtin_amdgcn_s_waitcnt(0);
        unsigned nloc = b.st[0], nx = b.st[1];
        if (nloc == 0u) { xcd_barrier_complete(bar, b.x, nloc, nx); b.st[0] = nloc; b.st[1] = nx; }
        const unsigned old = xb_add(&bar[XB_XSUB(b.x)], 1u);
        const unsigned gen = old / nloc;
        if (old + 1u == (gen + 1u) * nloc) {
            __builtin_amdgcn_fence(__ATOMIC_RELEASE, "agent");
            asm volatile("s_waitcnt vmcnt(0)" ::: "memory");
            const unsigned og = xb_add(&bar[XB_TOP], 1u);
            const unsigned tg = og / nx;
            if (og + 1u == (tg + 1u) * nx) xb_add(&bar[XB_TOPGEN], 1u);
            else XB_SPIN(xb_ld(&bar[XB_TOPGEN]) == tg, bar);
            __builtin_amdgcn_fence(__ATOMIC_ACQUIRE, "agent");
            xb_add(&bar[XB_XGEN(b.x)], 1u);
            asm volatile("s_waitcnt vmcnt(0)" ::: "memory");
        } else {
            XB_SPIN(xb_ld(&bar[XB_XGEN(b.x)]) == gen, bar);
            __builtin_amdgcn_fence(__ATOMIC_ACQUIRE, "agent");
            asm volatile("s_waitcnt vmcnt(0)" ::: "memory");
        }
    }
    __syncthreads();
}

template <class T> __device__ __forceinline__ T* launder_uniform(T* p) {
    const unsigned long long v = (unsigned long long)p; unsigned lo = (unsigned)v, hi = (unsigned)(v >> 32);
    asm volatile("" : "+v"(lo), "+v"(hi));
    lo = __builtin_amdgcn_readfirstlane(lo); hi = __builtin_amdgcn_readfirstlane(hi);
    return (T*)(((unsigned long long)hi << 32) | lo);
}
struct Args { const float* in[29]; float* out; unsigned char* ws; int ph_lo, ph_hi; };
enum { I_X = 0, I_C, I_CTX, I_CCTX, I_WMOD, I_BMOD, I_GN1, I_WIN, I_GQA, I_GKA, I_GQB, I_GKB, I_RPB, I_GQC, I_GKC, I_LQ1, I_LK1, I_LQ2, I_LK2, I_GSUB,
       I_WBRA, I_WBRB, I_WBRC, I_WO, I_GN2, I_WUP, I_CONVW, I_CONVB, I_WDN };
struct Ctx {
    const float* const* in; float* out; unsigned char* ws;
    __device__ __forceinline__ float* mod() const { return (float*)(ws + WS_MOD); }
    __device__ __forceinline__ float* lam() const { return (float*)(ws + WS_LAM); }
    __device__ __forceinline__ float* h() const { return (float*)(ws + WS_H); }
    __device__ __forceinline__ bf16_t* u() const { return (bf16_t*)(ws + WS_U); }
    __device__ __forceinline__ bf16_t* wt() const { return (bf16_t*)(ws + WS_WT); }
    __device__ __forceinline__ bf16_t* P() const { return (bf16_t*)(ws + WS_P); }
    __device__ __forceinline__ float* R() const { return (float*)(ws + WS_R); }
    __device__ __forceinline__ bf16_t* oa() const { return (bf16_t*)(ws + WS_OA); }
    __device__ __forceinline__ bf16_t* ob() const { return (bf16_t*)(ws + WS_OA) + 1024; }
    __device__ __forceinline__ bf16_t* oc() const { return (bf16_t*)(ws + WS_OA) + 1536; }
    __device__ __forceinline__ float* ocs() const { return (float*)(ws + WS_OCS); }
    __device__ __forceinline__ float* mf() const { return (float*)(ws + WS_MF); }
    __device__ __forceinline__ bf16_t* mb() const { return (bf16_t*)(ws + WS_MB); }
    __device__ __forceinline__ float* Y() const { return (float*)(ws + WS_Y); }
    __device__ __forceinline__ float* edge() const { return (float*)(ws + WS_EDGE); }
    __device__ __forceinline__ bf16_t* act() const { return (bf16_t*)(ws + WS_ACT); }
};
__device__ __forceinline__ unsigned long long kernarg_u64(int off) {
    unsigned long long v; auto kp = __builtin_amdgcn_kernarg_segment_ptr();
    asm volatile("s_load_dwordx2 %0, %1, %2\n\ts_waitcnt lgkmcnt(0)" : "=s"(v) : "s"(kp), "i"(off));
    return v;
}
__device__ __forceinline__ Ctx make_ctx() {
    Ctx c; c.in = (const float* const*)__builtin_amdgcn_kernarg_segment_ptr();
    c.out = (float*)kernarg_u64(29 * 8); c.ws = (unsigned char*)kernarg_u64(30 * 8);
    return c;
}
#define PHASE_ENTER(cin) Ctx c = make_ctx(); int tid_ = tid_of(wid_k);

__device__ __forceinline__ int win_src_col(int j) {
    if (j < C_VA) { const int s = j & 127, hb = j - s, grp = s >> 6, sp = s & 63, i = sp >> 3, jj = sp & 7; return hb + 64 * grp + (jj < 4 ? 4 * i + jj : 32 + 4 * i + (jj - 4)); }
    if (j >= C_QC && j < C_VC) { const int s = j & 63, hb = j - s, grp = s >> 5, sp = s & 31, i = sp >> 3, jj = sp & 7; return hb + 32 * grp + (jj < 4 ? 4 * i + jj : 16 + 4 * i + (jj - 4)); }
    return j;
}
__device__ __forceinline__ int wup_src_col(int j) { const int pn = j >> 8, bj = (j >> 7) & 1, s = j & 127; return bj * DFF + 128 * pn + s; }

constexpr int T_WIN = (DIN / 256) * (DM / 64), T_BRA = (DM / 256) * (1024 / 64), T_BRB = (DM / 256) * (512 / 64), T_WO = (DM / 256) * (DM / 64), T_WUP = (DUP / 256) * (DM / 64), T_WDN = (DM / 256) * (DFF / 64);
constexpr int T_LAYER = T_WIN + T_BRA + 2 * T_BRB + T_WO + T_WUP + T_WDN;
#ifndef MK_CONV_NDEF
#define MK_CONV_NDEF 3848
#endif
#ifndef MK_CONV_NUP
#define MK_CONV_NUP 1536
#endif
constexpr int CONV_NDEF = MK_CONV_NDEF, CONV_CHUNK = 8, CONV_NP = T_LAYER + (DEPTH - 1) * (T_LAYER - CONV_NDEF), CONV_NATT = CONV_NDEF - MK_CONV_NUP;
static_assert(MK_CONV_NUP >= 0 && MK_CONV_NUP <= MK_CONV_NDEF && MK_CONV_NUP % 8 == 0, "w_up share of the deferred tiles");
static_assert(CONV_NDEF >= 0 && CONV_NDEF < T_LAYER && CONV_NDEF % CONV_CHUNK == 0, "deferred tile count");
__device__ __forceinline__ void conv_run(const Ctx& c, char* lds, int tid, int p0, int pend, int pstep, int mode, int L) {
        asm volatile("" : "+v"(tid));
        float* tile = (float*)lds;
        struct WD { const float* src; bf16_t* dst; int K, N, kind, ldd, l, j0, k0; };
#define WDEC(t_, d_) do { const int l_ = (t_) / T_LAYER; int r_ = (t_) % T_LAYER; bf16_t* wl_ = c.wt() + (size_t)l_ * LAYER_ELEMS; d_.l = l_; d_.kind = 0; d_.ldd = 0; \
            if (r_ < T_WIN) { d_.src = c.in[I_WIN] + (size_t)l_ * DM * DIN; d_.dst = wl_ + O_WIN; d_.K = DM; d_.N = DIN; d_.kind = 1; } \
            else if ((r_ -= T_WIN) < T_BRA) { d_.src = c.in[I_WBRA] + (size_t)l_ * 1024 * DM; d_.dst = wl_ + O_BRA; d_.K = 1024; d_.N = DM; d_.ldd = DM; }             \
            else if ((r_ -= T_BRA) < T_BRB) { d_.src = c.in[I_WBRB] + (size_t)l_ * 512 * DM; d_.dst = wl_ + O_BRA + 1024; d_.K = 512; d_.N = DM; d_.ldd = DM; }      \
            else if ((r_ -= T_BRB) < T_BRB) { d_.src = c.in[I_WBRC] + (size_t)l_ * 512 * DM; d_.dst = wl_ + O_BRA + 1536; d_.K = 512; d_.N = DM; d_.ldd = DM; }      \
            else if ((r_ -= T_BRB) < T_WO) { d_.src = c.in[I_WO] + (size_t)l_ * DM * DM; d_.dst = wl_ + O_WO; d_.K = DM; d_.N = DM; } \
            else if ((r_ -= T_WO) < T_WUP) { d_.src = c.in[I_WUP] + (size_t)l_ * DM * DUP; d_.dst = wl_ + O_WUP; d_.K = DM; d_.N = DUP; d_.kind = 2; } \
            else { r_ -= T_WUP; d_.src = c.in[I_WDN] + (size_t)l_ * DFF * DM; d_.dst = wl_ + O_WDN; d_.K = DFF; d_.N = DM; } \
            const int nkt_ = d_.K / 64; d_.j0 = (r_ / nkt_) * 256; d_.k0 = (r_ % nkt_) * 64; } while (0)
#define WLOAD(d_) do { _Pragma("unroll") for (int s = 0; s < 4; ++s) { const int j = d_.j0 + 64 * s + j4; const int sc = d_.kind == 1 ? win_src_col(j) : (d_.kind == 2 ? wup_src_col(j) : j); \
            _Pragma("unroll") for (int i = 0; i < 2; ++i) v[s][i] = *(const f32x4*)(d_.src + (size_t)(d_.k0 + (tid >> 4) + 32 * i) * d_.N + sc); } } while (0)
        const int j4 = (tid & 15) * 4; f32x4 v[4][2];
#define TMAP(p_) (mode ? L * T_LAYER + (p_) : ((p_) < T_LAYER ? (p_) : (1 + ((p_) - T_LAYER) / (T_LAYER - CONV_NDEF)) * T_LAYER + CONV_NDEF + ((p_) - T_LAYER) % (T_LAYER - CONV_NDEF)))
        WD cur, nxt; int p = p0;
        if (p < pend) { const int t = TMAP(p); WDEC(t, cur); WLOAD(cur); }
        for (; p < pend; p += pstep) {
#pragma unroll
            for (int s = 0; s < 4; ++s)
#pragma unroll
                for (int i = 0; i < 2; ++i) { float* tp = tile + s * (64 * 65) + ((tid >> 4) + 32 * i) * 65 + j4; tp[0] = v[s][i][0]; tp[1] = v[s][i][1]; tp[2] = v[s][i][2]; tp[3] = v[s][i][3]; }
            __syncthreads();
            nxt = cur;
            if (p + pstep < pend) { const int t = TMAP(p + pstep); WDEC(t, nxt); WLOAD(nxt); }
            {
                const int jj = tid >> 3, kk = (tid & 7) * 8;
#pragma unroll
                for (int s = 0; s < 4; ++s) { const float* ts = tile + s * (64 * 65);
                    if (MK_GATE_FP8 && MK_FAST_GEMM && cur.kind == 1 && cur.j0 + 64 * s >= C_G) {
                        u32x2 w8;
                        w8.x = pk4_fp8(ts[(kk + 0) * 65 + jj] * 32.f, ts[(kk + 1) * 65 + jj] * 32.f, ts[(kk + 2) * 65 + jj] * 32.f, ts[(kk + 3) * 65 + jj] * 32.f);
                        w8.y = pk4_fp8(ts[(kk + 4) * 65 + jj] * 32.f, ts[(kk + 5) * 65 + jj] * 32.f, ts[(kk + 6) * 65 + jj] * 32.f, ts[(kk + 7) * 65 + jj] * 32.f);
                        *(u32x2*)(c.ws + WS_WG8 + ((size_t)cur.l * NGATE + (cur.j0 + 64 * s + jj - C_G)) * DM + cur.k0 + kk) = w8;
                        continue; }
                    u32x4 w;
                    w.x = cvt_pk_bf16(ts[(kk + 0) * 65 + jj], ts[(kk + 1) * 65 + jj]); w.y = cvt_pk_bf16(ts[(kk + 2) * 65 + jj], ts[(kk + 3) * 65 + jj]);
                    w.z = cvt_pk_bf16(ts[(kk + 4) * 65 + jj], ts[(kk + 5) * 65 + jj]); w.w = cvt_pk_bf16(ts[(kk + 6) * 65 + jj], ts[(kk + 7) * 65 + jj]);
                    *(u32x4*)(cur.dst + (size_t)(cur.j0 + 64 * s + jj) * (cur.ldd ? cur.ldd : cur.K) + cur.k0 + kk) = w; }
            }
            __syncthreads();
            cur = nxt;
        }
#undef WDEC
#undef WLOAD
#undef TMAP
}

__device__ __forceinline__ void phase_prologue(int wid_k, char* lds) {
    PHASE_ENTER(cin)
    const int tid = tid_, lane = tid & 63, wid = tid >> 6, G = gridDim.x, b = blockIdx.x;
    if (!MK_FAST_GEMM) {
        const f32x4* x4 = (const f32x4*)c.in[I_X]; const f32x4* c4 = (const f32x4*)c.in[I_CTX]; f32x4* h4 = (f32x4*)c.h();
        const size_t nx = (size_t)SEQ * DM / 4, nc = (size_t)CTX * DM / 4;
        for (size_t i = (size_t)b * 512 + tid; i < nx + nc; i += (size_t)G * 512) h4[i] = i < nx ? x4[i] : c4[i - nx];
    }
    if (b == 0 && wid < DEPTH) {
        const int l = wid;
        const float p1 = wave_sum(c.in[I_LQ1][l * 64 + lane] * c.in[I_LK1][l * 64 + lane]);
        const float p2 = wave_sum(c.in[I_LQ2][l * 64 + lane] * c.in[I_LK2][l * 64 + lane]);
        if (lane == 0) c.lam()[l] = expf(p1) - expf(p2) + (0.8f - 0.6f * expf(-0.3f * (float)l));
    }
    {
        float* sc0 = (float*)lds; float* sc1 = sc0 + DM; float* part = sc1 + DM;
        for (int k = tid; k < DM; k += 512) { sc0[k] = siluf(c.in[I_C][k]); sc1[k] = siluf(c.in[I_CCTX][k]); }
        __syncthreads();
        for (int blk = b; blk < DEPTH * NMOD / 64; blk += G) {
            const int l = blk / (NMOD / 64), j = (blk % (NMOD / 64)) * 64 + lane;
            const float* w = c.in[I_WMOD] + (size_t)l * DM * NMOD + j;
            float a0 = 0.f, a1 = 0.f;
            const int kb = wid * 256;
#pragma unroll 32
            for (int k = 0; k < 256; ++k) { const float wv = w[(size_t)(kb + k) * NMOD]; a0 += sc0[kb + k] * wv; a1 += sc1[kb + k] * wv; }
            part[(wid * 64 + lane) * 2 + 0] = a0; part[(wid * 64 + lane) * 2 + 1] = a1;
            __syncthreads();
            if (wid < 2) {
                float s = c.in[I_BMOD][l * NMOD + j];
#pragma unroll
                for (int w8 = 0; w8 < 8; ++w8) s += part[(w8 * 64 + lane) * 2 + wid];
                c.mod()[((size_t)l * 2 + wid) * NMOD + j] = s;
            }
            __syncthreads();
        }
    }
    conv_run(c, lds, tid, b, CONV_NP, G, 0, 0);
}

__device__ __forceinline__ void phase_norm(int wid_k, int l, int which) {
    PHASE_ENTER(cin)
    const int lane = tid_ & 63, wid = tid_ >> 6;
    const float* g = c.in[which ? I_GN2 : I_GN1] + l * DM;
#define NORM_ROWPTR(r_) ((MK_FAST_GEMM && l == 0 && which == 0) ? ((r_) < SEQ ? c.in[I_X] + (size_t)(r_) * DM : c.in[I_CTX] + (size_t)((r_) - SEQ) * DM) : c.h() + (size_t)(r_) * DM)
    const int row0 = blockIdx.x * 8 + wid, rstep = gridDim.x * 8;
    f32x4 v[8], vn[8];
    if (row0 < MT) { const float* hr = NORM_ROWPTR(row0);
#pragma unroll
        for (int i = 0; i < 8; ++i) v[i] = *(const f32x4*)(hr + i * 256 + lane * 4); }
    for (int row = row0; row < MT; row += rstep) {
        if (row + rstep < MT) { const float* hn = NORM_ROWPTR(row + rstep);
#pragma unroll
            for (int i = 0; i < 8; ++i) vn[i] = *(const f32x4*)(hn + i * 256 + lane * 4); }
        const float* md = c.mod() + ((size_t)l * 2 + (row >= SEQ ? 1 : 0)) * NMOD;
        const float* sh = md + (which ? 3 : 0) * DM; const float* sc = md + (which ? 4 : 1) * DM;
        float ss = 0.f;
#pragma unroll
        for (int i = 0; i < 8; ++i) ss += v[i][0] * v[i][0] + v[i][1] * v[i][1] + v[i][2] * v[i][2] + v[i][3] * v[i][3];
        ss = wave_sum(ss);
        const float rstd = __builtin_amdgcn_rsqf(ss * (1.0f / DM) + EPS);
#pragma unroll
        for (int i = 0; i < 8; ++i) {
            const int col = i * 256 + lane * 4;
            const f32x4 gg = *(const f32x4*)(g + col), s1 = *(const f32x4*)(sc + col), s0 = *(const f32x4*)(sh + col);
            f32x4 o;
#pragma unroll
            for (int e = 0; e < 4; ++e) o[e] = (v[i][e] * rstd * gg[e]) * (1.0f + s1[e]) + s0[e];
            u32x2 w; w.x = cvt_pk_bf16(o[0], o[1]); w.y = cvt_pk_bf16(o[2], o[3]);
            *(u32x2*)(c.u() + (size_t)row * DM + col) = w;
            if (MK_GATE_FP8 && MK_FAST_GEMM && which == 0) *(unsigned*)(c.ws + WS_U8 + (size_t)row * DM + col) = pk4_fp8(o[0], o[1], o[2], o[3]);
        }
#pragma unroll
        for (int i = 0; i < 8; ++i) v[i] = vn[i];
    }
#undef NORM_ROWPTR
}

__device__ __forceinline__ void rope_cs(float pos, int f, float inv_nf, float& cs, float& sn) {
    const float inv = __builtin_amdgcn_exp2f(-(float)f * inv_nf * 13.287712379549449f);
    const float ang = pos * inv;
    float rev = ang * 0.15915494309189535f; rev -= floorf(rev);
    cs = __builtin_amdgcn_cosf(rev); sn = __builtin_amdgcn_sinf(rev);
}
__device__ __forceinline__ void phase_qknorm(int wid_k, int l) {
    PHASE_ENTER(cin)
    const int lane = tid_ & 63, wid = tid_ >> 6;
    const int i = lane >> 2, j = lane & 3;
    const long nitems = (long)MT * 26;
    for (long it = (long)blockIdx.x * 8 + wid; it < nitems; it += (long)gridDim.x * 8) {
        const int row = (int)(it / 26), g = (int)(it % 26);
        const int rc = g * 128, pc = rc < 1280 ? rc : (rc < 2304 ? rc + 256 : rc + 768);
        const float* rp = c.R() + (size_t)row * RW + rc;
        const float x1 = rp[8 * i + j], x2 = rp[8 * i + 4 + j];
        float ss = x1 * x1 + x2 * x2;
        int type; const float* gv;
        if (g < 8) { type = 0; gv = c.in[I_GQA] + l * 128; } else if (g < 10) { type = 0; gv = c.in[I_GKA] + l * 128; }
        else if (g < 14) { type = 1; gv = c.in[I_GQB] + l * 128; } else if (g < 18) { type = 1; gv = c.in[I_GKB] + l * 128; }
        else if (g < 22) { type = 2; gv = c.in[I_GQC] + l * 64; } else { type = 2; gv = c.in[I_GKC] + l * 64; }
        ss = half_sum(ss);
        if (type != 2) { auto rr = __builtin_amdgcn_permlane32_swap(__float_as_uint(ss), __float_as_uint(ss), false, false); ss = __uint_as_float(rr[0]) + __uint_as_float(rr[1]); }
        const float rstd = 1.0f / sqrtf(ss * (type == 2 ? 1.0f / 64.0f : 1.0f / 128.0f) + EPS);
        float y1, y2;
        if (type == 1) { y1 = x1 * rstd * gv[8 * i + j]; y2 = x2 * rstd * gv[8 * i + 4 + j]; }
        else {
            int d1, d2, f; float inv_nf; int grp;
            if (type == 0) { grp = i >> 3; f = 4 * (i & 7) + j; d1 = 64 * grp + f; d2 = d1 + 32; inv_nf = 1.0f / 32.0f; }
            else { const int ip = i & 7; grp = ip >> 2; f = 4 * (ip & 3) + j; d1 = 32 * grp + f; d2 = d1 + 16; inv_nf = 1.0f / 16.0f; }
            y1 = x1 * rstd * gv[d1]; y2 = x2 * rstd * gv[d2];
            if (row < SEQ) {
                const float pos = (float)(grp ? (row & 63) : (row >> 6));
                float cs, sn; rope_cs(pos, f, inv_nf, cs, sn);
                const float o1 = y1 * cs - y2 * sn, o2 = y2 * cs + y1 * sn; y1 = o1; y2 = o2;
            }
        }
        const float qs = (g < 8 || (g >= 10 && g < 14)) ? 0.12751743f : ((g >= 18 && g < 22) ? 0.18033688f : 1.0f);
        bf16_t* pp = c.P() + (size_t)row * DIN + pc;
        pp[8 * i + j] = f2bf(y1 * qs); pp[8 * i + 4 + j] = f2bf(y2 * qs);
    }
}

__device__ __forceinline__ void phase_conv(int wid_k, int l) {
    PHASE_ENTER(cin)
    const float* cw = c.in[I_CONVW] + (size_t)l * 3 * DUP; const float* cb = c.in[I_CONVB] + (size_t)l * DUP;
    const long n = (long)MT * DFF;
    for (long idx = (long)blockIdx.x * 512 + tid_; idx < n; idx += (long)gridDim.x * 512) {
        const int row = (int)(idx / DFF), col = (int)(idx % DFF);
        const int ya = 256 * (col >> 7) + (col & 127), yg = ya + 128;
        const bool up = (row != 0 && row != SEQ), dn = (row != SEQ - 1 && row != MT - 1);
        const float* y = c.Y() + (size_t)row * DUP;
        float ha = cb[col] + cw[DUP + col] * y[ya], hg = cb[DFF + col] + cw[DUP + DFF + col] * y[yg];
        if (up) { ha += cw[col] * y[ya - DUP]; hg += cw[DFF + col] * y[yg - DUP]; }
        if (dn) { ha += cw[2 * DUP + col] * y[ya + DUP]; hg += cw[2 * DUP + DFF + col] * y[yg + DUP]; }
        c.act()[idx] = f2bf(siluf(hg) * ha);
    }
}


__device__ __forceinline__ void phase_convfix(int wid_k, int l) {
    PHASE_ENTER(cin)
    const float* cw = c.in[I_CONVW] + (size_t)l * 3 * DUP; const float* cb = c.in[I_CONVB] + (size_t)l * DUP; const float* E = c.edge();
    const int nrows = (l == DEPTH - 1 ? SEQ / 64 : NBLK64) * 2;
    const long n = (long)nrows * (DFF / 4);
    for (long idx = (long)blockIdx.x * 512 + tid_; idx < n; idx += (long)gridDim.x * 512) {
        const int br = (int)(idx / (DFF / 4)), ch = (int)(idx % (DFF / 4)) * 4, b = br >> 1, lastrow = br & 1, row = 64 * b + (lastrow ? 63 : 0);
        const int ya = 256 * (ch >> 7) + (ch & 127), yg = ya + 128;
        const float* eb = E + (size_t)b * 4 * DUP;
        f32x4 ua = {0.f, 0.f, 0.f, 0.f}, ug = ua, da = ua, dg = ua, ma, mg;
        if (!lastrow) {
            if (row != 0 && row != SEQ) { ua = *(const f32x4*)(eb - DUP + ya); ug = *(const f32x4*)(eb - DUP + yg); }
            ma = *(const f32x4*)(eb + ya); mg = *(const f32x4*)(eb + yg); da = *(const f32x4*)(eb + DUP + ya); dg = *(const f32x4*)(eb + DUP + yg);
        } else {
            ua = *(const f32x4*)(eb + 2 * DUP + ya); ug = *(const f32x4*)(eb + 2 * DUP + yg); ma = *(const f32x4*)(eb + 3 * DUP + ya); mg = *(const f32x4*)(eb + 3 * DUP + yg);
            if (row != SEQ - 1 && row != MT - 1) { da = *(const f32x4*)(eb + 4 * DUP + ya); dg = *(const f32x4*)(eb + 4 * DUP + yg); }
        }
        const f32x4 wa0 = *(const f32x4*)(cw + ch), wa1 = *(const f32x4*)(cw + DUP + ch), wa2 = *(const f32x4*)(cw + 2 * DUP + ch), ba = *(const f32x4*)(cb + ch);
        const f32x4 wg0 = *(const f32x4*)(cw + DFF + ch), wg1 = *(const f32x4*)(cw + DUP + DFF + ch), wg2 = *(const f32x4*)(cw + 2 * DUP + DFF + ch), bg = *(const f32x4*)(cb + DFF + ch);
        f32x4 o;
#pragma unroll
        for (int e = 0; e < 4; ++e) { const float ha = ba[e] + wa0[e] * ua[e] + wa1[e] * ma[e] + wa2[e] * da[e], hg = bg[e] + wg0[e] * ug[e] + wg1[e] * mg[e] + wg2[e] * dg[e]; o[e] = siluf(hg) * ha; }
        u32x2 w; w.x = cvt_pk_bf16(o[0], o[1]); w.y = cvt_pk_bf16(o[2], o[3]);
        *(u32x2*)(c.act() + (size_t)row * DFF + ch) = w;
    }
}

__device__ __forceinline__ void phase_copy_out(int wid_k) {
    PHASE_ENTER(cin)
    const f32x4* h4 = (const f32x4*)c.h(); f32x4* o4 = (f32x4*)c.out; const size_t n = (size_t)SEQ * DM / 4;
    for (size_t i = (size_t)blockIdx.x * 512 + tid_; i < n; i += (size_t)gridDim.x * 512) o4[i] = h4[i];
}

template <class Epi>
__device__ __forceinline__ void simple_gemm(int wid_k, const bf16_t* A, const bf16_t* Bt, int M, int N, int K, const Epi& epi) {
    int tid_ = tid_of(wid_k); A = launder_uniform(A); Bt = launder_uniform(Bt);
    const int lane = tid_ & 63, wid = tid_ >> 6, wm = wid >> 2, wn = wid & 3, fr = lane & 15, fq = lane >> 4;
    const int ntn = N / 128, ntiles = (M / 128) * ntn;
    for (int t = blockIdx.x; t < ntiles; t += gridDim.x) {
        const int tm = t / ntn, tn = t % ntn, row0 = tm * 128 + wm * 64, col0 = tn * 128 + wn * 32;
        f32x4 acc[4][2];
#pragma unroll
        for (int m = 0; m < 4; ++m)
#pragma unroll
            for (int n = 0; n < 2; ++n) acc[m][n] = (f32x4){0.f, 0.f, 0.f, 0.f};
        const bf16_t* ap = A + (size_t)(row0 + fr) * K + fq * 8; const bf16_t* bp = Bt + (size_t)(col0 + fr) * K + fq * 8;
        for (int k0 = 0; k0 < K; k0 += 32) {
            bf16x8 a[4], b[2];
#pragma unroll
            for (int m = 0; m < 4; ++m) a[m] = *(const bf16x8*)(ap + (size_t)m * 16 * K + k0);
#pragma unroll
            for (int n = 0; n < 2; ++n) b[n] = *(const bf16x8*)(bp + (size_t)n * 16 * K + k0);
#pragma unroll
            for (int m = 0; m < 4; ++m)
#pragma unroll
                for (int n = 0; n < 2; ++n) acc[m][n] = __builtin_amdgcn_mfma_f32_16x16x32_bf16(a[m], b[n], acc[m][n], 0, 0, 0);
        }
#pragma unroll
        for (int m = 0; m < 4; ++m)
#pragma unroll
            for (int n = 0; n < 2; ++n)
#pragma unroll
                for (int j = 0; j < 4; ++j) epi(row0 + m * 16 + fq * 4 + j, col0 + n * 16 + fr, acc[m][n][j]);
    }
}

template <class Epi>
__device__ __forceinline__ void slab_gemm(int wid_k, const bf16_t* A, int lda, const bf16_t* Bt, int ldb, int row_base, int M, int N, int K, const Epi& epi) {
    int tid_ = tid_of(wid_k); A = launder_uniform(A); Bt = launder_uniform(Bt);
    const int lane = tid_ & 63, wid = tid_ >> 6, fr = lane & 15, fq = lane >> 4;
    const int ntn = N / 16, ntiles = (M / 128) * ntn;
    for (int t = blockIdx.x; t < ntiles; t += gridDim.x) {
        const int tm = t / ntn, tn = t % ntn, row0 = row_base + tm * 128 + wid * 16, col0 = tn * 16;
        f32x4 acc0 = {0.f, 0.f, 0.f, 0.f}, acc1 = acc0;
        const bf16_t* ap = A + (size_t)(row0 + fr) * lda + fq * 8; const bf16_t* bp = Bt + (size_t)(col0 + fr) * ldb + fq * 8;
#pragma unroll 8
        for (int k0 = 0; k0 < K; k0 += 64) {
            const bf16x8 a0 = *(const bf16x8*)(ap + k0), b0 = *(const bf16x8*)(bp + k0), a1 = *(const bf16x8*)(ap + k0 + 32), b1 = *(const bf16x8*)(bp + k0 + 32);
            acc0 = __builtin_amdgcn_mfma_f32_16x16x32_bf16(a0, b0, acc0, 0, 0, 0);
            acc1 = __builtin_amdgcn_mfma_f32_16x16x32_bf16(a1, b1, acc1, 0, 0, 0);
        }
#pragma unroll
        for (int j = 0; j < 4; ++j) epi(row0 + fq * 4 + j, col0 + fr, acc0[j] + acc1[j]);
    }
}

template <class Epi4>
__device__ __forceinline__ void slab_gemm4(int wid_k, char* lds, const bf16_t* A, int lda, const bf16_t* Bt, int ldb, int row_base, int M, int N, int K, const Epi4& epi) {
    int tid_ = tid_of(wid_k); A = launder_uniform(A); Bt = launder_uniform(Bt);
    const int lane = tid_ & 63, wid = __builtin_amdgcn_readfirstlane(tid_ >> 6), r32 = lane & 31, hi = lane >> 5, ch = wid & 1, kq = wid >> 1, kl = K >> 2;
    float* part = (float*)lds;
    const int ntn = N / 64, ntiles = (M / 32) * ntn;
    typedef const __attribute__((address_space(1))) bf16x8 gfrag;
    for (int t = blockIdx.x; t < ntiles; t += gridDim.x) {
        const int tm = t / ntn, tn = t % ntn, row0 = row_base + tm * 32, col0 = tn * 64 + ch * 32;
        const bf16_t* ap = A + (size_t)(row0 + r32) * lda + kq * kl + hi * 8; const bf16_t* bp = Bt + (size_t)(col0 + r32) * ldb + kq * kl + hi * 8;
        f32x16 acc = {};
        bf16x8 fa0[8], fb0[8], fa1[8], fb1[8];
#define SLAB_LD(FA, FB, kb_) do { _Pragma("unroll") for (int i = 0; i < 8; ++i) { const int kk_ = (kb_) + 16 * i; if (kk_ < kl) { FA[i] = *(gfrag*)(ap + kk_); FB[i] = *(gfrag*)(bp + kk_); } else { FA[i] = (bf16x8){0, 0, 0, 0, 0, 0, 0, 0}; FB[i] = FA[i]; } } } while (0)
#define SLAB_MM(FA, FB) do { _Pragma("unroll") for (int i = 0; i < 8; ++i) acc = __builtin_amdgcn_mfma_f32_32x32x16_bf16(FA[i], FB[i], acc, 0, 0, 0); } while (0)
        SLAB_LD(fa0, fb0, 0);
        for (int k0 = 0; k0 < kl; k0 += 256) {
            if (k0 + 128 < kl) SLAB_LD(fa1, fb1, k0 + 128);
            SLAB_MM(fa0, fb0);
            if (k0 + 256 < kl) SLAB_LD(fa0, fb0, k0 + 256);
            if (k0 + 128 < kl) SLAB_MM(fa1, fb1);
        }
#undef SLAB_LD
#undef SLAB_MM
        float* pw = part + ((kq * 2 + ch) * 32) * 32 + r32;
#pragma unroll
        for (int i = 0; i < 16; ++i) pw[((i & 3) + 8 * (i >> 2) + 4 * hi) * 32] = acc[i];
        __syncthreads();
#pragma unroll
        for (int j = 0; j < 4; ++j) { const int o = (tid_ & 255) + 256 * j, c2 = tid_ >> 8, rr = o >> 5, cc = o & 31;
            const float* pp = part + (c2 * 32 + rr) * 32 + cc;
            epi(row_base + tm * 32 + rr, tn * 64 + c2 * 32 + cc, pp[0], pp[2 * 1024], pp[4 * 1024], pp[6 * 1024]); }
        __syncthreads();
    }
}
template <bool QUART, class Epi4>
__device__ __forceinline__ void slab_gemm5(int wid_k, char* lds, const bf16_t* A, int lda, const bf16_t* Bt, int ldb, int row_base, int M, int N, int K, const Epi4& epi) {
    int tid_ = tid_of(wid_k); A = launder_uniform(A); Bt = launder_uniform(Bt);
    const int lane = tid_ & 63, wid = __builtin_amdgcn_readfirstlane(tid_ >> 6), r32 = lane & 31, hi = lane >> 5, ch = wid & 1, kq = wid >> 1, kl = K >> 2, ns = K >> 7;
    constexpr int STG = 24576, NSTG = 5;
    float* part = (float*)lds;
    LAS unsigned char* ldsL = (LAS unsigned char*)(unsigned)(uintptr_t)lds;
    const int ntn = N / 64, ntiles = (M / 32) * ntn;
    for (int t = blockIdx.x; t < ntiles; t += gridDim.x) {
        const int tm = t / ntn, tn = t % ntn, row0 = row_base + tm * 32, col0 = tn * 64;
        const char* gsrc[3];
#pragma unroll
        for (int j = 0; j < 3; ++j) { const int J = 3 * wid + j, isA = J < 8, G = (isA ? J : J - 8) * 64 + lane, row = G >> 4, lc = (G & 15) ^ (row & 15);
            const bf16_t* rp = isA ? A + (size_t)(row0 + row) * lda : Bt + (size_t)(col0 + row) * ldb;
            gsrc[j] = (const char*)(rp + (QUART ? (lc >> 2) * kl + (lc & 3) * 8 : lc * 8)); }
        const size_t sstep = QUART ? 64 : 256;
#define S5_DMA(st_, si_) do { _Pragma("unroll") for (int j = 0; j < 3; ++j) \
            __builtin_amdgcn_global_load_lds((const unsigned*)(gsrc[j] + (size_t)(si_) * sstep), (LAS unsigned*)(ldsL + (st_) * STG + (3 * wid + j) * 1024), 16, 0, 0); } while (0)
        int aoff[2], boff[2];
#pragma unroll
        for (int m = 0; m < 2; ++m) { const int lc = QUART ? 4 * kq + 2 * m + hi : 2 * kq + 8 * m + hi;
            aoff[m] = r32 * 256 + ((lc ^ (r32 & 15)) << 4); boff[m] = 8192 + (ch * 32 + r32) * 256 + ((lc ^ (r32 & 15)) << 4); }
        f32x16 acc = {};
#pragma unroll
        for (int s = 0; s < NSTG - 1; ++s) if (s < ns) S5_DMA(s, s);
        int st = 0;
        for (int s = 0; s < ns; ++s) {
            const int rem = ns - 1 - s;
            if (rem >= 3) asm volatile("s_waitcnt vmcnt(9)" ::: "memory"); else if (rem == 2) asm volatile("s_waitcnt vmcnt(6)" ::: "memory");
            else if (rem == 1) asm volatile("s_waitcnt vmcnt(3)" ::: "memory"); else asm volatile("s_waitcnt vmcnt(0)" ::: "memory");
            __builtin_amdgcn_s_barrier(); asm volatile("" ::: "memory");
            if (s + NSTG - 1 < ns) { const int sn = st == 0 ? NSTG - 1 : st - 1; S5_DMA(sn, s + NSTG - 1); }
            const LAS unsigned char* sb = ldsL + st * STG;
            const bf16x8 a0 = *(const LAS bf16x8*)(sb + aoff[0]), b0 = *(const LAS bf16x8*)(sb + boff[0]), a1 = *(const LAS bf16x8*)(sb + aoff[1]), b1 = *(const LAS bf16x8*)(sb + boff[1]);
            acc = __builtin_amdgcn_mfma_f32_32x32x16_bf16(a0, b0, acc, 0, 0, 0);
            acc = __builtin_amdgcn_mfma_f32_32x32x16_bf16(a1, b1, acc, 0, 0, 0);
            st = st == NSTG - 1 ? 0 : st + 1;
        }
#undef S5_DMA
        asm volatile("s_waitcnt lgkmcnt(0)" ::: "memory"); __builtin_amdgcn_s_barrier(); asm volatile("" ::: "memory");
        float* pw = part + ((kq * 2 + ch) * 32) * 32 + r32;
#pragma unroll
        for (int i = 0; i < 16; ++i) pw[((i & 3) + 8 * (i >> 2) + 4 * hi) * 32] = acc[i];
        __syncthreads();
#pragma unroll
        for (int j = 0; j < 4; ++j) { const int o = (tid_ & 255) + 256 * j, c2 = tid_ >> 8, rr = o >> 5, cc = o & 31;
            const float* pp = part + (c2 * 32 + rr) * 32 + cc;
            epi(row_base + tm * 32 + rr, tn * 64 + c2 * 32 + cc, pp[0], pp[2 * 1024], pp[4 * 1024], pp[6 * 1024]); }
        __syncthreads();
    }
}
struct SEpiRes4 {
    float* h; const float* gx; const float* gc; const float* src;
    __device__ __forceinline__ void operator()(int row, int col, float p0, float p1, float p2, float p3) const { const size_t o = (size_t)row * DM + col; h[o] = src[o] + (row < SEQ ? gx[col] : gc[col]) * ((p0 + p1) + (p2 + p3)); }
};
struct SEpiBr4 {
    bf16_t* mb; const bf16_t* P;
    __device__ __forceinline__ void operator()(int row, int col, float p0, float p1, float p2, float p3) const { const bf16_t* g = P + (size_t)row * DIN + C_G + col;
        mb[(size_t)row * DM + col] = f2bf(bf2f(g[0]) * (p0 + p1) + bf2f(g[DM]) * p2 + bf2f(g[2 * DM]) * p3); }
};
struct SEpiWin {
    float* R; bf16_t* P;
    __device__ __forceinline__ void operator()(int row, int col, float v) const {
        const bool isv = (col >= C_VA && col < C_QB) || (col >= C_VB && col < C_QC) || (col >= C_VC);
        if (!isv) { const int rc = col < C_VA ? col : (col < C_VB ? col - 256 : col - 768); R[(size_t)row * RW + rc] = v; }
        else P[(size_t)row * DIN + col] = f2bf(col >= C_G ? sigmoidf(v) : v);
    }
};
template <int STEP> struct SEpiBr {
    float* mf; bf16_t* mb; const bf16_t* P;
    __device__ __forceinline__ void operator()(int row, int col, float v) const {
        const float g = bf2f(P[(size_t)row * DIN + C_G + STEP * DM + col]);
        const size_t o = (size_t)row * DM + col;
        if (STEP == 0) mf[o] = g * v; else if (STEP == 1) mf[o] += g * v; else mb[o] = f2bf(mf[o] + g * v);
    }
};
struct SEpiRes {
    float* h; const float* gx; const float* gc; const float* src;
    __device__ __forceinline__ void operator()(int row, int col, float v) const { const size_t o = (size_t)row * DM + col; h[o] = src[o] + (row < SEQ ? gx[col] : gc[col]) * v; }
};
struct SEpiY { float* Y; __device__ __forceinline__ void operator()(int row, int col, float v) const { Y[(size_t)row * DUP + col] = v; } };

namespace pg8 {
#define PG8_LAS __attribute__((address_space(3)))
constexpr int BM = 256, BK = 64, HALF = 128, HTB = HALF * BK * 2  , STAGE_BYTES = 8 * HTB, NXCD = 8, WGM = 8;
__host__ __device__ __forceinline__ int lds_byte(int r, int c) { const int st = (r >> 4) * 2 + (c >> 5), rr = r & 15, cc = c & 31, ob = rr * 64 + cc * 2; return st * 1024 + (ob ^ (((ob >> 9) & 1) << 5)); }
__host__ __device__ __forceinline__ void stage_rc(int b, int& R, int& C) { const int st = b / 1024, sb = b % 1024, swz = sb ^ (((sb >> 9) & 1) << 5); R = (st >> 1) * 16 + swz / 64; C = (st & 1) * 32 + (swz % 64) / 2; }
__host__ __device__ __forceinline__ int perm32(int rho) { const int n = rho >> 4, i = rho & 15; return 8 * (i >> 2) + 4 * n + (i & 3); }
struct Unit { int pm, pn; };
struct Gemm { const bf16_t* A; const bf16_t* Bt; int M, N, K; int lda = 0, ldb = 0; };
struct OneUnit { Unit u; __device__ __forceinline__ bool next(int i, Unit& o) const { o = u; return i == 0; } __device__ __forceinline__ void a_ready(const Unit&) const {} __device__ __forceinline__ void done(const Unit&) const {} };
struct StaticOrder {
    int nM, nN, nwg, G, c;
    __host__ __device__ __forceinline__ void init(int M, int N, int G_, int c_) { nM = M / BM; nN = N / BM; nwg = nM * nN; G = G_; c = c_; }
    __host__ __device__ __forceinline__ bool next(int i, Unit& u) const {
        const long L = (long)i * G + c; if (L >= nwg) return false;
        int wgid = (int)L; { const int q = nwg / NXCD, r = nwg % NXCD, xcd = wgid % NXCD, off = wgid / NXCD; wgid = (xcd < r ? xcd * (q + 1) : r * (q + 1) + (xcd - r) * q) + off; }
        const int nig = WGM * nN, gid = wgid / nig, fm = gid * WGM, gsz = (nM - fm) < WGM ? (nM - fm) : WGM;
        u.pm = fm + ((wgid % nig) % gsz); u.pn = (wgid % nig) / gsz; return true;
    }
    __device__ __forceinline__ void a_ready(const Unit&) const {}
    __device__ __forceinline__ void done(const Unit&) const {}
};
template <class Epi, class Sched, bool KEEP_IN, bool KEEP_OUT, bool F8 = false>
__device__ __forceinline__ void gemm_phase_core(PG8_LAS unsigned char* lds, const Gemm g, const Sched& S, const Epi& E, int tid, f32x4 (&acc)[2][2][4][2]) {
    asm volatile("" : "+v"(tid));
    const int wid = __builtin_amdgcn_readfirstlane(tid >> 6), lane = tid & 63, wr = wid >> 2, wc = wid & 3, fr = lane & 15, fq = lane >> 4;
    const int K = g.K, nt = K / BK, lda = g.lda ? g.lda : K, ldb = g.ldb ? g.ldb : K;
    unsigned voffA[2], voffB[2];
#pragma unroll
    for (int i = 0; i < 2; ++i) { int R, C; stage_rc(tid * 16 + i * 8192, R, C); const int Rb = Epi::PERM ? ((R & ~31) + perm32(R & 31)) : R;
        voffA[i] = (unsigned)(R * lda + C) * 2u; voffB[i] = (unsigned)(Rb * ldb + C) * 2u; }
    const size_t kstep = (size_t)(BK * 2);
    const size_t hstepA = (size_t)HALF * lda * 2, hstepB = (size_t)HALF * ldb * 2;
    const size_t tstepA = 2 * hstepA, tstepB = 2 * hstepB;
    const unsigned ldsw = (unsigned)wid * 1024u;
    const int aoff = lds_byte(wr * 64 + fr, fq * 8), boff = lds_byte(wc * 32 + fr, fq * 8);
#define PG8_SA(b, h) (((b) * 2 + (h)) * HTB)
#define PG8_SB(b, h) ((4 + (b) * 2 + (h)) * HTB)
#define PG8_STAGE(bufoff, gbase, voff) do { _Pragma("unroll") for (int _i = 0; _i < 2; ++_i) \
        __builtin_amdgcn_global_load_lds((const unsigned*)((const char*)(gbase) + (voff)[_i]), (PG8_LAS unsigned*)(lds + (bufoff) + ldsw + _i * 8192), 16, 0, 0); } while (0)
#define PG8_LDA(dst, b, h) do { _Pragma("unroll") for (int m = 0; m < 4; ++m) _Pragma("unroll") for (int k = 0; k < 2; ++k) dst[m][k] = *(const PG8_LAS bf16x8*)(lds + PG8_SA(b, h) + aoff + m * 2048 + k * 1024); } while (0)
#define PG8_LDB(dst, b, h) do { _Pragma("unroll") for (int n = 0; n < 2; ++n) _Pragma("unroll") for (int k = 0; k < 2; ++k) dst[n][k] = *(const PG8_LAS bf16x8*)(lds + PG8_SB(b, h) + boff + n * 2048 + k * 1024); } while (0)
#define PG8_MMA(ai, bj, At, Bt) do { __builtin_amdgcn_s_setprio(1); _Pragma("unroll") for (int m = 0; m < 4; ++m) _Pragma("unroll") for (int n = 0; n < 2; ++n) { \
        if constexpr (F8) { typedef int v4i_ __attribute__((ext_vector_type(4))); typedef int v8i_ __attribute__((ext_vector_type(8))); \
            const v8i_ b8_ = __builtin_shufflevector(__builtin_bit_cast(v4i_, Bt[n][0]), __builtin_bit_cast(v4i_, Bt[n][1]), 0, 1, 2, 3, 4, 5, 6, 7); \
            const v8i_ a8_ = __builtin_shufflevector(__builtin_bit_cast(v4i_, At[m][0]), __builtin_bit_cast(v4i_, At[m][1]), 0, 1, 2, 3, 4, 5, 6, 7); \
            asm volatile("v_mfma_scale_f32_16x16x128_f8f6f4 %0, %1, %2, %0, %3, %3 op_sel_hi:[0,0,0]" : "+v"(acc[ai][bj][m][n]) : "v"(b8_), "v"(a8_), "v"(sc8_)); } \
        else { _Pragma("unroll") for (int k = 0; k < 2; ++k) acc[ai][bj][m][n] = __builtin_amdgcn_mfma_f32_16x16x32_bf16(Bt[n][k], At[m][k], acc[ai][bj][m][n], 0, 0, 0); } } \
        __builtin_amdgcn_s_setprio(0); } while (0)
#define PG8_WAIT_V(n) asm volatile("s_waitcnt vmcnt(" #n ")" ::: "memory")
#define PG8_WAIT_L(n) asm volatile("s_waitcnt lgkmcnt(" #n ")" ::: "memory")
#define PG8_BAR __builtin_amdgcn_s_barrier()
#define PG8_SCHED __builtin_amdgcn_sched_barrier(0)
    int sc8_ = 127; if constexpr (F8) asm volatile("" : "+v"(sc8_));
    Unit cur, nxt; int ui = 0;
    if (!S.next(0, cur)) return;
    if constexpr (!KEEP_IN) {
#pragma unroll
    for (int a = 0; a < 2; ++a)
#pragma unroll
        for (int b = 0; b < 2; ++b)
#pragma unroll
            for (int m = 0; m < 4; ++m)
#pragma unroll
                for (int n = 0; n < 2; ++n) acc[a][b][m][n] = (f32x4){0.f, 0.f, 0.f, 0.f};
    }
    bf16x8 At[4][2], B0[2][2], B1[2][2];
    const char* cA = (const char*)g.A + (size_t)cur.pm * tstepA; const char* cB = (const char*)g.Bt + (size_t)cur.pn * tstepB;
    S.a_ready(cur);
    PG8_STAGE(PG8_SB(0, 0), cB, voffB); PG8_STAGE(PG8_SA(0, 0), cA, voffA); PG8_STAGE(PG8_SB(0, 1), cB + hstepB, voffB); PG8_STAGE(PG8_SA(0, 1), cA + hstepA, voffA);
    if (wr == 1) PG8_BAR;
    PG8_WAIT_V(4); PG8_BAR;
    PG8_STAGE(PG8_SB(1, 0), cB + kstep, voffB); PG8_STAGE(PG8_SA(1, 0), cA + kstep, voffA); PG8_STAGE(PG8_SB(1, 1), cB + hstepB + kstep, voffB);
    PG8_WAIT_V(6); PG8_BAR;
    for (;;) {
        const bool has_next = S.next(ui + 1, nxt);
        const char* nA = has_next ? (const char*)g.A + (size_t)nxt.pm * tstepA : cA; const char* nB = has_next ? (const char*)g.Bt + (size_t)nxt.pn * tstepB : cB;
        for (int t = 0; t < nt; t += 2) {
            const bool last = (t == nt - 2);
            const char* a1 = cA + (size_t)(t + 1) * kstep;
            const char* a2 = last ? nA : cA + (size_t)(t + 2) * kstep; const char* b2 = last ? nB : cB + (size_t)(t + 2) * kstep;
            const char* a3 = a2 + kstep; const char* b3 = b2 + kstep;
            if (last && has_next) S.a_ready(nxt);
            PG8_LDB(B0, 0, 0); PG8_SCHED; PG8_LDA(At, 0, 0); PG8_STAGE(PG8_SA(1, 1), a1 + hstepA, voffA);
            PG8_WAIT_L(8); PG8_BAR; PG8_WAIT_L(0); PG8_MMA(0, 0, At, B0); PG8_BAR; PG8_SCHED;
            PG8_LDB(B1, 0, 1); PG8_STAGE(PG8_SB(0, 0), b2, voffB);
            PG8_BAR; PG8_WAIT_L(0); PG8_MMA(0, 1, At, B1); PG8_BAR;
            PG8_LDA(At, 0, 1); PG8_STAGE(PG8_SA(0, 0), a2, voffA);
            PG8_BAR; PG8_WAIT_L(0); PG8_MMA(1, 0, At, B0); PG8_BAR; PG8_SCHED;
            PG8_STAGE(PG8_SB(0, 1), b2 + hstepB, voffB);
            PG8_WAIT_V(6); PG8_BAR; PG8_MMA(1, 1, At, B1); PG8_BAR;
            PG8_LDB(B0, 1, 0); PG8_SCHED; PG8_LDA(At, 1, 0); PG8_STAGE(PG8_SA(0, 1), a2 + hstepA, voffA);
            PG8_WAIT_L(8); PG8_BAR; PG8_WAIT_L(0); PG8_MMA(0, 0, At, B0); PG8_BAR; PG8_SCHED;
            PG8_LDB(B1, 1, 1); PG8_STAGE(PG8_SB(1, 0), b3, voffB);
            PG8_BAR; PG8_WAIT_L(0); PG8_MMA(0, 1, At, B1); PG8_BAR;
            PG8_LDA(At, 1, 1); PG8_STAGE(PG8_SA(1, 0), a3, voffA);
            PG8_BAR; PG8_WAIT_L(0); PG8_MMA(1, 0, At, B0); PG8_BAR; PG8_SCHED;
            PG8_STAGE(PG8_SB(1, 1), b3 + hstepB, voffB);
            PG8_WAIT_V(6); PG8_BAR; PG8_MMA(1, 1, At, B1); PG8_BAR;
        }
        if constexpr (F8) {
#define PG8_PIN8(ai, bj, TXT) asm volatile(TXT : "+v"(acc[ai][bj][0][0]), "+v"(acc[ai][bj][0][1]), "+v"(acc[ai][bj][1][0]), "+v"(acc[ai][bj][1][1]), "+v"(acc[ai][bj][2][0]), "+v"(acc[ai][bj][2][1]), "+v"(acc[ai][bj][3][0]), "+v"(acc[ai][bj][3][1]))
            PG8_PIN8(0, 0, "s_nop 15\n\ts_nop 15"); PG8_PIN8(0, 1, ""); PG8_PIN8(1, 0, ""); PG8_PIN8(1, 1, "");
#undef PG8_PIN8
        }
        if constexpr (!Epi::AFTER_DRAIN && !KEEP_OUT) { E(acc, cur, wr, wc, fr, fq); S.done(cur); }
        if (!has_next) break;
#pragma unroll
        for (int a = 0; a < 2; ++a)
#pragma unroll
            for (int b = 0; b < 2; ++b)
#pragma unroll
                for (int m = 0; m < 4; ++m)
#pragma unroll
                    for (int n = 0; n < 2; ++n) acc[a][b][m][n] = (f32x4){0.f, 0.f, 0.f, 0.f};
        cur = nxt; cA = nA; cB = nB; ++ui;
    }
    PG8_WAIT_V(0);
    if (wr == 0) PG8_BAR;
    PG8_BAR;
    if constexpr (Epi::AFTER_DRAIN && !KEEP_OUT) { E.fused(acc, cur, wr, wc, fr, fq, lds, wid, lane); S.done(cur); }
#undef PG8_SA
#undef PG8_SB
#undef PG8_STAGE
#undef PG8_LDA
#undef PG8_LDB
#undef PG8_MMA
#undef PG8_WAIT_V
#undef PG8_WAIT_L
#undef PG8_BAR
#undef PG8_SCHED
}
template <class Epi, class Sched, bool F8 = false>
__device__ __forceinline__ void gemm_phase(PG8_LAS unsigned char* lds, const Gemm g, const Sched& S, const Epi& E, int tid) {
    f32x4 acc[2][2][4][2];
    gemm_phase_core<Epi, Sched, false, false, F8>(lds, g, S, E, tid, acc);
}
}

namespace pg8 {
typedef const f32x4 (&AccRef)[2][2][4][2];
__device__ __forceinline__ u32x4 pack8(const f32x4 a, const f32x4 b) {
    unsigned x, y, z, w;
    asm volatile("s_nop 0\n\tv_cvt_pk_bf16_f32 %0, %4, %5\n\tv_cvt_pk_bf16_f32 %1, %6, %7\n\tv_cvt_pk_bf16_f32 %2, %8, %9\n\tv_cvt_pk_bf16_f32 %3, %10, %11"
        : "=&v"(x), "=&v"(y), "=&v"(z), "=&v"(w) : "v"(a[0]), "v"(a[1]), "v"(a[2]), "v"(a[3]), "v"(b[0]), "v"(b[1]), "v"(b[2]), "v"(b[3]));
    return (u32x4){x, y, z, w}; }
__device__ __forceinline__ void unpack8(const u32x4 w, f32x4& a, f32x4& b) {
    a[0] = __uint_as_float(w.x << 16); a[1] = __uint_as_float(w.x & 0xffff0000u); a[2] = __uint_as_float(w.y << 16); a[3] = __uint_as_float(w.y & 0xffff0000u);
    b[0] = __uint_as_float(w.z << 16); b[1] = __uint_as_float(w.z & 0xffff0000u); b[2] = __uint_as_float(w.w << 16); b[3] = __uint_as_float(w.w & 0xffff0000u); }
struct EpiWin {
    static constexpr bool PERM = true, AFTER_DRAIN = false;
    bf16_t* P; const float* gqa; const float* gka; const float* gqb; const float* gkb; const float* gqc; const float* gkc; LAS float* part; float zs = 1.0f;
    __device__ __forceinline__ void operator()(AccRef acc, const Unit& u, int wr, int wc, int fr_, int fq_) const {
        int fr = fr_, fq = fq_; asm volatile("" : "+v"(fr), "+v"(fq));
        const int row0 = u.pm * BM + wr * 64 + fr, pn = u.pn, colt = pn * BM, cw = wc * 32 + 8 * fq;
        const bool isv = (pn == 5) || (pn == 10) || (pn == 11) || (pn >= 16);
        if (isv) {
            const bool gate = pn >= 18;
#pragma unroll
            for (int ai = 0; ai < 2; ++ai)
#pragma unroll
                for (int m = 0; m < 4; ++m) { bf16_t* pp = P + (size_t)(row0 + ai * HALF + m * 16) * DIN + colt + cw;
#pragma unroll
                    for (int bj = 0; bj < 2; ++bj) { f32x4 v0 = acc[ai][bj][m][0], v1 = acc[ai][bj][m][1];
                        if (gate) {
#pragma unroll
                            for (int e = 0; e < 4; ++e) { v0[e] = sigmoidf(v0[e] * zs); v1[e] = sigmoidf(v1[e] * zs); } }
                        *(u32x4*)(pp + bj * HALF) = pack8(v0, v1); } }
            return;
        }
        int type; float qs; f32x4 g1, g2; const int grpA = wc >> 1, fA = 16 * (wc & 1) + 4 * fq, grpC = wc & 1, fC = 4 * fq;
        if (pn < 4) { type = 0; qs = 0.12751743f; g1 = *(const f32x4*)(gqa + 64 * grpA + fA); g2 = *(const f32x4*)(gqa + 64 * grpA + 32 + fA); }
        else if (pn == 4) { type = 0; qs = 1.f; g1 = *(const f32x4*)(gka + 64 * grpA + fA); g2 = *(const f32x4*)(gka + 64 * grpA + 32 + fA); }
        else if (pn < 8) { type = 1; qs = 0.12751743f; g1 = *(const f32x4*)(gqb + cw); g2 = *(const f32x4*)(gqb + cw + 4); }
        else if (pn < 10) { type = 1; qs = 1.f; g1 = *(const f32x4*)(gkb + cw); g2 = *(const f32x4*)(gkb + cw + 4); }
        else if (pn < 14) { type = 2; qs = 0.18033688f; g1 = *(const f32x4*)(gqc + 32 * grpC + fC); g2 = *(const f32x4*)(gqc + 32 * grpC + 16 + fC); }
        else { type = 2; qs = 1.f; g1 = *(const f32x4*)(gkc + 32 * grpC + fC); g2 = *(const f32x4*)(gkc + 32 * grpC + 16 + fC); }
        const int prow = wr * 64 + fr;
#pragma unroll
        for (int ai = 0; ai < 2; ++ai)
#pragma unroll
            for (int m = 0; m < 4; ++m)
#pragma unroll
                for (int bj = 0; bj < 2; ++bj) { const f32x4 a = acc[ai][bj][m][0], b = acc[ai][bj][m][1];
                    float s = (a[0] * a[0] + a[1] * a[1]) + (a[2] * a[2] + a[3] * a[3]) + (b[0] * b[0] + b[1] * b[1]) + (b[2] * b[2] + b[3] * b[3]);
                    s += swz_xor<16>(s);
                    { auto rr = __builtin_amdgcn_permlane32_swap(__float_as_uint(s), __float_as_uint(s), false, false); s = __uint_as_float(rr[0]) + __uint_as_float(rr[1]); }
                    if (fq == 0) part[((ai * HALF + m * 16 + prow) * 2 + bj) * 4 + wc] = s; }
        asm volatile("s_waitcnt lgkmcnt(0)" ::: "memory"); __builtin_amdgcn_s_barrier(); asm volatile("" ::: "memory");
        f32x4 inv = {0.f, 0.f, 0.f, 0.f}; const int grp = type == 0 ? grpA : grpC;
        if (type != 1) { const int f0 = type == 0 ? fA : fC; const float kf = type == 0 ? (13.287712379549449f / 32.0f) : (13.287712379549449f / 16.0f);
#pragma unroll
            for (int e = 0; e < 4; ++e) inv[e] = __builtin_amdgcn_exp2f(-(float)(f0 + e) * kf); }
        const bool rope = (type != 1) && (u.pm * BM < SEQ);
        const float invn = type == 2 ? (1.0f / 64.0f) : (1.0f / 128.0f);
#pragma unroll
        for (int ai = 0; ai < 2; ++ai)
#pragma unroll
            for (int m = 0; m < 4; ++m) {
                f32x4 cs = {1.f, 1.f, 1.f, 1.f}, sn = {0.f, 0.f, 0.f, 0.f};
                if (rope) { const float pos = grp ? (float)(m * 16 + fr) : (float)(4 * u.pm + 2 * ai + wr);
#pragma unroll
                    for (int e = 0; e < 4; ++e) { const float rev = __builtin_amdgcn_fractf(pos * inv[e] * 0.15915494309189535f); cs[e] = __builtin_amdgcn_cosf(rev); sn[e] = __builtin_amdgcn_sinf(rev); } }
                bf16_t* pp = P + (size_t)(row0 + ai * HALF + m * 16) * DIN + colt + cw;
#pragma unroll
                for (int bj = 0; bj < 2; ++bj) {
                    const f32x4 pq = *(const LAS f32x4*)(part + ((ai * HALF + m * 16 + prow) * 2 + bj) * 4);
                    const float tot = type == 2 ? ((wc & 2) ? pq[2] + pq[3] : pq[0] + pq[1]) : (pq[0] + pq[1]) + (pq[2] + pq[3]);
                    const float rstd = qs * __builtin_amdgcn_rsqf(tot * invn + EPS);
                    f32x4 v0, v1;
#pragma unroll
                    for (int e = 0; e < 4; ++e) { const float y1 = acc[ai][bj][m][0][e] * rstd * g1[e], y2 = acc[ai][bj][m][1][e] * rstd * g2[e];
                        v0[e] = y1 * cs[e] - y2 * sn[e]; v1[e] = y2 * cs[e] + y1 * sn[e]; }
                    *(u32x4*)(pp + bj * HALF) = pack8(v0, v1); }
                asm volatile("" ::: "memory"); }
    }
};
struct EpiGate {
    static constexpr bool PERM = true, AFTER_DRAIN = false;
    bf16_t* P;
    __device__ __forceinline__ void operator()(AccRef acc, const Unit& u, int wr, int wc, int fr, int fq) const {
        const int row0 = u.pm * BM + wr * 64 + fr, col0 = C_G + u.pn * BM + wc * 32 + 8 * fq;
#pragma unroll
        for (int ai = 0; ai < 2; ++ai)
#pragma unroll
            for (int m = 0; m < 4; ++m) { bf16_t* pp = P + (size_t)(row0 + ai * HALF + m * 16) * DIN + col0;
#pragma unroll
                for (int bj = 0; bj < 2; ++bj) { f32x4 v0 = acc[ai][bj][m][0], v1 = acc[ai][bj][m][1];
#pragma unroll
                    for (int e = 0; e < 4; ++e) { v0[e] = __builtin_amdgcn_rcpf(1.0f + __builtin_amdgcn_exp2f(v0[e] * (-1.4426950408889634f / 32.0f))); v1[e] = __builtin_amdgcn_rcpf(1.0f + __builtin_amdgcn_exp2f(v1[e] * (-1.4426950408889634f / 32.0f))); }
                    *(u32x4*)(pp + bj * HALF) = pack8(v0, v1); } }
    }
};
struct GateOrder {
    int first, count, stride;
    __device__ __forceinline__ void init(int c, int G) { stride = 1; if (G != 256) { first = c; stride = G; count = (33 * 24 - c + G - 1) / G; } else if (c < 82) { first = 2 * c; count = 2; } else if (c < 188) { first = 164 + 4 * (c - 82); count = 4; } else { first = 588 + 3 * (c - 188); count = 3; } }
    __device__ __forceinline__ bool next(int i, Unit& u) const { if (i >= count) return false; const int g = first + i * stride; u.pm = g / 24; u.pn = g % 24; return true; }
    __device__ __forceinline__ void a_ready(const Unit&) const {}
    __device__ __forceinline__ void done(const Unit&) const {}
};
template <int STEP> struct EpiBr {
    static constexpr bool PERM = true, AFTER_DRAIN = false;
    float* mf; bf16_t* mb; const bf16_t* P;
    __device__ __forceinline__ void operator()(AccRef acc, const Unit& u, int wr, int wc, int fr, int fq) const {
        const int row0 = u.pm * BM + wr * 64 + fr, col0 = u.pn * BM + wc * 32 + 8 * fq;
#pragma unroll
        for (int am = 0; am < 4; ++am) { const int ai = am >> 1, m0 = (am & 1) * 2;
            u32x4 gw[2][2]; f32x4 old0[2][2], old1[2][2];
#pragma unroll
            for (int mm = 0; mm < 2; ++mm)
#pragma unroll
                for (int bj = 0; bj < 2; ++bj) { const size_t row = (size_t)(row0 + ai * HALF + (m0 + mm) * 16); const int col = col0 + bj * HALF;
                    gw[mm][bj] = *(const u32x4*)(P + row * DIN + C_G + STEP * DM + col);
                    if (STEP > 0) { old0[mm][bj] = *(const f32x4*)(mf + row * DM + col); old1[mm][bj] = *(const f32x4*)(mf + row * DM + col + 4); } }
#pragma unroll
            for (int mm = 0; mm < 2; ++mm)
#pragma unroll
                for (int bj = 0; bj < 2; ++bj) { const size_t row = (size_t)(row0 + ai * HALF + (m0 + mm) * 16); const int col = col0 + bj * HALF;
                    f32x4 g0, g1; unpack8(gw[mm][bj], g0, g1);
                    f32x4 v0 = g0 * acc[ai][bj][m0 + mm][0], v1 = g1 * acc[ai][bj][m0 + mm][1];
                    if (STEP > 0) { v0 += old0[mm][bj]; v1 += old1[mm][bj]; }
                    float* mp = mf + row * DM + col;
                    if (STEP < 2) { *(f32x4*)mp = v0; *(f32x4*)(mp + 4) = v1; } else *(u32x4*)(mb + row * DM + col) = pack8(v0, v1); }
            asm volatile("" ::: "memory");
        }
    }
};

struct EpiBrChain {
    static constexpr bool PERM = true, AFTER_DRAIN = false;
    bf16_t* mb; const bf16_t* P;
    template <int GS> __device__ __forceinline__ void scale(f32x4 (&acc)[2][2][4][2], const Unit& u, int tid) const {
        asm volatile("" : "+v"(tid));
        const int wid = __builtin_amdgcn_readfirstlane(tid >> 6), lane = tid & 63, wr = wid >> 2, wc = wid & 3, fr = lane & 15, fq = lane >> 4;
        const bf16_t* gp0 = P + (size_t)(u.pm * BM + wr * 64 + fr) * DIN + C_G + GS * DM + u.pn * BM + wc * 32 + 8 * fq;
        typedef const __attribute__((address_space(1))) u32x4 gq;
        u32x4 cn[2], cd[2], nn[2], nd[2];
#define GLD(n_, d_, g_) do { const bf16_t* gp_ = gp0 + (size_t)(((g_) >> 2) * HALF + ((g_) & 3) * 16) * DIN; _Pragma("unroll") for (int bj = 0; bj < 2; ++bj) { n_[bj] = *(gq*)(gp_ + bj * HALF); d_[bj] = *(gq*)(gp_ + DM + bj * HALF); } } while (0)
        GLD(cn, cd, 0);
#pragma unroll
        for (int g = 0; g < 8; ++g) { const int ai = g >> 2, m = g & 3;
            if (g < 7) GLD(nn, nd, g + 1);
#pragma unroll
            for (int bj = 0; bj < 2; ++bj) { f32x4 n0, n1, d0, d1; unpack8(cn[bj], n0, n1); unpack8(cd[bj], d0, d1);
#pragma unroll
                for (int e = 0; e < 4; ++e) { const float a0 = GS ? fmaxf(n0[e], 1e-15f) : n0[e], a1 = GS ? fmaxf(n1[e], 1e-15f) : n1[e];
                    acc[ai][bj][m][0][e] *= a0 * __builtin_amdgcn_rcpf(fmaxf(d0[e], 1e-15f)); acc[ai][bj][m][1][e] *= a1 * __builtin_amdgcn_rcpf(fmaxf(d1[e], 1e-15f)); } }
            asm volatile("" : "+v"(acc[ai][0][m][0]), "+v"(acc[ai][0][m][1]), "+v"(acc[ai][1][m][0]), "+v"(acc[ai][1][m][1]) :: "memory");
#pragma unroll
            for (int bj = 0; bj < 2; ++bj) { cn[bj] = nn[bj]; cd[bj] = nd[bj]; }
        }
#undef GLD
    }
    __device__ __forceinline__ void operator()(AccRef acc, const Unit& u, int wr, int wc, int fr_, int fq) const {
        int fr = fr_; asm volatile("" : "+v"(fr));
        const int row0 = u.pm * BM + wr * 64 + fr, col0 = u.pn * BM + wc * 32 + 8 * fq;
#pragma unroll
        for (int am = 0; am < 4; ++am) { const int ai = am >> 1, m0 = (am & 1) * 2;
            u32x4 gw[2][2];
#pragma unroll
            for (int mm = 0; mm < 2; ++mm)
#pragma unroll
                for (int bj = 0; bj < 2; ++bj) gw[mm][bj] = *(const __attribute__((address_space(1))) u32x4*)(P + (size_t)(row0 + ai * HALF + (m0 + mm) * 16) * DIN + C_G + 2 * DM + col0 + bj * HALF);
#pragma unroll
            for (int mm = 0; mm < 2; ++mm)
#pragma unroll
                for (int bj = 0; bj < 2; ++bj) { f32x4 g0, g1; unpack8(gw[mm][bj], g0, g1);
#pragma unroll
                    for (int e = 0; e < 4; ++e) { g0[e] = fmaxf(g0[e], 1e-15f); g1[e] = fmaxf(g1[e], 1e-15f); }
                    *(u32x4*)(mb + (size_t)(row0 + ai * HALF + (m0 + mm) * 16) * DM + col0 + bj * HALF) = pack8(g0 * acc[ai][bj][m0 + mm][0], g1 * acc[ai][bj][m0 + mm][1]); }
            asm volatile("" ::: "memory"); }
    }
};
struct EpiRes {
    static constexpr bool PERM = false, AFTER_DRAIN = false;
    const float* h; const float* gx; const float* gc; float* dst;
    __device__ __forceinline__ void operator()(AccRef acc, const Unit& u, int wr, int wc, int fr, int fq) const {
        const int row0 = u.pm * BM + wr * 64 + fr, col0 = u.pn * BM + wc * 32 + 4 * fq;
        const float* gp = (u.pm * BM < SEQ ? gx : gc) + col0;
        f32x4 gv[2][2];
#pragma unroll
        for (int bj = 0; bj < 2; ++bj)
#pragma unroll
            for (int n = 0; n < 2; ++n) gv[bj][n] = *(const f32x4*)(gp + bj * HALF + n * 16);
#pragma unroll
        for (int am = 0; am < 4; ++am) { const int ai = am >> 1, m0 = (am & 1) * 2;
            f32x4 old[2][2][2];
#pragma unroll
            for (int mm = 0; mm < 2; ++mm)
#pragma unroll
                for (int bj = 0; bj < 2; ++bj)
#pragma unroll
                    for (int n = 0; n < 2; ++n) old[mm][bj][n] = *(const f32x4*)(h + (size_t)(row0 + ai * HALF + (m0 + mm) * 16) * DM + col0 + bj * HALF + n * 16);
#pragma unroll
            for (int mm = 0; mm < 2; ++mm)
#pragma unroll
                for (int bj = 0; bj < 2; ++bj)
#pragma unroll
                    for (int n = 0; n < 2; ++n) *(f32x4*)(dst + (size_t)(row0 + ai * HALF + (m0 + mm) * 16) * DM + col0 + bj * HALF + n * 16) = old[mm][bj][n] + gv[bj][n] * acc[ai][bj][m0 + mm][n];
            asm volatile("" ::: "memory"); }
    }
};
__device__ __forceinline__ float dpp_ror1(float v)  { return __int_as_float(__builtin_amdgcn_update_dpp(__float_as_int(v), __float_as_int(v), 0x121, 0xf, 0xf, false)); }
__device__ __forceinline__ float dpp_ror15(float v) { return __int_as_float(__builtin_amdgcn_update_dpp(__float_as_int(v), __float_as_int(v), 0x12f, 0xf, 0xf, false)); }
struct EpiUp {
    static constexpr bool PERM = true, AFTER_DRAIN = false;
    bf16_t* act; float* E; const float* cw; const float* cb;
    __device__ __forceinline__ void operator()(AccRef acc, const Unit& u, int wr, int wc, int fr, int fq) const {
        const int ch0 = u.pn * 128 + wc * 32 + 8 * fq, ycol0 = u.pn * BM + wc * 32 + 8 * fq;
#pragma unroll
        for (int nn = 0; nn < 2; ++nn) {
            const int ch = ch0 + 4 * nn;
            const f32x4 wa0 = *(const f32x4*)(cw + ch), wa1 = *(const f32x4*)(cw + DUP + ch), wa2 = *(const f32x4*)(cw + 2 * DUP + ch), ba = *(const f32x4*)(cb + ch);
            const f32x4 wg0 = *(const f32x4*)(cw + DFF + ch), wg1 = *(const f32x4*)(cw + DUP + DFF + ch), wg2 = *(const f32x4*)(cw + 2 * DUP + DFF + ch), bg = *(const f32x4*)(cb + DFF + ch);
#pragma unroll
            for (int ai = 0; ai < 2; ++ai) {
                const int blk = 4 * u.pm + 2 * ai + wr;
#pragma unroll
                for (int m = 0; m < 4; ++m) {
                    const f32x4 ya = acc[ai][0][m][nn], yg = acc[ai][1][m][nn];
                    const f32x4 pa = acc[ai][0][m > 0 ? m - 1 : 0][nn], pg = acc[ai][1][m > 0 ? m - 1 : 0][nn];
                    const f32x4 na = acc[ai][0][m < 3 ? m + 1 : 3][nn], ng = acc[ai][1][m < 3 ? m + 1 : 3][nn];
                    f32x4 o, ha4, hg4;
#pragma unroll
                    for (int e = 0; e < 4; ++e) {
                        const float ua = dpp_ror1(fr == 15 ? pa[e] : ya[e]), ug = dpp_ror1(fr == 15 ? pg[e] : yg[e]);
                        const float da = dpp_ror15(fr == 0 ? na[e] : ya[e]), dg = dpp_ror15(fr == 0 ? ng[e] : yg[e]);
                        ha4[e] = ba[e] + wa0[e] * ua + wa1[e] * ya[e] + wa2[e] * da;
                        hg4[e] = bg[e] + wg0[e] * ug + wg1[e] * yg[e] + wg2[e] * dg;
                    }
                    {
                        f32x4 t = hg4 * -1.4426950408889634f;
#pragma unroll
                        for (int e = 0; e < 4; ++e) t[e] = __builtin_amdgcn_exp2f(t[e]);
                        t = t + 1.0f;
#pragma unroll
                        for (int e = 0; e < 4; ++e) t[e] = __builtin_amdgcn_rcpf(t[e]);
                        o = (hg4 * ha4) * t;
                    }
                    const int row = u.pm * BM + ai * HALF + wr * 64 + m * 16 + fr;
                    const bool edge = (m == 0 && fr == 0) || (m == 3 && fr == 15);
                    if (!edge) { u32x2 w; w.x = cvt_pk_bf16(o[0], o[1]); w.y = cvt_pk_bf16(o[2], o[3]); *(u32x2*)(act + (size_t)row * DFF + ch) = w; }
                    if ((m == 0 && fr < 2) || (m == 3 && fr >= 14)) {
                        const int slot = (m == 0) ? fr : fr - 12;
                        float* ep = E + ((size_t)blk * 4 + slot) * DUP + ycol0 + 4 * nn; *(f32x4*)ep = ya; *(f32x4*)(ep + HALF) = yg;
                    }
                }
            }
        }
    }
};
struct EpiY {
    static constexpr bool PERM = false, AFTER_DRAIN = false;
    float* Y;
    __device__ __forceinline__ void operator()(AccRef acc, const Unit& u, int wr, int wc, int fr, int fq) const {
        const int row0 = u.pm * BM + wr * 64 + fr, col0 = u.pn * BM + wc * 32 + 4 * fq;
#pragma unroll
        for (int ai = 0; ai < 2; ++ai)
#pragma unroll
            for (int m = 0; m < 4; ++m) { float* yp = Y + (size_t)(row0 + ai * HALF + m * 16) * DUP + col0;
#pragma unroll
                for (int bj = 0; bj < 2; ++bj)
#pragma unroll
                    for (int n = 0; n < 2; ++n) *(f32x4*)(yp + bj * HALF + n * 16) = acc[ai][bj][m][n]; }
    }
};
}

namespace att {
constexpr int D = 128, NW = 8, QBLK = 32, KVBLK = 64, LDP = DIN;
constexpr int SHM_V = KVBLK * D * 2, SHM_K = SHM_V;
constexpr int TILE_B = SHM_K + SHM_V, NRING = 4;
constexpr int OFF_WS = NRING * TILE_B, OFF_BIAS = OFF_WS + NW * 64 * 4, BIAS_PAD = 64, BIAS_N = 15 * 31, SHM_TOTAL = OFF_BIAS + (2 * BIAS_PAD + 480) * 4;
#define KSWZ(row, colB) ((row) * 256 + ((colB) ^ (((row) & 7) << 4)))
#define SBAR() __builtin_amdgcn_sched_barrier(0)
#define LAUNDER(p) asm volatile("" : "+v"(p))
__device__ __forceinline__ int crow(int r, int hi) { return (r & 3) + 8 * (r >> 2) + 4 * hi; }

struct Unit {
    const bf16_t* Q;
    const bf16_t* K;
    const bf16_t* V;
    int nt, key0;
    int rsA, r0;
    bf16_t* O; int ldo;
    float* S;
    const float* gsub; float lam, osc;
    float shift;
    int tmask;
    int var;
};

__device__ __forceinline__ void halfSM(f32x16& p, float& l_reg, bf16x8& paX, bf16x8& paY) {
#pragma unroll
    for (int r = 0; r < 16; ++r) p[r] = __builtin_amdgcn_exp2f(p[r]);
    float ps = 0;
#pragma unroll
    for (int r = 0; r < 16; ++r) ps += p[r];
    l_reg += ps;
#define PK4(P, BASE, OUT) do { unsigned a0, a1, b0, b1; \
    asm volatile("s_nop 0\n\tv_cvt_pk_bf16_f32 %0, %4, %5\n\tv_cvt_pk_bf16_f32 %1, %6, %7\n\tv_cvt_pk_bf16_f32 %2, %8, %9\n\tv_cvt_pk_bf16_f32 %3, %10, %11" \
        : "=&v"(a0), "=&v"(a1), "=&v"(b0), "=&v"(b1) : "v"(P[BASE + 0]), "v"(P[BASE + 1]), "v"(P[BASE + 2]), "v"(P[BASE + 3]), "v"(P[BASE + 4]), "v"(P[BASE + 5]), "v"(P[BASE + 6]), "v"(P[BASE + 7])); \
    u32x4 w = {a0, a1, b0, b1}; OUT = *reinterpret_cast<bf16x8*>(&w); } while (0)
    PK4(p, 0, paX); PK4(p, 8, paY);
#undef PK4
}
template <int NDQ, int DB, bool SHIFT>
__device__ __forceinline__ void qkt(f32x16& p0, f32x16& p1, const char* Ks, const bf16x8* qr, int r32, int hi, float shift) {
    p0 = f32x16{}; p1 = f32x16{};
#pragma unroll
    for (int d0 = 0; d0 < NDQ; ++d0) { const int cb = ((DB + d0) * 16 + hi * 8) * 2;
        const bf16x8 b0 = *reinterpret_cast<const bf16x8*>(Ks + KSWZ(r32, cb));
        const bf16x8 b1 = *reinterpret_cast<const bf16x8*>(Ks + KSWZ(32 + r32, cb));
        p0 = __builtin_amdgcn_mfma_f32_32x32x16_bf16(b0, qr[d0], p0, 0, 0, 0);
        p1 = __builtin_amdgcn_mfma_f32_32x32x16_bf16(b1, qr[d0], p1, 0, 0, 0); }
    if (SHIFT && shift != 0.f) {
        const short one = hi == 0 ? (short)0x3f80 : (short)0, ms = hi == 0 ? (short)f2bf(-shift) : (short)0;
        const bf16x8 af = {one, 0, 0, 0, 0, 0, 0, 0}, bf = {ms, 0, 0, 0, 0, 0, 0, 0};
        p0 = __builtin_amdgcn_mfma_f32_32x32x16_bf16(af, bf, p0, 0, 0, 0);
        p1 = __builtin_amdgcn_mfma_f32_32x32x16_bf16(af, bf, p1, 0, 0, 0); }
}
__device__ __forceinline__ int v_st(int k, int c) { const int kk = (k & ~0xC) | ((k & 4) << 1) | ((k & 8) >> 1); return ((kk >> 3) * 4 + (c >> 5)) * 512 + ((kk & 7) * 32 + (c & 31)) * 2; }
__device__ __forceinline__ int v_rd_base(int lane) { return ((lane & 3) << 3) | (((lane >> 2) & 3) << 6) | (((lane >> 4) & 1) << 5) | (((lane >> 5) & 1) << 8); }
constexpr int v_rd_off(int d0, int ks, int half) { return d0 * 512 + ks * 4096 + half * 2048; }
template <int OFF> __device__ __forceinline__ s16x4 tr_read(int vb) {
    s16x4 r; asm volatile("ds_read_b64_tr_b16 %0, %1 offset:%2" : "=&v"(r) : "v"(vb), "i"(OFF) : "memory"); return r;
}
template <int D0> __device__ __forceinline__ void pv_one(f32x16& od, int vb, bf16x8 pa0, bf16x8 pa1, bf16x8 pa2, bf16x8 pa3) {
    const s16x4 l0 = tr_read<v_rd_off(D0, 0, 0)>(vb), h0 = tr_read<v_rd_off(D0, 0, 1)>(vb), l1 = tr_read<v_rd_off(D0, 1, 0)>(vb), h1 = tr_read<v_rd_off(D0, 1, 1)>(vb);
    const s16x4 l2 = tr_read<v_rd_off(D0, 2, 0)>(vb), h2 = tr_read<v_rd_off(D0, 2, 1)>(vb), l3 = tr_read<v_rd_off(D0, 3, 0)>(vb), h3 = tr_read<v_rd_off(D0, 3, 1)>(vb);
    asm volatile("s_waitcnt lgkmcnt(0)" ::: "memory"); SBAR();
#define PK(L, H) (bf16x8){L[0], L[1], L[2], L[3], H[0], H[1], H[2], H[3]}
    od = __builtin_amdgcn_mfma_f32_32x32x16_bf16(pa0, PK(l0, h0), od, 0, 0, 0);
    od = __builtin_amdgcn_mfma_f32_32x32x16_bf16(pa1, PK(l1, h1), od, 0, 0, 0);
    od = __builtin_amdgcn_mfma_f32_32x32x16_bf16(pa2, PK(l2, h2), od, 0, 0, 0);
    od = __builtin_amdgcn_mfma_f32_32x32x16_bf16(pa3, PK(l3, h3), od, 0, 0, 0);
#undef PK
}
__device__ __forceinline__ void pv_d0(f32x16* o, int vb, bf16x8 pa0, bf16x8 pa1, bf16x8 pa2, bf16x8 pa3) {
    pv_one<0>(o[0], vb, pa0, pa1, pa2, pa3); pv_one<1>(o[1], vb, pa0, pa1, pa2, pa3); pv_one<2>(o[2], vb, pa0, pa1, pa2, pa3); pv_one<3>(o[3], vb, pa0, pa1, pa2, pa3);
}


template <int OFF> __device__ __forceinline__ bf16x8 k_read(int addr) { bf16x8 r; asm volatile("ds_read_b128 %0, %1 offset:%2" : "=&v"(r) : "v"(addr), "i"(OFF) : "memory"); return r; }
#define LWAIT(n) do { asm volatile("s_waitcnt lgkmcnt(" #n ")" ::: "memory"); SBAR(); } while (0)
template <int D0> __device__ __forceinline__ void v_read8(s16x4 (&v)[8], int vb) {
    v[0] = tr_read<v_rd_off(D0, 0, 0)>(vb); v[1] = tr_read<v_rd_off(D0, 0, 1)>(vb); v[2] = tr_read<v_rd_off(D0, 1, 0)>(vb); v[3] = tr_read<v_rd_off(D0, 1, 1)>(vb);
    v[4] = tr_read<v_rd_off(D0, 2, 0)>(vb); v[5] = tr_read<v_rd_off(D0, 2, 1)>(vb); v[6] = tr_read<v_rd_off(D0, 3, 0)>(vb); v[7] = tr_read<v_rd_off(D0, 3, 1)>(vb);
}
__device__ __forceinline__ void pv_mma(f32x16& od, const s16x4 (&v)[8], bf16x8 pa0, bf16x8 pa1, bf16x8 pa2, bf16x8 pa3) {
#define PK(L, H) (bf16x8){L[0], L[1], L[2], L[3], H[0], H[1], H[2], H[3]}
    od = __builtin_amdgcn_mfma_f32_32x32x16_bf16(pa0, PK(v[0], v[1]), od, 0, 0, 0);
    od = __builtin_amdgcn_mfma_f32_32x32x16_bf16(pa1, PK(v[2], v[3]), od, 0, 0, 0);
    od = __builtin_amdgcn_mfma_f32_32x32x16_bf16(pa2, PK(v[4], v[5]), od, 0, 0, 0);
    od = __builtin_amdgcn_mfma_f32_32x32x16_bf16(pa3, PK(v[6], v[7]), od, 0, 0, 0);
#undef PK
}
template <int NDQ, int DB, bool SHIFT>
__device__ __forceinline__ void x_phase(f32x16& p0, f32x16& p1, f32x16 (&o)[4], const bf16x8* qr, const int (&ka)[4], int kd, int vb, bool do_pv, s16x4 (&va)[8],
                                        bf16x8 pa0, bf16x8 pa1, bf16x8 pa2, bf16x8 pa3, float shift, int hi, int var) {
    bf16x8 kf[2 * NDQ]; s16x4 vbk[8];
    int kb[4];
#pragma unroll
    for (int b = 0; b < 4; ++b) kb[b] = ka[b] + (DB >= 4 ? kd : 0);
    asm volatile("s_waitcnt lgkmcnt(0)" ::: "memory");
    SBAR();
#pragma unroll
    for (int b = 0; b < 4; ++b) { kf[2 * b] = k_read<0>(kb[b]); kf[2 * b + 1] = k_read<8192>(kb[b]); }
    if (do_pv) {
        v_read8<1>(vbk, vb); LWAIT(8); pv_mma(o[0], va, pa0, pa1, pa2, pa3); SBAR();
        v_read8<2>(va, vb);  LWAIT(8); pv_mma(o[1], vbk, pa0, pa1, pa2, pa3); SBAR();
        v_read8<3>(vbk, vb); LWAIT(8); pv_mma(o[2], va, pa0, pa1, pa2, pa3); SBAR();
    }
    if constexpr (NDQ == 8) {
#pragma unroll
        for (int b = 0; b < 4; ++b) { kf[8 + 2 * b] = k_read<0>(ka[b] + kd); kf[8 + 2 * b + 1] = k_read<8192>(ka[b] + kd); }
        if (do_pv) { LWAIT(8); pv_mma(o[3], vbk, pa0, pa1, pa2, pa3); SBAR(); } else LWAIT(8);
    } else { if (do_pv) { LWAIT(0); pv_mma(o[3], vbk, pa0, pa1, pa2, pa3); SBAR(); } else LWAIT(0); }
    p0 = f32x16{}; p1 = f32x16{};
#pragma unroll
    for (int d0 = 0; d0 < 4; ++d0) { p0 = __builtin_amdgcn_mfma_f32_32x32x16_bf16(kf[2 * d0], qr[d0], p0, 0, 0, 0); p1 = __builtin_amdgcn_mfma_f32_32x32x16_bf16(kf[2 * d0 + 1], qr[d0], p1, 0, 0, 0); }
    SBAR();
    if constexpr (NDQ == 8) {
        LWAIT(0);
#pragma unroll
        for (int d0 = 4; d0 < 8; ++d0) { p0 = __builtin_amdgcn_mfma_f32_32x32x16_bf16(kf[2 * d0], qr[d0], p0, 0, 0, 0); p1 = __builtin_amdgcn_mfma_f32_32x32x16_bf16(kf[2 * d0 + 1], qr[d0], p1, 0, 0, 0); }
        SBAR();
    }
    if (SHIFT && shift != 0.f) {
        const short one = hi == 0 ? (short)0x3f80 : (short)0, ms = hi == 0 ? (short)f2bf(-shift) : (short)0;
        const bf16x8 af = {one, 0, 0, 0, 0, 0, 0, 0}, bfr = {ms, 0, 0, 0, 0, 0, 0, 0};
        p0 = __builtin_amdgcn_mfma_f32_32x32x16_bf16(af, bfr, p0, 0, 0, 0); p1 = __builtin_amdgcn_mfma_f32_32x32x16_bf16(af, bfr, p1, 0, 0, 0); SBAR();
    }
}

struct NaCtx { int rsA, rq, rsq, cq, csq; const float* bias; };
template <bool NA, int HALF_>
__device__ __forceinline__ void na_hook(f32x16& p, int t, const NaCtx& n, int hi) {
    if constexpr (NA) {
        if (t >= 4) {
            const int kr = n.rsA + t - 4;
            if (kr < n.rsq || kr >= n.rsq + 8) {
#pragma unroll
                for (int r = 0; r < 16; ++r) p[r] = -1e30f;
            } else {
                const float* brow = n.bias + (kr - n.rq + 7) * 31 + 15 - n.cq + 32 * HALF_;
#pragma unroll
                for (int rg = 0; rg < 16; rg += 8) {
                    float b[8];
#pragma unroll
                    for (int r = 0; r < 8; ++r) b[r] = brow[crow(rg + r, hi)];
                    asm volatile("s_waitcnt lgkmcnt(0)" ::: "memory");
#pragma unroll
                    for (int r = 0; r < 8; ++r) { const int kc = crow(rg + r, hi) + 32 * HALF_; p[rg + r] = (kc >= n.csq && kc < n.csq + 16) ? p[rg + r] + b[r] : -1e30f; }
                }
            }
        }
    }
}

template <int NDQ, int DB, bool NA, int EPI, bool SHIFT>
__device__ __forceinline__ void attn_body(const Unit& u, char* lds, int tid) {
    asm volatile("" : "+v"(tid));
    const int wid = __builtin_amdgcn_readfirstlane(tid >> 6), lane = tid & 63, r32 = lane & 31, hi = lane >> 5;
    const bool trail = wid >= 4;
    float* li_l = (float*)(lds + OFF_WS) + wid * 64;
    float l_reg = 0; f32x16 o[4] = {}; bf16x8 qr[NDQ]; const float shift = u.shift;
    typedef __attribute__((address_space(1))) const bf16x8 gbf16x8;
    const bf16_t* Qw = u.Q + (long)(wid * QBLK + r32) * LDP + hi * 8 + DB * 16;
#pragma unroll
    for (int d0 = 0; d0 < NDQ; ++d0) qr[d0] = *(gbf16x8*)(Qw + d0 * 16);
    const int vb0 = (int)(uintptr_t)lds + SHM_K + v_rd_base(lane);
    int ka0[4];
#pragma unroll
    for (int b = 0; b < 4; ++b) ka0[b] = (int)(uintptr_t)lds + r32 * 256 + 16 * ((2 * b) ^ (hi ^ (r32 & 7))) + 128 * ((r32 >> 3) & 1);
    const int kd = 128 - 256 * ((r32 >> 3) & 1);
    NaCtx na;
    if constexpr (NA) { na.rsA = u.rsA; na.rq = u.r0 + (wid >> 1); na.rsq = min(max(na.rq - 4, 0), 120); na.cq = 32 * (wid & 1) + r32; na.csq = min(max(na.cq - 8, 0), 48); na.bias = (const float*)(lds + OFF_BIAS) + BIAS_PAD; }
    unsigned koff[2], voff[2];
#pragma unroll
    for (int i = 0; i < 2; ++i) { const int G = wid * 128 + i * 64 + lane;
        { const int row = G >> 4, g = (G & 15) ^ (row & 15); koff[i] = (unsigned)(row * LDP + g * 8) * 2u; }
        { const int sub = G >> 5, r8 = (G >> 2) & 7, c4 = G & 3, kk = (sub >> 2) * 8 + r8, cg = (sub & 3) * 4 + c4, k = kk; voff[i] = (unsigned)(k * LDP + cg * 8) * 2u; } }
    const char* Kg = (const char*)u.K; const char* Vg = (const char*)u.V;
    LAS unsigned char* ldsL = (LAS unsigned char*)(unsigned)(uintptr_t)lds;
#define TROW(t) (NA ? ((t) < 4 ? SEQ + 64 * ((t) & u.tmask) : (u.rsA + (((t) - 4) & u.tmask)) * 64) : u.key0 + 64 * ((t) & u.tmask))
    const __amdgpu_buffer_rsrc_t rK_ = __builtin_amdgcn_make_buffer_rsrc((void*)launder_uniform(Kg), 0, 0x7fffffff, 0x00020000);
    const __amdgpu_buffer_rsrc_t rV_ = __builtin_amdgcn_make_buffer_rsrc((void*)launder_uniform(Vg), 0, 0x7fffffff, 0x00020000);
#define DMA_TILE(t, boff) do { const int rb_ = __builtin_amdgcn_readfirstlane((TROW(t)) * (LDP * 2)); _Pragma("unroll") for (int i_ = 0; i_ < 2; ++i_) { \
        __builtin_amdgcn_raw_ptr_buffer_load_lds(rK_, (LAS void*)(ldsL + (boff) + wid * 2048 + i_ * 1024), 16, koff[i_], rb_, 0, 0); \
        __builtin_amdgcn_raw_ptr_buffer_load_lds(rV_, (LAS void*)(ldsL + (boff) + SHM_K + wid * 2048 + i_ * 1024), 16, voff[i_], rb_, 0, 0); } } while (0)
#define VWAIT() asm volatile("s_waitcnt vmcnt(0)" ::: "memory")
#define PBAR() do { asm volatile("s_waitcnt lgkmcnt(0)" ::: "memory"); __builtin_amdgcn_s_barrier(); asm volatile("" ::: "memory"); } while (0)
    bf16x8 pa0, pa1, pa2, pa3; f32x16 p0, p1; s16x4 va[8]; const int NT = u.nt;
#if MK_ATT_1BAR
#define SLOT(t) (((t) & (NRING - 1)) * TILE_B)
#define ENDI(k) do { if ((k) + 2 < NT) asm volatile("s_waitcnt vmcnt(4)" ::: "memory"); else VWAIT(); PBAR(); } while (0)
    DMA_TILE(0, 0); DMA_TILE(1, TILE_B); VWAIT(); PBAR();
    if (trail && 2 < NT) DMA_TILE(2, 2 * TILE_B);
    int b_prev = 3 * TILE_B, b_cur = 0;
    for (int i = 0; i < NT; ++i) {
        { int ka[4];
#pragma unroll
          for (int b = 0; b < 4; ++b) ka[b] = ka0[b] + b_cur;
          x_phase<NDQ, DB, SHIFT>(p0, p1, o, qr, ka, kd, vb0 + b_prev, i >= 1, va, pa0, pa1, pa2, pa3, shift, hi, 0); }
        if (trail) ENDI(i);
        { const int td = trail ? i + 3 : i + 2; if (td < NT) DMA_TILE(td, SLOT(td)); }
        na_hook<NA, 0>(p0, i, na, hi); halfSM(p0, l_reg, pa0, pa1); SBAR();
        na_hook<NA, 1>(p1, i, na, hi); halfSM(p1, l_reg, pa2, pa3);
        asm volatile("" : "+v"(l_reg));
        SBAR(); v_read8<0>(va, vb0 + b_cur);
        if (!trail) ENDI(i); else { asm volatile("" ::: "memory"); SBAR(); }
        b_prev = b_cur; b_cur = (b_cur + TILE_B) & (NRING * TILE_B - 1);
    }
#undef SLOT
#undef ENDI
#else
    DMA_TILE(0, 0); DMA_TILE(1, TILE_B); VWAIT(); PBAR();
    if (trail) PBAR();
    int b_prev = 3 * TILE_B, b_cur = 0;
    for (int i = 0; i < NT; ++i) {
        { int ka[4];
#pragma unroll
          for (int b = 0; b < 4; ++b) ka[b] = ka0[b] + b_cur;
          x_phase<NDQ, DB, SHIFT>(p0, p1, o, qr, ka, kd, vb0 + b_prev, i >= 1, va, pa0, pa1, pa2, pa3, shift, hi, u.var); }
        VWAIT();
        PBAR();
        if (i + 2 < NT && !(u.var & 8)) DMA_TILE(i + 2, (b_cur + 2 * TILE_B) & (NRING * TILE_B - 1));
        if (!(u.var & 2)) { na_hook<NA, 0>(p0, i, na, hi); halfSM(p0, l_reg, pa0, pa1); SBAR();
        na_hook<NA, 1>(p1, i, na, hi); halfSM(p1, l_reg, pa2, pa3); }
        asm volatile("" : "+v"(l_reg));
        SBAR(); if (!(u.var & 16)) v_read8<0>(va, vb0 + b_cur);
        PBAR();
        b_prev = b_cur; b_cur = (b_cur + TILE_B) & (NRING * TILE_B - 1);
    }
#endif
    {
        s16x4 vbk[8];
        v_read8<1>(vbk, vb0 + b_prev); LWAIT(8); pv_mma(o[0], va, pa0, pa1, pa2, pa3); SBAR();
        v_read8<2>(va, vb0 + b_prev);  LWAIT(8); pv_mma(o[1], vbk, pa0, pa1, pa2, pa3); SBAR();
        v_read8<3>(vbk, vb0 + b_prev); LWAIT(8); pv_mma(o[2], va, pa0, pa1, pa2, pa3); SBAR();
        LWAIT(0); pv_mma(o[3], vbk, pa0, pa1, pa2, pa3); SBAR();
    }
#if !MK_ATT_1BAR
    if (!trail) PBAR();
#endif
    { auto rr = __builtin_amdgcn_permlane32_swap(__float_as_uint(l_reg), __float_as_uint(l_reg), false, false); l_reg = __uint_as_float(rr[0]) + __uint_as_float(rr[1]); }
    if (hi == 0) li_l[r32] = l_reg; asm volatile("s_waitcnt lgkmcnt(0)" ::: "memory");
    float rli[16];
#pragma unroll
    for (int r = 0; r < 16; ++r) rli[r] = __builtin_amdgcn_rcpf(li_l[crow(r, hi)]);
    if constexpr (EPI == 0) {
        bf16_t* Ow = u.O + (long)(wid * QBLK) * u.ldo + r32; LAUNDER(Ow);
#pragma unroll
        for (int r = 0; r < 16; ++r) { const int orow = crow(r, hi);
#pragma unroll
            for (int d0 = 0; d0 < 4; ++d0) Ow[(long)orow * u.ldo + d0 * 32] = f2bf(o[d0][r] * rli[r]); }
    } else if constexpr (EPI == 1) {
        float* Sw = u.S + (long)(wid * QBLK) * 512 + r32; LAUNDER(Sw);
#pragma unroll
        for (int r = 0; r < 16; ++r) { const int orow = crow(r, hi);
#pragma unroll
            for (int d0 = 0; d0 < 4; ++d0) Sw[(long)orow * 512 + d0 * 32] = o[d0][r] * rli[r]; }
    } else {
        const float* Sw = u.S + (long)(wid * QBLK) * 512 + r32; bf16_t* Ow = u.O + (long)(wid * QBLK) * u.ldo + r32; LAUNDER(Sw); LAUNDER(Ow);
        float gg[4];
#pragma unroll
        for (int d0 = 0; d0 < 4; ++d0) gg[d0] = u.gsub[d0 * 32 + r32] * u.osc;
#pragma unroll
        for (int r = 0; r < 16; ++r) { const int orow = crow(r, hi); float v[4]; float ss = 0.f;
#pragma unroll
            for (int d0 = 0; d0 < 4; ++d0) { v[d0] = Sw[(long)orow * 512 + d0 * 32] - u.lam * (o[d0][r] * rli[r]); ss += v[d0] * v[d0]; }
            ss = half_sum(ss);
            const float rstd = __builtin_amdgcn_rsqf(ss * (1.0f / 128.0f) + EPS);
#pragma unroll
            for (int d0 = 0; d0 < 4; ++d0) Ow[(long)orow * u.ldo + d0 * 32] = f2bf(v[d0] * rstd * gg[d0]); asm volatile("" ::: "memory"); }
    }
    asm volatile("s_waitcnt vmcnt(0) lgkmcnt(0)" ::: "memory");
    __builtin_amdgcn_s_barrier();
    asm volatile("" ::: "memory");
#undef TROW
#undef DMA_TILE
#undef VWAIT
#undef PBAR
}
}

__device__ __forceinline__ int q_pop(unsigned* ctr, char* lds, int tid_) {
    volatile int* slot = (volatile int*)(lds + att::SHM_TOTAL);
    __syncthreads();
    if (tid_ == 0) *slot = (int)__hip_atomic_fetch_add(ctr, 1u, __ATOMIC_RELAXED, __HIP_MEMORY_SCOPE_AGENT);
    __syncthreads();
    return *slot;
}
__device__ __forceinline__ void phase_attn(int wid_k, int l, char* lds, int rep) {
    PHASE_ENTER(cin)
    unsigned* qctr = (unsigned*)(c.ws + WS_CTL + 16384) + (l + 4 * rep) * 256;
    bf16_t* const oa_ = rep ? (bf16_t*)(c.ws + WS_ACT) : c.oa(); bf16_t* const ob_ = oa_ + 1024; bf16_t* const oc_ = oa_ + 1536; float* const ocs_ = rep ? (float*)(c.ws + WS_ACT + (size_t)MT * 2048 * 2) : c.ocs();
    const bool last = (l == DEPTH - 1);
    const float lam = c.lam()[l], osc = 1.0f - (0.8f - 0.6f * expf(-0.3f * (float)l));
    float shA, shB, shC;
    {
        const int lane = tid_ & 63;
        const float mA = 11.313708f * vmax_abs(c.in[I_GQA] + l * 128, 128, lane) * vmax_abs(c.in[I_GKA] + l * 128, 128, lane) * 1.4426950f;
        const float mB = (11.313708f * vmax_abs(c.in[I_GQB] + l * 128, 128, lane) * vmax_abs(c.in[I_GKB] + l * 128, 128, lane) + vmax_abs(c.in[I_RPB] + (size_t)l * 4 * att::BIAS_N, 4 * att::BIAS_N, lane)) * 1.4426950f;
        const float mC = 8.0f * vmax_abs(c.in[I_GQC] + l * 64, 64, lane) * vmax_abs(c.in[I_GKC] + l * 64, 64, lane) * 1.4426950f;
#define SGPR_F(x_) __uint_as_float(__builtin_amdgcn_readfirstlane(__float_as_uint(x_)))
        shA = SGPR_F(fmaxf(0.f, mA - 100.f)); shB = SGPR_F(fmaxf(0.f, mB - 100.f)); shC = SGPR_F(fmaxf(0.f, mC - 100.f));
#undef SGPR_F
    }
    for (;;) {
        const int id = q_pop(qctr + 0, lds, tid_);
        if (id >= 128 + (last ? 0 : 4)) break;
        att::Unit u{}; u.tmask = (rep && MK_ATT_VARIANT == 1) ? 0 : ~0; u.var = rep ? MK_ATT_VARIANT : 0; int head, qrow0;
        if (id < 128) { head = id >> 5; qrow0 = (id & 31) * 256; u.nt = MT / 64; u.key0 = 0; }
        else { head = id - 128; qrow0 = SEQ; u.nt = CTX / 64; u.key0 = SEQ; }
        u.Q = c.P() + (size_t)qrow0 * DIN + C_QC + head * 128; u.K = c.P() + C_KC + head * 128; u.V = c.P() + C_VC + head * 128;
        u.O = oc_ + (size_t)qrow0 * 2048 + head * 128; u.ldo = 2048; u.S = ocs_ + (size_t)qrow0 * 512 + head * 128;
        u.gsub = c.in[I_GSUB] + l * 128; u.lam = lam; u.osc = osc; u.shift = shC;
        if (__builtin_expect(shC != 0.f, 0)) { att::attn_body<4, 0, false, 1, true>(u, lds, tid_); att::attn_body<4, 4, false, 2, true>(u, lds, tid_); }
        else { att::attn_body<4, 0, false, 1, false>(u, lds, tid_); att::attn_body<4, 4, false, 2, false>(u, lds, tid_); }
    }
    for (;;) {
        const int id = q_pop(qctr + 64, lds, tid_);
        if (id >= 256 + (last ? 0 : 12)) break;
        att::Unit u{}; u.tmask = (rep && MK_ATT_VARIANT == 1) ? 0 : ~0; u.var = rep ? MK_ATT_VARIANT : 0;
        if (id < 256) { const int head = id >> 5, qb = id & 31;
            u.Q = c.P() + (size_t)(qb * 256) * DIN + C_QA + head * 128; u.K = c.P() + C_KA + (head >> 2) * 128; u.V = c.P() + C_VA + (head >> 2) * 128;
            u.nt = MT / 64; u.key0 = 0; u.O = oa_ + (size_t)(qb * 256) * 2048 + head * 128; u.ldo = 2048; }
        else if (id < 264) { const int head = id - 256;
            u.Q = c.P() + (size_t)SEQ * DIN + C_QA + head * 128; u.K = c.P() + C_KA + (head >> 2) * 128; u.V = c.P() + C_VA + (head >> 2) * 128;
            u.nt = CTX / 64; u.key0 = SEQ; u.O = oa_ + (size_t)SEQ * 2048 + head * 128; u.ldo = 2048; }
        else { const int head = id - 264;
            u.Q = c.P() + (size_t)SEQ * DIN + C_QB + head * 128; u.K = c.P() + C_KB + head * 128; u.V = c.P() + C_VB + head * 128;
            u.nt = CTX / 64; u.key0 = SEQ; u.O = ob_ + (size_t)SEQ * 2048 + head * 128; u.ldo = 2048; }
        u.shift = id < 264 ? shA : shB;
        if (__builtin_expect(u.shift != 0.f, 0)) att::attn_body<8, 0, false, 0, true>(u, lds, tid_); else att::attn_body<8, 0, false, 0, false>(u, lds, tid_);
    }
    for (;;) {
        const int id = q_pop(qctr + 128, lds, tid_);
        if (id >= 128) break;
        const int head = id >> 5, qb = id & 31, r0 = qb * 4;
        float* bt = (float*)(lds + att::OFF_BIAS);
        for (int i = tid_; i < 2 * att::BIAS_PAD + 480; i += 512) { const int k = i - att::BIAS_PAD; bt[i] = (k >= 0 && k < att::BIAS_N) ? c.in[I_RPB][((size_t)l * 4 + head) * att::BIAS_N + k] * 1.4426950408889634f : 0.f; }
        __syncthreads();
        att::Unit u{}; u.tmask = (rep && MK_ATT_VARIANT == 1) ? 0 : ~0; u.var = rep ? MK_ATT_VARIANT : 0;
        u.Q = c.P() + (size_t)(qb * 256) * DIN + C_QB + head * 128; u.K = c.P() + C_KB + head * 128; u.V = c.P() + C_VB + head * 128;
        u.nt = 16; u.r0 = r0; u.rsA = min(max(r0 - 4, 0), 116);
        u.O = ob_ + (size_t)(qb * 256) * 2048 + head * 128; u.ldo = 2048; u.shift = shB;
        att::attn_body<8, 0, true, 0, true>(u, lds, tid_);
    }
    if (!rep && l + 1 < DEPTH && CONV_NATT > 0) {
        for (;;) {
            const int ch = q_pop(qctr + 192, lds, tid_);
            if (ch >= CONV_NATT / CONV_CHUNK) break;
            __syncthreads();
            conv_run(c, lds, tid_of(wid_k), ch * CONV_CHUNK, ch * CONV_CHUNK + CONV_CHUNK, 1, 1, l + 1);
        }
    }
}

constexpr int PH_PER_LAYER = 10, PH_FINAL = 1 + DEPTH * PH_PER_LAYER, N_PHASES = PH_FINAL + 1;

__global__ void __launch_bounds__(512, 2) fwd(Args a) {
    extern __shared__ __attribute__((aligned(16))) unsigned char lds_raw[];
    char* lds = (char*)lds_raw;
    volatile LAS unsigned* xbw = (volatile LAS unsigned*)(LAS unsigned char*)(lds_raw) + (LDS_BYTES - 16) / 4;
    const int wid_k = __builtin_amdgcn_readfirstlane(threadIdx.x >> 6);
    if (tid_of(wid_k) == 0) { xbw[0] = 0u; xbw[1] = 0u; xbw[2] = 0u; xbw[3] = 0u; }
    __syncthreads();
    const int lo = a.ph_lo, hi = a.ph_hi;
    if (hi - lo > 1) { Ctx c = make_ctx(); (void)xcd_barrier_post((unsigned*)(c.ws + WS_CTL), xbw, tid_of(wid_k)); }
#define IN(k) (lo <= (k) && (k) < hi)
#define SEAM(k) do { if (IN((k) + 1)) { Ctx cb_ = make_ctx(); XcdBarrier b2_; b2_.bar = (unsigned*)(cb_.ws + WS_CTL); b2_.x = xb_xcc_id(); b2_.st = xbw; xcd_barrier(b2_, tid_of(wid_k)); if (MK_PROBE == 10) xcd_barrier(b2_, tid_of(wid_k)); } } while (0)

    if (IN(0)) { phase_prologue(wid_k, lds); if (MK_PROBE == 1) { __syncthreads(); phase_prologue(wid_k, lds); } SEAM(0); }
    for (int l = 0; l < DEPTH; ++l) {
        const int pb = 1 + l * PH_PER_LAYER; const bool lastl = (l == DEPTH - 1);
#define FRESH() Ctx c = make_ctx(); int tid_ = tid_of(wid_k); PG8_LAS unsigned char* ldsL = (PG8_LAS unsigned char*)lds_raw; (void)tid_; (void)ldsL; \
        const bf16_t* wl = c.wt() + (size_t)l * LAYER_ELEMS; const float* modx = c.mod() + ((size_t)l * 2 + 0) * NMOD; const float* modc = c.mod() + ((size_t)l * 2 + 1) * NMOD; (void)wl; (void)modx; (void)modc;
        if (IN(pb + 0)) { phase_norm(wid_k, l, 0); if (MK_PROBE == 4) phase_norm(wid_k, l, 0); SEAM(pb + 0); }
#define FASTG(Aptr, Bptr, MM, NN, KK, EPI) do { pg8::Gemm g_{Aptr, Bptr, MM, NN, KK}; pg8::StaticOrder S_; S_.init(MM, NN, (int)gridDim.x, (int)blockIdx.x); pg8::gemm_phase(ldsL, g_, S_, EPI, tid_); } while (0)
#if MK_FAST_GEMM
        if (IN(pb + 1)) { FRESH(); pg8::EpiWin e{c.P(), c.in[I_GQA] + l * 128, c.in[I_GKA] + l * 128, c.in[I_GQB] + l * 128, c.in[I_GKB] + l * 128, c.in[I_GQC] + l * 64, c.in[I_GKC] + l * 64, (LAS float*)(ldsL + pg8::STAGE_BYTES)};
#if MK_GATE_FP8
            {
                pg8::Gemm gq_{c.u(), wl + O_WIN, MT, C_G, DM}; pg8::StaticOrder Sq_; Sq_.init(MT, C_G, (int)gridDim.x, (int)blockIdx.x); pg8::gemm_phase(ldsL, gq_, Sq_, e, tid_);
                pg8::EpiGate eg{c.P()};
                pg8::Gemm gg_{(const bf16_t*)(c.ws + WS_U8), (const bf16_t*)(c.ws + WS_WG8 + (size_t)l * NGATE * DM), MT, NGATE, DM / 2};
                pg8::GateOrder Sg_; Sg_.init((int)blockIdx.x, (int)gridDim.x); pg8::gemm_phase<pg8::EpiGate, pg8::GateOrder, true>(ldsL, gg_, Sg_, eg, tid_);
            }
#else
            FASTG(c.u(), wl + O_WIN, MT, DIN, DM, e);
#endif
            if (IN(pb + 3)) SEAM(pb + 2); }
#else
        if (IN(pb + 1)) { FRESH(); SEpiWin e{c.R(), c.P()}; simple_gemm(wid_k, c.u(), wl + O_WIN, MT, DIN, DM, e); SEAM(pb + 1); }
#endif
#if !MK_FAST_GEMM
        if (IN(pb + 2)) { phase_qknorm(wid_k, l); SEAM(pb + 2); }
#endif
        if (IN(pb + 3)) { phase_attn(wid_k, l, lds, 0); if (MK_PROBE == 2) { __syncthreads(); phase_attn(wid_k, l, lds, 1); } SEAM(pb + 3); }
        if (IN(pb + 4)) {
            for (int rp_ = 0; rp_ < (MK_PROBE == 7 ? 2 : 1); ++rp_) { FRESH(); pg8::EpiBrChain e{c.mb(), c.P()};
                pg8::StaticOrder S_; S_.init(SEQ, DM, (int)gridDim.x, (int)blockIdx.x); pg8::Unit u_;
                for (int ui_ = 0; S_.next(ui_, u_); ++ui_) {
                    pg8::OneUnit O_{u_}; f32x4 acc_[2][2][4][2];
                    { pg8::Gemm g_{c.oa(), wl + O_BRA, SEQ, DM, 1024, DM, DM}; pg8::gemm_phase_core<pg8::EpiBrChain, pg8::OneUnit, false, true>(ldsL, g_, O_, e, tid_, acc_); }
                    e.scale<0>(acc_, u_, tid_);
                    { pg8::Gemm g_{c.ob(), wl + O_BRA + 1024, SEQ, DM, 512, DM, DM}; pg8::gemm_phase_core<pg8::EpiBrChain, pg8::OneUnit, true, true>(ldsL, g_, O_, e, tid_, acc_); }
                    e.scale<1>(acc_, u_, tid_);
                    { pg8::Gemm g_{c.oc(), wl + O_BRA + 1536, SEQ, DM, 512, DM, DM}; pg8::gemm_phase_core<pg8::EpiBrChain, pg8::OneUnit, true, false>(ldsL, g_, O_, e, tid_, acc_); }
                } }
            if (!lastl) { FRESH(); SEpiBr4 e{c.mb(), c.P()}; slab_gemm5<true>(wid_k, lds, c.oa(), DM, wl + O_BRA, DM, SEQ, CTX, DM, DM, e); }
            SEAM(pb + 4);
        }
#if MK_FAST_GEMM
        if (IN(pb + 5)) { FRESH(); pg8::EpiRes e{l == 0 ? c.in[I_X] : c.h(), modx + 2 * DM, modc + 2 * DM, c.h()}; FASTG(c.mb(), wl + O_WO, SEQ, DM, DM, e); if (MK_PROBE == 8) { pg8::EpiRes e2{c.mf(), modx + 2 * DM, modc + 2 * DM, c.mf()}; FASTG(c.mb(), wl + O_WO, SEQ, DM, DM, e2); }
            if (!lastl) { SEpiRes4 es{c.h(), modx + 2 * DM, modc + 2 * DM, l == 0 ? c.in[I_CTX] - (size_t)SEQ * DM : c.h()}; slab_gemm5<false>(wid_k, lds, c.mb(), DM, wl + O_WO, DM, SEQ, CTX, DM, DM, es); } SEAM(pb + 5); }
#else
        if (IN(pb + 5)) { FRESH(); SEpiRes e{c.h(), modx + 2 * DM, modc + 2 * DM, c.h()}; simple_gemm(wid_k, c.mb(), wl + O_WO, MT, DM, DM, e); SEAM(pb + 5); }
#endif
        if (IN(pb + 6)) { phase_norm(wid_k, l, 1); if (MK_PROBE == 4) phase_norm(wid_k, l, 1); SEAM(pb + 6); }
#if MK_FAST_GEMM
        if (IN(pb + 7)) { FRESH(); pg8::EpiUp e{c.act(), c.edge(), c.in[I_CONVW] + (size_t)l * 3 * DUP, c.in[I_CONVB] + (size_t)l * DUP}; FASTG(c.u(), wl + O_WUP, (lastl ? SEQ : MT), DUP, DM, e); if (MK_PROBE == 6) FASTG(c.u(), wl + O_WUP, (lastl ? SEQ : MT), DUP, DM, e);
            if (!lastl && MK_CONV_NUP > 0) {
                unsigned* fq_ = (unsigned*)(c.ws + WS_CTL + 16384) + l * 256 + 224;
                for (;;) { const int ch = q_pop(fq_, lds, tid_of(wid_k)); if (ch >= MK_CONV_NUP / CONV_CHUNK) break; __syncthreads();
                    conv_run(c, lds, tid_of(wid_k), CONV_NATT + ch * CONV_CHUNK, CONV_NATT + ch * CONV_CHUNK + CONV_CHUNK, 1, 1, l + 1); } }
            SEAM(pb + 7); }
#else
        if (IN(pb + 7)) { FRESH(); SEpiY e{c.Y()}; simple_gemm(wid_k, c.u(), wl + O_WUP, MT, DUP, DM, e); SEAM(pb + 7); }
#endif
#if MK_FAST_GEMM
        if (IN(pb + 8)) { phase_convfix(wid_k, l); if (MK_PROBE == 3) phase_convfix(wid_k, l); SEAM(pb + 8); }
#else
        if (IN(pb + 8)) { phase_conv(wid_k, l); SEAM(pb + 8); }
#endif
#if MK_FAST_GEMM
        if (IN(pb + 9)) { FRESH(); pg8::EpiRes e{c.h(), modx + 5 * DM, modc + 5 * DM, lastl ? c.out : c.h()}; FASTG(c.act(), wl + O_WDN, SEQ, DM, DFF, e); if (MK_PROBE == 9) { pg8::EpiRes e2{c.mf(), modx + 5 * DM, modc + 5 * DM, c.mf()}; FASTG(c.act(), wl + O_WDN, SEQ, DM, DFF, e2); }
            if (!lastl) { SEpiRes4 es{c.h(), modx + 5 * DM, modc + 5 * DM, c.h()}; slab_gemm5<false>(wid_k, lds, c.act(), DFF, wl + O_WDN, DFF, SEQ, CTX, DM, DFF, es); SEAM(pb + 9); } }
#else
        if (IN(pb + 9)) { FRESH(); SEpiRes e{c.h(), modx + 5 * DM, modc + 5 * DM, c.h()}; simple_gemm(wid_k, c.act(), wl + O_WDN, MT, DM, DFF, e); SEAM(pb + 9); }
#endif
#undef FASTG
#undef FRESH
    }
#if !MK_FAST_GEMM
    if (IN(PH_FINAL)) phase_copy_out(wid_k);
#endif
#undef IN
#undef SEAM
}

extern "C" void kernel_launch(void* const* d_in, const int* in_sizes, int n_in, void* d_out, int out_size, void* d_ws, size_t ws_size, hipStream_t stream) {
    static int grid = 0;
    if (grid == 0) {
        if (n_in != 29 || out_size != SEQ * DM || ws_size < WS_END) { fprintf(stderr, "kernel_launch: unexpected shapes: n_in %d out %d ws %zu (need %zu)\n", n_in, out_size, ws_size, (size_t)WS_END); grid = -1; return; }
        int dev = 0, cus = 0, per_cu = 0;
        if (hipGetDevice(&dev) != hipSuccess || hipDeviceGetAttribute(&cus, hipDeviceAttributeMultiprocessorCount, dev) != hipSuccess) { grid = -1; return; }
        if (hipFuncSetAttribute((const void*)fwd, hipFuncAttributeMaxDynamicSharedMemorySize, LDS_BYTES) != hipSuccess) { fprintf(stderr, "kernel_launch: hipFuncSetAttribute failed\n"); grid = -1; return; }
        if (hipOccupancyMaxActiveBlocksPerMultiprocessor(&per_cu, (const void*)fwd, 512, LDS_BYTES) != hipSuccess || per_cu < 1) fprintf(stderr, "kernel_launch: occupancy query reports %d\n", per_cu);
        (void)hipGetLastError();
        grid = cus;
    }
    if (grid < 0) return;
    (void)hipMemsetAsync((char*)d_ws + WS_CTL, 0, CTL_BYTES, stream);
    Args a{};
    for (int i = 0; i < 29; ++i) a.in[i] = (const float*)d_in[i];
    a.out = (float*)d_out; a.ws = (unsigned char*)d_ws;
#if MK_ONE_LAUNCH
    a.ph_lo = 0; a.ph_hi = N_PHASES;
    hipLaunchKernelGGL(fwd, dim3(grid), dim3(512), LDS_BYTES, stream, a);
#else
    for (int p = 0; p < N_PHASES; ++p) { a.ph_lo = p; a.ph_hi = p + 1; hipLaunchKernelGGL(fwd, dim3(grid), dim3(512), LDS_BYTES, stream, a); }
#endif
    const hipError_t le = hipPeekAtLastError();
    if (le != hipSuccess) fprintf(stderr, "kernel_launch: launch failed: %s\n", hipGetErrorName(le));
}
```

```cpp
#include <hip/hip_runtime.h>
#include <cstdio>
#include <cstdint>
#include <cstddef>

#define LAS __attribute__((address_space(3)))
typedef unsigned short bf16_t;
typedef short bf16x8 __attribute__((ext_vector_type(8)));
typedef short s16x4 __attribute__((ext_vector_type(4)));
typedef float f32x4 __attribute__((ext_vector_type(4)));
typedef float f32x16 __attribute__((ext_vector_type(16)));
typedef unsigned u32x4 __attribute__((ext_vector_type(4)));
typedef unsigned u32x2 __attribute__((ext_vector_type(2)));

#ifndef MK_FAST_GEMM
#define MK_FAST_GEMM 1
#endif
#ifndef MK_PROBE
#define MK_PROBE 0
#endif
#ifndef MK_ATT_VARIANT
#define MK_ATT_VARIANT 0
#endif
#ifndef MK_GATE_FP8
#define MK_GATE_FP8 1
#endif
#ifndef MK_ATT_1BAR
#define MK_ATT_1BAR 1
#endif
#ifndef MK_ONE_LAUNCH
#define MK_ONE_LAUNCH 1
#endif

constexpr int DM = 2048, SEQ = 8192, CTX = 256, MT = SEQ + CTX, DEPTH = 4;
constexpr int DIN = 10752, DFF = 5504, DUP = 2 * DFF, NMOD = 6 * DM;
constexpr int RW = 3328;
constexpr int C_QA = 0, C_KA = 1024, C_VA = 1280, C_QB = 1536, C_KB = 2048, C_VB = 2560, C_QC = 3072, C_KC = 3584, C_VC = 4096, C_G = 4608;
constexpr float EPS = 1e-6f;

constexpr size_t O_WIN = 0, O_BRA = O_WIN + (size_t)DIN * DM, O_BRB = O_BRA + (size_t)DM * 1024, O_BRC = O_BRB + (size_t)DM * 512,
                 O_WO = O_BRC + (size_t)DM * 512, O_WUP = O_WO + (size_t)DM * DM, O_WDN = O_WUP + (size_t)DUP * DM, LAYER_ELEMS = O_WDN + (size_t)DM * DFF;

constexpr size_t al256(size_t x) { return (x + 255) / 256 * 256; }
constexpr size_t WS_CTL = 0, CTL_BYTES = 65536;
constexpr size_t WS_MOD = WS_CTL + CTL_BYTES;
constexpr size_t WS_LAM = al256(WS_MOD + (size_t)DEPTH * 2 * NMOD * 4);
constexpr size_t WS_H = al256(WS_LAM + 256);
constexpr size_t WS_U = al256(WS_H + (size_t)MT * DM * 4);
constexpr size_t WS_WT = al256(WS_U + (size_t)MT * DM * 2);
constexpr size_t WS_P = al256(WS_WT + (size_t)DEPTH * LAYER_ELEMS * 2);
constexpr size_t WS_R = al256(WS_P + (size_t)MT * DIN * 2);
constexpr size_t WS_U8 = WS_R;
constexpr size_t WS_WG8 = al256(WS_U8 + (size_t)MT * DM);
constexpr int NGATE = 3 * DM;
static_assert(WS_WG8 + (size_t)DEPTH * NGATE * DM <= WS_R + (size_t)MT * RW * 4, "fp8 buffers fit the R region");
constexpr size_t WS_OA = al256(WS_R + (size_t)MT * RW * 4);
constexpr size_t WS_OB = al256(WS_OA + (size_t)MT * 1024 * 2);
constexpr size_t WS_OC = al256(WS_OB + (size_t)MT * 512 * 2);
constexpr size_t WS_OCS = al256(WS_OC + (size_t)MT * 512 * 2);
constexpr size_t WS_MF = al256(WS_OCS + (size_t)MT * 512 * 4);
constexpr size_t WS_MB = al256(WS_MF + (size_t)MT * DM * 4);
constexpr size_t WS_PEND = al256(WS_MB + (size_t)MT * DM * 2);
constexpr size_t WS_Y = WS_P;
static_assert(WS_Y + (size_t)MT * DUP * 4 <= WS_PEND, "Y alias");
constexpr int NBLK64 = MT / 64;
constexpr size_t WS_EDGE = WS_P;
constexpr size_t WS_ACT = WS_PEND;
constexpr size_t WS_END = al256(WS_ACT + (size_t)MT * DFF * 2);

constexpr int LDS_BYTES = 147456;

__device__ __forceinline__ unsigned cvt_pk_bf16(float lo, float hi) { unsigned r; asm volatile("s_nop 0\n\tv_cvt_pk_bf16_f32 %0, %1, %2" : "=v"(r) : "v"(lo), "v"(hi)); return r; }
__device__ __forceinline__ bf16_t f2bf(float x) { return (bf16_t)(cvt_pk_bf16(x, 0.f) & 0xffffu); }
__device__ __forceinline__ float sat8(float x) { return __builtin_amdgcn_fmed3f(x, -448.0f, 448.0f); }
__device__ __forceinline__ unsigned pk4_fp8(float a, float b, float c, float d) { unsigned w = __builtin_amdgcn_cvt_pk_fp8_f32(sat8(a), sat8(b), 0u, false); return __builtin_amdgcn_cvt_pk_fp8_f32(sat8(c), sat8(d), w, true); }
__device__ __forceinline__ float bf2f(bf16_t b) { return __uint_as_float(((unsigned)b) << 16); }
template <int O> __device__ __forceinline__ float swz_xor(float v) { return __int_as_float(__builtin_amdgcn_ds_swizzle(__float_as_int(v), (O << 10) | 0x1f)); }
__device__ __forceinline__ float half_sum(float v) { v += swz_xor<16>(v); v += swz_xor<8>(v); v += swz_xor<4>(v); v += swz_xor<2>(v); v += swz_xor<1>(v); return v; }
__device__ __forceinline__ float wave_sum(float v) {
    v = half_sum(v);
    auto rr = __builtin_amdgcn_permlane32_swap(__float_as_uint(v), __float_as_uint(v), false, false);
    return __uint_as_float(rr[0]) + __uint_as_float(rr[1]);
}
__device__ __forceinline__ float wave_max(float v) {
    v = fmaxf(v, swz_xor<16>(v)); v = fmaxf(v, swz_xor<8>(v)); v = fmaxf(v, swz_xor<4>(v)); v = fmaxf(v, swz_xor<2>(v)); v = fmaxf(v, swz_xor<1>(v));
    auto rr = __builtin_amdgcn_permlane32_swap(__float_as_uint(v), __float_as_uint(v), false, false);
    return fmaxf(__uint_as_float(rr[0]), __uint_as_float(rr[1]));
}
__device__ __forceinline__ float vmax_abs(const float* v, int n, int lane) {
    float m = 0.f; for (int i = lane; i < n; i += 64) m = fmaxf(m, fabsf(v[i]));
    return __uint_as_float(__builtin_amdgcn_readfirstlane(__float_as_uint(wave_max(m))));
}
__device__ __forceinline__ float siluf(float x) { return x * __builtin_amdgcn_rcpf(1.0f + __builtin_amdgcn_exp2f(x * -1.4426950408889634f)); }
__device__ __forceinline__ float sigmoidf(float x) { return __builtin_amdgcn_rcpf(1.0f + __builtin_amdgcn_exp2f(x * -1.4426950408889634f)); }

__device__ __forceinline__ int tid_of(int wid_k) { int z; asm volatile("s_mov_b32 %0, 0" : "=s"(z)); return wid_k * 64 + (int)__builtin_amdgcn_mbcnt_hi(~0u, __builtin_amdgcn_mbcnt_lo(~0u, (unsigned)z)); }

#define XB_TMO      128
#define XB_XCNT(j)  (256  + 64 * (j))
#define XB_XSUB(j)  (1280 + 64 * (j))
#define XB_XGEN(j)  (2304 + 64 * (j))
#define XB_TOP      3328
#define XB_TOPGEN   3392
#define XCD_BAR_WORDS 3456
#define XB_SPIN_CAP (1u << 18)
__device__ __forceinline__ unsigned xb_ld(unsigned* p)              { return __hip_atomic_load(p, __ATOMIC_RELAXED, __HIP_MEMORY_SCOPE_AGENT); }
__device__ __forceinline__ unsigned xb_add(unsigned* p, unsigned v) { return __hip_atomic_fetch_add(p, v, __ATOMIC_RELAXED, __HIP_MEMORY_SCOPE_AGENT); }
__device__ __forceinline__ unsigned xb_xcc_id() { return (unsigned)__builtin_amdgcn_s_getreg((3 << 11) | 20) & 0xFu; }
#define XB_SPIN(cond, bar) do { unsigned _sp = 0; while (cond) { __builtin_amdgcn_s_sleep(1); \
    if ((++_sp & 255u) == 0u) { if (xb_ld(&(bar)[XB_TMO])) break; if (_sp > XB_SPIN_CAP) { atomicAdd(&(bar)[XB_TMO], 1u); break; } } } } while (0)
struct XcdBarrier { unsigned* bar; unsigned x; volatile LAS unsigned* st; };
__device__ __forceinline__ XcdBarrier xcd_barrier_post(unsigned* bar, volatile LAS unsigned* st, int tid) {
    XcdBarrier b; b.bar = bar; b.x = xb_xcc_id(); b.st = st;
    if (tid == 0) (void)xb_add(&bar[XB_XCNT(b.x)], 1u);
    return b;
}
__device__ __forceinline__ void xcd_barrier_complete(unsigned* bar, unsigned x, unsigned& nloc, unsigned& nx) {
    const unsigned G = gridDim.x * gridDim.y * gridDim.z;
    unsigned sum, cnt, mine, sp = 0u;
    for (;;) {
        sum = 0u; cnt = 0u; mine = 0u;
#pragma unroll
        for (unsigned j = 0; j < 16; ++j) { const unsigned c = xb_ld(&bar[XB_XCNT(j)]); sum += c; cnt += (c > 0u) ? 1u : 0u; }
        mine = xb_ld(&bar[XB_XCNT(x)]);
        if (sum == G) break;
        __builtin_amdgcn_s_sleep(1);
        if ((++sp & 255u) == 0u) { if (xb_ld(&bar[XB_TMO])) break; if (sp > XB_SPIN_CAP) { atomicAdd(&bar[XB_TMO], 1u); break; } }
    }
    nloc = mine > 0u ? mine : 1u; nx = cnt > 0u ? cnt : 1u;
}
__device__ __forceinline__ void xcd_barrier(const XcdBarrier& b, int tid) {
    asm volatile("s_waitcnt vmcnt(0)" ::: "memory");
    __syncthreads();
    if (tid == 0) {
        unsigned* bar = b.bar;
        __builtin_amdgcn_s_waitcnt(0);
        unsigned nloc = b.st[0], nx = b.st[1];
        if (nloc == 0u) { xcd_barrier_complete(bar, b.x, nloc, nx); b.st[0] = nloc; b.st[1] = nx; }
        const unsigned old = xb_add(&bar[XB_XSUB(b.x)], 1u);
        const unsigned gen = old / nloc;
        if (old + 1u == (gen + 1u) * nloc) {
            __builtin_amdgcn_fence(__ATOMIC_RELEASE, "agent");
            asm volatile("s_waitcnt vmcnt(0)" ::: "memory");
            const unsigned og = xb_add(&bar[XB_TOP], 1u);
            const unsigned tg = og / nx;
            if (og + 1u == (tg + 1u) * nx) xb_add(&bar[XB_TOPGEN], 1u);
            else XB_SPIN(xb_ld(&bar[XB_TOPGEN]) == tg, bar);
            __builtin_amdgcn_fence(__ATOMIC_ACQUIRE, "agent");
            xb_add(&bar[XB_XGEN(b.x)], 1u);
            asm volatile("s_waitcnt vmcnt(0)" ::: "memory");
        } else {
            XB_SPIN(xb_ld(&bar[XB_XGEN(b.x)]) == gen, bar);
            __builtin_amdgcn_fence(__ATOMIC_ACQUIRE, "agent");
            asm volatile("s_waitcnt vmcnt(0)" ::: "memory");
        }
    }
    __syncthreads();
}

template <class T> __device__ __forceinline__ T* launder_uniform(T* p) {
    const unsigned long long v = (unsigned long long)p; unsigned lo = (unsigned)v, hi = (unsigned)(v >> 32);
    asm volatile("" : "+v"(lo), "+v"(hi));
    lo = __builtin_amdgcn_readfirstlane(lo); hi = __builtin_amdgcn_readfirstlane(hi);
    return (T*)(((unsigned long long)hi << 32) | lo);
}
struct Args { const float* in[29]; float* out; unsigned char* ws; int ph_lo, ph_hi; };
enum { I_X = 0, I_C, I_CTX, I_CCTX, I_WMOD, I_BMOD, I_GN1, I_WIN, I_GQA, I_GKA, I_GQB, I_GKB, I_RPB, I_GQC, I_GKC, I_LQ1, I_LK1, I_LQ2, I_LK2, I_GSUB,
       I_WBRA, I_WBRB, I_WBRC, I_WO, I_GN2, I_WUP, I_CONVW, I_CONVB, I_WDN };
struct Ctx {
    const float* const* in; float* out; unsigned char* ws;
    __device__ __forceinline__ float* mod() const { return (float*)(ws + WS_MOD); }
    __device__ __forceinline__ float* lam() const { return (float*)(ws + WS_LAM); }
    __device__ __forceinline__ float* h() const { return (float*)(ws + WS_H); }
    __device__ __forceinline__ bf16_t* u() const { return (bf16_t*)(ws + WS_U); }
    __device__ __forceinline__ bf16_t* wt() const { return (bf16_t*)(ws + WS_WT); }
    __device__ __forceinline__ bf16_t* P() const { return (bf16_t*)(ws + WS_P); }
    __device__ __forceinline__ float* R() const { return (float*)(ws + WS_R); }
    __device__ __forceinline__ bf16_t* oa() const { return (bf16_t*)(ws + WS_OA); }
    __device__ __forceinline__ bf16_t* ob() const { return (bf16_t*)(ws + WS_OA) + 1024; }
    __device__ __forceinline__ bf16_t* oc() const { return (bf16_t*)(ws + WS_OA) + 1536; }
    __device__ __forceinline__ float* ocs() const { return (float*)(ws + WS_OCS); }
    __device__ __forceinline__ float* mf() const { return (float*)(ws + WS_MF); }
    __device__ __forceinline__ bf16_t* mb() const { return (bf16_t*)(ws + WS_MB); }
    __device__ __forceinline__ float* Y() const { return (float*)(ws + WS_Y); }
    __device__ __forceinline__ float* edge() const { return (float*)(ws + WS_EDGE); }
    __device__ __forceinline__ bf16_t* act() const { return (bf16_t*)(ws + WS_ACT); }
};
__device__ __forceinline__ unsigned long long kernarg_u64(int off) {
    unsigned long long v; auto kp = __builtin_amdgcn_kernarg_segment_ptr();
    asm volatile("s_load_dwordx2 %0, %1, %2\n\ts_waitcnt lgkmcnt(0)" : "=s"(v) : "s"(kp), "i"(off));
    return v;
}
__device__ __forceinline__ Ctx make_ctx() {
    Ctx c; c.in = (const float* const*)__builtin_amdgcn_kernarg_segment_ptr();
    c.out = (float*)kernarg_u64(29 * 8); c.ws = (unsigned char*)kernarg_u64(30 * 8);
    return c;
}
#define PHASE_ENTER(cin) Ctx c = make_ctx(); int tid_ = tid_of(wid_k);

__device__ __forceinline__ int win_src_col(int j) {
    if (j < C_VA) { const int s = j & 127, hb = j - s, grp = s >> 6, sp = s & 63, i = sp >> 3, jj = sp & 7; return hb + 64 * grp + (jj < 4 ? 4 * i + jj : 32 + 4 * i + (jj - 4)); }
    if (j >= C_QC && j < C_VC) { const int s = j & 63, hb = j - s, grp = s >> 5, sp = s & 31, i = sp >> 3, jj = sp & 7; return hb + 32 * grp + (jj < 4 ? 4 * i + jj : 16 + 4 * i + (jj - 4)); }
    return j;
}
__device__ __forceinline__ int wup_src_col(int j) { const int pn = j >> 8, bj = (j >> 7) & 1, s = j & 127; return bj * DFF + 128 * pn + s; }

constexpr int T_WIN = (DIN / 256) * (DM / 64), T_BRA = (DM / 256) * (1024 / 64), T_BRB = (DM / 256) * (512 / 64), T_WO = (DM / 256) * (DM / 64), T_WUP = (DUP / 256) * (DM / 64), T_WDN = (DM / 256) * (DFF / 64);
constexpr int T_LAYER = T_WIN + T_BRA + 2 * T_BRB + T_WO + T_WUP + T_WDN;
#ifndef MK_CONV_NDEF
#define MK_CONV_NDEF 3848
#endif
#ifndef MK_CONV_NUP
#define MK_CONV_NUP 1536
#endif
constexpr int CONV_NDEF = MK_CONV_NDEF, CONV_CHUNK = 8, CONV_NP = T_LAYER + (DEPTH - 1) * (T_LAYER - CONV_NDEF), CONV_NATT = CONV_NDEF - MK_CONV_NUP;
static_assert(MK_CONV_NUP >= 0 && MK_CONV_NUP <= MK_CONV_NDEF && MK_CONV_NUP % 8 == 0, "w_up share of the deferred tiles");
static_assert(CONV_NDEF >= 0 && CONV_NDEF < T_LAYER && CONV_NDEF % CONV_CHUNK == 0, "deferred tile count");
__device__ __forceinline__ void conv_run(const Ctx& c, char* lds, int tid, int p0, int pend, int pstep, int mode, int L) {
        asm volatile("" : "+v"(tid));
        float* tile = (float*)lds;
        struct WD { const float* src; bf16_t* dst; int K, N, kind, ldd, l, j0, k0; };
#define WDEC(t_, d_) do { const int l_ = (t_) / T_LAYER; int r_ = (t_) % T_LAYER; bf16_t* wl_ = c.wt() + (size_t)l_ * LAYER_ELEMS; d_.l = l_; d_.kind = 0; d_.ldd = 0; \
            if (r_ < T_WIN) { d_.src = c.in[I_WIN] + (size_t)l_ * DM * DIN; d_.dst = wl_ + O_WIN; d_.K = DM; d_.N = DIN; d_.kind = 1; } \
            else if ((r_ -= T_WIN) < T_BRA) { d_.src = c.in[I_WBRA] + (size_t)l_ * 1024 * DM; d_.dst = wl_ + O_BRA; d_.K = 1024; d_.N = DM; d_.ldd = DM; }             \
            else if ((r_ -= T_BRA) < T_BRB) { d_.src = c.in[I_WBRB] + (size_t)l_ * 512 * DM; d_.dst = wl_ + O_BRA + 1024; d_.K = 512; d_.N = DM; d_.ldd = DM; }      \
            else if ((r_ -= T_BRB) < T_BRB) { d_.src = c.in[I_WBRC] + (size_t)l_ * 512 * DM; d_.dst = wl_ + O_BRA + 1536; d_.K = 512; d_.N = DM; d_.ldd = DM; }      \
            else if ((r_ -= T_BRB) < T_WO) { d_.src = c.in[I_WO] + (size_t)l_ * DM * DM; d_.dst = wl_ + O_WO; d_.K = DM; d_.N = DM; } \
            else if ((r_ -= T_WO) < T_WUP) { d_.src = c.in[I_WUP] + (size_t)l_ * DM * DUP; d_.dst = wl_ + O_WUP; d_.K = DM; d_.N = DUP; d_.kind = 2; } \
            else { r_ -= T_WUP; d_.src = c.in[I_WDN] + (size_t)l_ * DFF * DM; d_.dst = wl_ + O_WDN; d_.K = DFF; d_.N = DM; } \
            const int nkt_ = d_.K / 64; d_.j0 = (r_ / nkt_) * 256; d_.k0 = (r_ % nkt_) * 64; } while (0)
#define WLOAD(d_) do { _Pragma("unroll") for (int s = 0; s < 4; ++s) { const int j = d_.j0 + 64 * s + j4; const int sc = d_.kind == 1 ? win_src_col(j) : (d_.kind == 2 ? wup_src_col(j) : j); \
            _Pragma("unroll") for (int i = 0; i < 2; ++i) v[s][i] = *(const f32x4*)(d_.src + (size_t)(d_.k0 + (tid >> 4) + 32 * i) * d_.N + sc); } } while (0)
        const int j4 = (tid & 15) * 4; f32x4 v[4][2];
#define TMAP(p_) (mode ? L * T_LAYER + (p_) : ((p_) < T_LAYER ? (p_) : (1 + ((p_) - T_LAYER) / (T_LAYER - CONV_NDEF)) * T_LAYER + CONV_NDEF + ((p_) - T_LAYER) % (T_LAYER - CONV_NDEF)))
        WD cur, nxt; int p = p0;
        if (p < pend) { const int t = TMAP(p); WDEC(t, cur); WLOAD(cur); }
        for (; p < pend; p += pstep) {
#pragma unroll
            for (int s = 0; s < 4; ++s)
#pragma unroll
                for (int i = 0; i < 2; ++i) { float* tp = tile + s * (64 * 65) + ((tid >> 4) + 32 * i) * 65 + j4; tp[0] = v[s][i][0]; tp[1] = v[s][i][1]; tp[2] = v[s][i][2]; tp[3] = v[s][i][3]; }
            __syncthreads();
            nxt = cur;
            if (p + pstep < pend) { const int t = TMAP(p + pstep); WDEC(t, nxt); WLOAD(nxt); }
            {
                const int jj = tid >> 3, kk = (tid & 7) * 8;
#pragma unroll
                for (int s = 0; s < 4; ++s) { const float* ts = tile + s * (64 * 65);
                    if (MK_GATE_FP8 && MK_FAST_GEMM && cur.kind == 1 && cur.j0 + 64 * s >= C_G) {
                        u32x2 w8;
                        w8.x = pk4_fp8(ts[(kk + 0) * 65 + jj] * 32.f, ts[(kk + 1) * 65 + jj] * 32.f, ts[(kk + 2) * 65 + jj] * 32.f, ts[(kk + 3) * 65 + jj] * 32.f);
                        w8.y = pk4_fp8(ts[(kk + 4) * 65 + jj] * 32.f, ts[(kk + 5) * 65 + jj] * 32.f, ts[(kk + 6) * 65 + jj] * 32.f, ts[(kk + 7) * 65 + jj] * 32.f);
                        *(u32x2*)(c.ws + WS_WG8 + ((size_t)cur.l * NGATE + (cur.j0 + 64 * s + jj - C_G)) * DM + cur.k0 + kk) = w8;
                        continue; }
                    u32x4 w;
                    w.x = cvt_pk_bf16(ts[(kk + 0) * 65 + jj], ts[(kk + 1) * 65 + jj]); w.y = cvt_pk_bf16(ts[(kk + 2) * 65 + jj], ts[(kk + 3) * 65 + jj]);
                    w.z = cvt_pk_bf16(ts[(kk + 4) * 65 + jj], ts[(kk + 5) * 65 + jj]); w.w = cvt_pk_bf16(ts[(kk + 6) * 65 + jj], ts[(kk + 7) * 65 + jj]);
                    *(u32x4*)(cur.dst + (size_t)(cur.j0 + 64 * s + jj) * (cur.ldd ? cur.ldd : cur.K) + cur.k0 + kk) = w; }
            }
            __syncthreads();
            cur = nxt;
        }
#undef WDEC
#undef WLOAD
#undef TMAP
}

__device__ __forceinline__ void phase_prologue(int wid_k, char* lds) {
    PHASE_ENTER(cin)
    const int tid = tid_, lane = tid & 63, wid = tid >> 6, G = gridDim.x, b = blockIdx.x;
    if (!MK_FAST_GEMM) {
        const f32x4* x4 = (const f32x4*)c.in[I_X]; const f32x4* c4 = (const f32x4*)c.in[I_CTX]; f32x4* h4 = (f32x4*)c.h();
        const size_t nx = (size_t)SEQ * DM / 4, nc = (size_t)CTX * DM / 4;
        for (size_t i = (size_t)b * 512 + tid; i < nx + nc; i += (size_t)G * 512) h4[i] = i < nx ? x4[i] : c4[i - nx];
    }
    if (b == 0 && wid < DEPTH) {
        const int l = wid;
        const float p1 = wave_sum(c.in[I_LQ1][l * 64 + lane] * c.in[I_LK1][l * 64 + lane]);
        const float p2 = wave_sum(c.in[I_LQ2][l * 64 + lane] * c.in[I_LK2][l * 64 + lane]);
        if (lane == 0) c.lam()[l] = expf(p1) - expf(p2) + (0.8f - 0.6f * expf(-0.3f * (float)l));
    }
    {
        float* sc0 = (float*)lds; float* sc1 = sc0 + DM; float* part = sc1 + DM;
        for (int k = tid; k < DM; k += 512) { sc0[k] = siluf(c.in[I_C][k]); sc1[k] = siluf(c.in[I_CCTX][k]); }
        __syncthreads();
        for (int blk = b; blk < DEPTH * NMOD / 64; blk += G) {
            const int l = blk / (NMOD / 64), j = (blk % (NMOD / 64)) * 64 + lane;
            const float* w = c.in[I_WMOD] + (size_t)l * DM * NMOD + j;
            float a0 = 0.f, a1 = 0.f;
            const int kb = wid * 256;
#pragma unroll 32
            for (int k = 0; k < 256; ++k) { const float wv = w[(size_t)(kb + k) * NMOD]; a0 += sc0[kb + k] * wv; a1 += sc1[kb + k] * wv; }
            part[(wid * 64 + lane) * 2 + 0] = a0; part[(wid * 64 + lane) * 2 + 1] = a1;
            __syncthreads();
            if (wid < 2) {
                float s = c.in[I_BMOD][l * NMOD + j];
#pragma unroll
                for (int w8 = 0; w8 < 8; ++w8) s += part[(w8 * 64 + lane) * 2 + wid];
                c.mod()[((size_t)l * 2 + wid) * NMOD + j] = s;
            }
            __syncthreads();
        }
    }
    conv_run(c, lds, tid, b, CONV_NP, G, 0, 0);
}

__device__ __forceinline__ void phase_norm(int wid_k, int l, int which) {
    PHASE_ENTER(cin)
    const int lane = tid_ & 63, wid = tid_ >> 6;
    const float* g = c.in[which ? I_GN2 : I_GN1] + l * DM;
#define NORM_ROWPTR(r_) ((MK_FAST_GEMM && l == 0 && which == 0) ? ((r_) < SEQ ? c.in[I_X] + (size_t)(r_) * DM : c.in[I_CTX] + (size_t)((r_) - SEQ) * DM) : c.h() + (size_t)(r_) * DM)
    const int row0 = blockIdx.x * 8 + wid, rstep = gridDim.x * 8;
    f32x4 v[8], vn[8];
    if (row0 < MT) { const float* hr = NORM_ROWPTR(row0);
#pragma unroll
        for (int i = 0; i < 8; ++i) v[i] = *(const f32x4*)(hr + i * 256 + lane * 4); }
    for (int row = row0; row < MT; row += rstep) {
        if (row + rstep < MT) { const float* hn = NORM_ROWPTR(row + rstep);
#pragma unroll
            for (int i = 0; i < 8; ++i) vn[i] = *(const f32x4*)(hn + i * 256 + lane * 4); }
        const float* md = c.mod() + ((size_t)l * 2 + (row >= SEQ ? 1 : 0)) * NMOD;
        const float* sh = md + (which ? 3 : 0) * DM; const float* sc = md + (which ? 4 : 1) * DM;
        float ss = 0.f;
#pragma unroll
        for (int i = 0; i < 8; ++i) ss += v[i][0] * v[i][0] + v[i][1] * v[i][1] + v[i][2] * v[i][2] + v[i][3] * v[i][3];
        ss = wave_sum(ss);
        const float rstd = __builtin_amdgcn_rsqf(ss * (1.0f / DM) + EPS);
#pragma unroll
        for (int i = 0; i < 8; ++i) {
            const int col = i * 256 + lane * 4;
            const f32x4 gg = *(const f32x4*)(g + col), s1 = *(const f32x4*)(sc + col), s0 = *(const f32x4*)(sh + col);
            f32x4 o;
#pragma unroll
            for (int e = 0; e < 4; ++e) o[e] = (v[i][e] * rstd * gg[e]) * (1.0f + s1[e]) + s0[e];
            u32x2 w; w.x = cvt_pk_bf16(o[0], o[1]); w.y = cvt_pk_bf16(o[2], o[3]);
            *(u32x2*)(c.u() + (size_t)row * DM + col) = w;
            if (MK_GATE_FP8 && MK_FAST_GEMM && which == 0) *(unsigned*)(c.ws + WS_U8 + (size_t)row * DM + col) = pk4_fp8(o[0], o[1], o[2], o[3]);
        }
#pragma unroll
        for (int i = 0; i < 8; ++i) v[i] = vn[i];
    }
#undef NORM_ROWPTR
}

__device__ __forceinline__ void rope_cs(float pos, int f, float inv_nf, float& cs, float& sn) {
    const float inv = __builtin_amdgcn_exp2f(-(float)f * inv_nf * 13.287712379549449f);
    const float ang = pos * inv;
    float rev = ang * 0.15915494309189535f; rev -= floorf(rev);
    cs = __builtin_amdgcn_cosf(rev); sn = __builtin_amdgcn_sinf(rev);
}
__device__ __forceinline__ void phase_qknorm(int wid_k, int l) {
    PHASE_ENTER(cin)
    const int lane = tid_ & 63, wid = tid_ >> 6;
    const int i = lane >> 2, j = lane & 3;
    const long nitems = (long)MT * 26;
    for (long it = (long)blockIdx.x * 8 + wid; it < nitems; it += (long)gridDim.x * 8) {
        const int row = (int)(it / 26), g = (int)(it % 26);
        const int rc = g * 128, pc = rc < 1280 ? rc : (rc < 2304 ? rc + 256 : rc + 768);
        const float* rp = c.R() + (size_t)row * RW + rc;
        const float x1 = rp[8 * i + j], x2 = rp[8 * i + 4 + j];
        float ss = x1 * x1 + x2 * x2;
        int type; const float* gv;
        if (g < 8) { type = 0; gv = c.in[I_GQA] + l * 128; } else if (g < 10) { type = 0; gv = c.in[I_GKA] + l * 128; }
        else if (g < 14) { type = 1; gv = c.in[I_GQB] + l * 128; } else if (g < 18) { type = 1; gv = c.in[I_GKB] + l * 128; }
        else if (g < 22) { type = 2; gv = c.in[I_GQC] + l * 64; } else { type = 2; gv = c.in[I_GKC] + l * 64; }
        ss = half_sum(ss);
        if (type != 2) { auto rr = __builtin_amdgcn_permlane32_swap(__float_as_uint(ss), __float_as_uint(ss), false, false); ss = __uint_as_float(rr[0]) + __uint_as_float(rr[1]); }
        const float rstd = 1.0f / sqrtf(ss * (type == 2 ? 1.0f / 64.0f : 1.0f / 128.0f) + EPS);
        float y1, y2;
        if (type == 1) { y1 = x1 * rstd * gv[8 * i + j]; y2 = x2 * rstd * gv[8 * i + 4 + j]; }
        else {
            int d1, d2, f; float inv_nf; int grp;
            if (type == 0) { grp = i >> 3; f = 4 * (i & 7) + j; d1 = 64 * grp + f; d2 = d1 + 32; inv_nf = 1.0f / 32.0f; }
            else { const int ip = i & 7; grp = ip >> 2; f = 4 * (ip & 3) + j; d1 = 32 * grp + f; d2 = d1 + 16; inv_nf = 1.0f / 16.0f; }
            y1 = x1 * rstd * gv[d1]; y2 = x2 * rstd * gv[d2];
            if (row < SEQ) {
                const float pos = (float)(grp ? (row & 63) : (row >> 6));
                float cs, sn; rope_cs(pos, f, inv_nf, cs, sn);
                const float o1 = y1 * cs - y2 * sn, o2 = y2 * cs + y1 * sn; y1 = o1; y2 = o2;
            }
        }
        const float qs = (g < 8 || (g >= 10 && g < 14)) ? 0.12751743f : ((g >= 18 && g < 22) ? 0.18033688f : 1.0f);
        bf16_t* pp = c.P() + (size_t)row * DIN + pc;
        pp[8 * i + j] = f2bf(y1 * qs); pp[8 * i + 4 + j] = f2bf(y2 * qs);
    }
}

__device__ __forceinline__ void phase_conv(int wid_k, int l) {
    PHASE_ENTER(cin)
    const float* cw = c.in[I_CONVW] + (size_t)l * 3 * DUP; const float* cb = c.in[I_CONVB] + (size_t)l * DUP;
    const long n = (long)MT * DFF;
    for (long idx = (long)blockIdx.x * 512 + tid_; idx < n; idx += (long)gridDim.x * 512) {
        const int row = (int)(idx / DFF), col = (int)(idx % DFF);
        const int ya = 256 * (col >> 7) + (col & 127), yg = ya + 128;
        const bool up = (row != 0 && row != SEQ), dn = (row != SEQ - 1 && row != MT - 1);
        const float* y = c.Y() + (size_t)row * DUP;
        float ha = cb[col] + cw[DUP + col] * y[ya], hg = cb[DFF + col] + cw[DUP + DFF + col] * y[yg];
        if (up) { ha += cw[col] * y[ya - DUP]; hg += cw[DFF + col] * y[yg - DUP]; }
        if (dn) { ha += cw[2 * DUP + col] * y[ya + DUP]; hg += cw[2 * DUP + DFF + col] * y[yg + DUP]; }
        c.act()[idx] = f2bf(siluf(hg) * ha);
    }
}


__device__ __forceinline__ void phase_convfix(int wid_k, int l) {
    PHASE_ENTER(cin)
    const float* cw = c.in[I_CONVW] + (size_t)l * 3 * DUP; const float* cb = c.in[I_CONVB] + (size_t)l * DUP; const float* E = c.edge();
    const int nrows = (l == DEPTH - 1 ? SEQ / 64 : NBLK64) * 2;
    const long n = (long)nrows * (DFF / 4);
    for (long idx = (long)blockIdx.x * 512 + tid_; idx < n; idx += (long)gridDim.x * 512) {
        const int br = (int)(idx / (DFF / 4)), ch = (int)(idx % (DFF / 4)) * 4, b = br >> 1, lastrow = br & 1, row = 64 * b + (lastrow ? 63 : 0);
        const int ya = 256 * (ch >> 7) + (ch & 127), yg = ya + 128;
        const float* eb = E + (size_t)b * 4 * DUP;
        f32x4 ua = {0.f, 0.f, 0.f, 0.f}, ug = ua, da = ua, dg = ua, ma, mg;
        if (!lastrow) {
            if (row != 0 && row != SEQ) { ua = *(const f32x4*)(eb - DUP + ya); ug = *(const f32x4*)(eb - DUP + yg); }
            ma = *(const f32x4*)(eb + ya); mg = *(const f32x4*)(eb + yg); da = *(const f32x4*)(eb + DUP + ya); dg = *(const f32x4*)(eb + DUP + yg);
        } else {
            ua = *(const f32x4*)(eb + 2 * DUP + ya); ug = *(const f32x4*)(eb + 2 * DUP + yg); ma = *(const f32x4*)(eb + 3 * DUP + ya); mg = *(const f32x4*)(eb + 3 * DUP + yg);
            if (row != SEQ - 1 && row != MT - 1) { da = *(const f32x4*)(eb + 4 * DUP + ya); dg = *(const f32x4*)(eb + 4 * DUP + yg); }
        }
        const f32x4 wa0 = *(const f32x4*)(cw + ch), wa1 = *(const f32x4*)(cw + DUP + ch), wa2 = *(const f32x4*)(cw + 2 * DUP + ch), ba = *(const f32x4*)(cb + ch);
        const f32x4 wg0 = *(const f32x4*)(cw + DFF + ch), wg1 = *(const f32x4*)(cw + DUP + DFF + ch), wg2 = *(const f32x4*)(cw + 2 * DUP + DFF + ch), bg = *(const f32x4*)(cb + DFF + ch);
        f32x4 o;
#pragma unroll
        for (int e = 0; e < 4; ++e) { const float ha = ba[e] + wa0[e] * ua[e] + wa1[e] * ma[e] + wa2[e] * da[e], hg = bg[e] + wg0[e] * ug[e] + wg1[e] * mg[e] + wg2[e] * dg[e]; o[e] = siluf(hg) * ha; }
        u32x2 w; w.x = cvt_pk_bf16(o[0], o[1]); w.y = cvt_pk_bf16(o[2], o[3]);
        *(u32x2*)(c.act() + (size_t)row * DFF + ch) = w;
    }
}

__device__ __forceinline__ void phase_copy_out(int wid_k) {
    PHASE_ENTER(cin)
    const f32x4* h4 = (const f32x4*)c.h(); f32x4* o4 = (f32x4*)c.out; const size_t n = (size_t)SEQ * DM / 4;
    for (size_t i = (size_t)blockIdx.x * 512 + tid_; i < n; i += (size_t)gridDim.x * 512) o4[i] = h4[i];
}

template <class Epi>
__device__ __forceinline__ void simple_gemm(int wid_k, const bf16_t* A, const bf16_t* Bt, int M, int N, int K, const Epi& epi) {
    int tid_ = tid_of(wid_k); A = launder_uniform(A); Bt = launder_uniform(Bt);
    const int lane = tid_ & 63, wid = tid_ >> 6, wm = wid >> 2, wn = wid & 3, fr = lane & 15, fq = lane >> 4;
    const int ntn = N / 128, ntiles = (M / 128) * ntn;
    for (int t = blockIdx.x; t < ntiles; t += gridDim.x) {
        const int tm = t / ntn, tn = t % ntn, row0 = tm * 128 + wm * 64, col0 = tn * 128 + wn * 32;
        f32x4 acc[4][2];
#pragma unroll
        for (int m = 0; m < 4; ++m)
#pragma unroll
            for (int n = 0; n < 2; ++n) acc[m][n] = (f32x4){0.f, 0.f, 0.f, 0.f};
        const bf16_t* ap = A + (size_t)(row0 + fr) * K + fq * 8; const bf16_t* bp = Bt + (size_t)(col0 + fr) * K + fq * 8;
        for (int k0 = 0; k0 < K; k0 += 32) {
            bf16x8 a[4], b[2];
#pragma unroll
            for (int m = 0; m < 4; ++m) a[m] = *(const bf16x8*)(ap + (size_t)m * 16 * K + k0);
#pragma unroll
            for (int n = 0; n < 2; ++n) b[n] = *(const bf16x8*)(bp + (size_t)n * 16 * K + k0);
#pragma unroll
            for (int m = 0; m < 4; ++m)
#pragma unroll
                for (int n = 0; n < 2; ++n) acc[m][n] = __builtin_amdgcn_mfma_f32_16x16x32_bf16(a[m], b[n], acc[m][n], 0, 0, 0);
        }
#pragma unroll
        for (int m = 0; m < 4; ++m)
#pragma unroll
            for (int n = 0; n < 2; ++n)
#pragma unroll
                for (int j = 0; j < 4; ++j) epi(row0 + m * 16 + fq * 4 + j, col0 + n * 16 + fr, acc[m][n][j]);
    }
}

template <class Epi>
__device__ __forceinline__ void slab_gemm(int wid_k, const bf16_t* A, int lda, const bf16_t* Bt, int ldb, int row_base, int M, int N, int K, const Epi& epi) {
    int tid_ = tid_of(wid_k); A = launder_uniform(A); Bt = launder_uniform(Bt);
    const int lane = tid_ & 63, wid = tid_ >> 6, fr = lane & 15, fq = lane >> 4;
    const int ntn = N / 16, ntiles = (M / 128) * ntn;
    for (int t = blockIdx.x; t < ntiles; t += gridDim.x) {
        const int tm = t / ntn, tn = t % ntn, row0 = row_base + tm * 128 + wid * 16, col0 = tn * 16;
        f32x4 acc0 = {0.f, 0.f, 0.f, 0.f}, acc1 = acc0;
        const bf16_t* ap = A + (size_t)(row0 + fr) * lda + fq * 8; const bf16_t* bp = Bt + (size_t)(col0 + fr) * ldb + fq * 8;
#pragma unroll 8
        for (int k0 = 0; k0 < K; k0 += 64) {
            const bf16x8 a0 = *(const bf16x8*)(ap + k0), b0 = *(const bf16x8*)(bp + k0), a1 = *(const bf16x8*)(ap + k0 + 32), b1 = *(const bf16x8*)(bp + k0 + 32);
            acc0 = __builtin_amdgcn_mfma_f32_16x16x32_bf16(a0, b0, acc0, 0, 0, 0);
            acc1 = __builtin_amdgcn_mfma_f32_16x16x32_bf16(a1, b1, acc1, 0, 0, 0);
        }
#pragma unroll
        for (int j = 0; j < 4; ++j) epi(row0 + fq * 4 + j, col0 + fr, acc0[j] + acc1[j]);
    }
}

template <class Epi4>
__device__ __forceinline__ void slab_gemm4(int wid_k, char* lds, const bf16_t* A, int lda, const bf16_t* Bt, int ldb, int row_base, int M, int N, int K, const Epi4& epi) {
    int tid_ = tid_of(wid_k); A = launder_uniform(A); Bt = launder_uniform(Bt);
    const int lane = tid_ & 63, wid = __builtin_amdgcn_readfirstlane(tid_ >> 6), r32 = lane & 31, hi = lane >> 5, ch = wid & 1, kq = wid >> 1, kl = K >> 2;
    float* part = (float*)lds;
    const int ntn = N / 64, ntiles = (M / 32) * ntn;
    typedef const __attribute__((address_space(1))) bf16x8 gfrag;
    for (int t = blockIdx.x; t < ntiles; t += gridDim.x) {
        const int tm = t / ntn, tn = t % ntn, row0 = row_base + tm * 32, col0 = tn * 64 + ch * 32;
        const bf16_t* ap = A + (size_t)(row0 + r32) * lda + kq * kl + hi * 8; const bf16_t* bp = Bt + (size_t)(col0 + r32) * ldb + kq * kl + hi * 8;
        f32x16 acc = {};
        bf16x8 fa0[8], fb0[8], fa1[8], fb1[8];
#define SLAB_LD(FA, FB, kb_) do { _Pragma("unroll") for (int i = 0; i < 8; ++i) { const int kk_ = (kb_) + 16 * i; if (kk_ < kl) { FA[i] = *(gfrag*)(ap + kk_); FB[i] = *(gfrag*)(bp + kk_); } else { FA[i] = (bf16x8){0, 0, 0, 0, 0, 0, 0, 0}; FB[i] = FA[i]; } } } while (0)
#define SLAB_MM(FA, FB) do { _Pragma("unroll") for (int i = 0; i < 8; ++i) acc = __builtin_amdgcn_mfma_f32_32x32x16_bf16(FA[i], FB[i], acc, 0, 0, 0); } while (0)
        SLAB_LD(fa0, fb0, 0);
        for (int k0 = 0; k0 < kl; k0 += 256) {
            if (k0 + 128 < kl) SLAB_LD(fa1, fb1, k0 + 128);
            SLAB_MM(fa0, fb0);
            if (k0 + 256 < kl) SLAB_LD(fa0, fb0, k0 + 256);
            if (k0 + 128 < kl) SLAB_MM(fa1, fb1);
        }
#undef SLAB_LD
#undef SLAB_MM
        float* pw = part + ((kq * 2 + ch) * 32) * 32 + r32;
#pragma unroll
        for (int i = 0; i < 16; ++i) pw[((i & 3) + 8 * (i >> 2) + 4 * hi) * 32] = acc[i];
        __syncthreads();
#pragma unroll
        for (int j = 0; j < 4; ++j) { const int o = (tid_ & 255) + 256 * j, c2 = tid_ >> 8, rr = o >> 5, cc = o & 31;
            const float* pp = part + (c2 * 32 + rr) * 32 + cc;
            epi(row_base + tm * 32 + rr, tn * 64 + c2 * 32 + cc, pp[0], pp[2 * 1024], pp[4 * 1024], pp[6 * 1024]); }
        __syncthreads();
    }
}
template <bool QUART, class Epi4>
__device__ __forceinline__ void slab_gemm5(int wid_k, char* lds, const bf16_t* A, int lda, const bf16_t* Bt, int ldb, int row_base, int M, int N, int K, const Epi4& epi) {
    int tid_ = tid_of(wid_k); A = launder_uniform(A); Bt = launder_uniform(Bt);
    const int lane = tid_ & 63, wid = __builtin_amdgcn_readfirstlane(tid_ >> 6), r32 = lane & 31, hi = lane >> 5, ch = wid & 1, kq = wid >> 1, kl = K >> 2, ns = K >> 7;
    constexpr int STG = 24576, NSTG = 5;
    float* part = (float*)lds;
    LAS unsigned char* ldsL = (LAS unsigned char*)(unsigned)(uintptr_t)lds;
    const int ntn = N / 64, ntiles = (M / 32) * ntn;
    for (int t = blockIdx.x; t < ntiles; t += gridDim.x) {
        const int tm = t / ntn, tn = t % ntn, row0 = row_base + tm * 32, col0 = tn * 64;
        const char* gsrc[3];
#pragma unroll
        for (int j = 0; j < 3; ++j) { const int J = 3 * wid + j, isA = J < 8, G = (isA ? J : J - 8) * 64 + lane, row = G >> 4, lc = (G & 15) ^ (row & 15);
            const bf16_t* rp = isA ? A + (size_t)(row0 + row) * lda : Bt + (size_t)(col0 + row) * ldb;
            gsrc[j] = (const char*)(rp + (QUART ? (lc >> 2) * kl + (lc & 3) * 8 : lc * 8)); }
        const size_t sstep = QUART ? 64 : 256;
#define S5_DMA(st_, si_) do { _Pragma("unroll") for (int j = 0; j < 3; ++j) \
            __builtin_amdgcn_global_load_lds((const unsigned*)(gsrc[j] + (size_t)(si_) * sstep), (LAS unsigned*)(ldsL + (st_) * STG + (3 * wid + j) * 1024), 16, 0, 0); } while (0)
        int aoff[2], boff[2];
#pragma unroll
        for (int m = 0; m < 2; ++m) { const int lc = QUART ? 4 * kq + 2 * m + hi : 2 * kq + 8 * m + hi;
            aoff[m] = r32 * 256 + ((lc ^ (r32 & 15)) << 4); boff[m] = 8192 + (ch * 32 + r32) * 256 + ((lc ^ (r32 & 15)) << 4); }
        f32x16 acc = {};
#pragma unroll
        for (int s = 0; s < NSTG - 1; ++s) if (s < ns) S5_DMA(s, s);
        int st = 0;
        for (int s = 0; s < ns; ++s) {
            const int rem = ns - 1 - s;
            if (rem >= 3) asm volatile("s_waitcnt vmcnt(9)" ::: "memory"); else if (rem == 2) asm volatile("s_waitcnt vmcnt(6)" ::: "memory");
            else if (rem == 1) asm volatile("s_waitcnt vmcnt(3)" ::: "memory"); else asm volatile("s_waitcnt vmcnt(0)" ::: "memory");
            __builtin_amdgcn_s_barrier(); asm volatile("" ::: "memory");
            if (s + NSTG - 1 < ns) { const int sn = st == 0 ? NSTG - 1 : st - 1; S5_DMA(sn, s + NSTG - 1); }
            const LAS unsigned char* sb = ldsL + st * STG;
            const bf16x8 a0 = *(const LAS bf16x8*)(sb + aoff[0]), b0 = *(const LAS bf16x8*)(sb + boff[0]), a1 = *(const LAS bf16x8*)(sb + aoff[1]), b1 = *(const LAS bf16x8*)(sb + boff[1]);
            acc = __builtin_amdgcn_mfma_f32_32x32x16_bf16(a0, b0, acc, 0, 0, 0);
            acc = __builtin_amdgcn_mfma_f32_32x32x16_bf16(a1, b1, acc, 0, 0, 0);
            st = st == NSTG - 1 ? 0 : st + 1;
        }
#undef S5_DMA
        asm volatile("s_waitcnt lgkmcnt(0)" ::: "memory"); __builtin_amdgcn_s_barrier(); asm volatile("" ::: "memory");
        float* pw = part + ((kq * 2 + ch) * 32) * 32 + r32;
#pragma unroll
        for (int i = 0; i < 16; ++i) pw[((i & 3) + 8 * (i >> 2) + 4 * hi) * 32] = acc[i];
        __syncthreads();
#pragma unroll
        for (int j = 0; j < 4; ++j) { const int o = (tid_ & 255) + 256 * j, c2 = tid_ >> 8, rr = o >> 5, cc = o & 31;
            const float* pp = part + (c2 * 32 + rr) * 32 + cc;
            epi(row_base + tm * 32 + rr, tn * 64 + c2 * 32 + cc, pp[0], pp[2 * 1024], pp[4 * 1024], pp[6 * 1024]); }
        __syncthreads();
    }
}
struct SEpiRes4 {
    float* h; const float* gx; const float* gc; const float* src;
    __device__ __forceinline__ void operator()(int row, int col, float p0, float p1, float p2, float p3) const { const size_t o = (size_t)row * DM + col; h[o] = src[o] + (row < SEQ ? gx[col] : gc[col]) * ((p0 + p1) + (p2 + p3)); }
};
struct SEpiBr4 {
    bf16_t* mb; const bf16_t* P;
    __device__ __forceinline__ void operator()(int row, int col, float p0, float p1, float p2, float p3) const { const bf16_t* g = P + (size_t)row * DIN + C_G + col;
        mb[(size_t)row * DM + col] = f2bf(bf2f(g[0]) * (p0 + p1) + bf2f(g[DM]) * p2 + bf2f(g[2 * DM]) * p3); }
};
struct SEpiWin {
    float* R; bf16_t* P;
    __device__ __forceinline__ void operator()(int row, int col, float v) const {
        const bool isv = (col >= C_VA && col < C_QB) || (col >= C_VB && col < C_QC) || (col >= C_VC);
        if (!isv) { const int rc = col < C_VA ? col : (col < C_VB ? col - 256 : col - 768); R[(size_t)row * RW + rc] = v; }
        else P[(size_t)row * DIN + col] = f2bf(col >= C_G ? sigmoidf(v) : v);
    }
};
template <int STEP> struct SEpiBr {
    float* mf; bf16_t* mb; const bf16_t* P;
    __device__ __forceinline__ void operator()(int row, int col, float v) const {
        const float g = bf2f(P[(size_t)row * DIN + C_G + STEP * DM + col]);
        const size_t o = (size_t)row * DM + col;
        if (STEP == 0) mf[o] = g * v; else if (STEP == 1) mf[o] += g * v; else mb[o] = f2bf(mf[o] + g * v);
    }
};
struct SEpiRes {
    float* h; const float* gx; const float* gc; const float* src;
    __device__ __forceinline__ void operator()(int row, int col, float v) const { const size_t o = (size_t)row * DM + col; h[o] = src[o] + (row < SEQ ? gx[col] : gc[col]) * v; }
};
struct SEpiY { float* Y; __device__ __forceinline__ void operator()(int row, int col, float v) const { Y[(size_t)row * DUP + col] = v; } };

namespace pg8 {
#define PG8_LAS __attribute__((address_space(3)))
constexpr int BM = 256, BK = 64, HALF = 128, HTB = HALF * BK * 2  , STAGE_BYTES = 8 * HTB, NXCD = 8, WGM = 8;
__host__ __device__ __forceinline__ int lds_byte(int r, int c) { const int st = (r >> 4) * 2 + (c >> 5), rr = r & 15, cc = c & 31, ob = rr * 64 + cc * 2; return st * 1024 + (ob ^ (((ob >> 9) & 1) << 5)); }
__host__ __device__ __forceinline__ void stage_rc(int b, int& R, int& C) { const int st = b / 1024, sb = b % 1024, swz = sb ^ (((sb >> 9) & 1) << 5); R = (st >> 1) * 16 + swz / 64; C = (st & 1) * 32 + (swz % 64) / 2; }
__host__ __device__ __forceinline__ int perm32(int rho) { const int n = rho >> 4, i = rho & 15; return 8 * (i >> 2) + 4 * n + (i & 3); }
struct Unit { int pm, pn; };
struct Gemm { const bf16_t* A; const bf16_t* Bt; int M, N, K; int lda = 0, ldb = 0; };
struct OneUnit { Unit u; __device__ __forceinline__ bool next(int i, Unit& o) const { o = u; return i == 0; } __device__ __forceinline__ void a_ready(const Unit&) const {} __device__ __forceinline__ void done(const Unit&) const {} };
struct StaticOrder {
    int nM, nN, nwg, G, c;
    __host__ __device__ __forceinline__ void init(int M, int N, int G_, int c_) { nM = M / BM; nN = N / BM; nwg = nM * nN; G = G_; c = c_; }
    __host__ __device__ __forceinline__ bool next(int i, Unit& u) const {
        const long L = (long)i * G + c; if (L >= nwg) return false;
        int wgid = (int)L; { const int q = nwg / NXCD, r = nwg % NXCD, xcd = wgid % NXCD, off = wgid / NXCD; wgid = (xcd < r ? xcd * (q + 1) : r * (q + 1) + (xcd - r) * q) + off; }
        const int nig = WGM * nN, gid = wgid / nig, fm = gid * WGM, gsz = (nM - fm) < WGM ? (nM - fm) : WGM;
        u.pm = fm + ((wgid % nig) % gsz); u.pn = (wgid % nig) / gsz; return true;
    }
    __device__ __forceinline__ void a_ready(const Unit&) const {}
    __device__ __forceinline__ void done(const Unit&) const {}
};
template <class Epi, class Sched, bool KEEP_IN, bool KEEP_OUT, bool F8 = false>
__device__ __forceinline__ void gemm_phase_core(PG8_LAS unsigned char* lds, const Gemm g, const Sched& S, const Epi& E, int tid, f32x4 (&acc)[2][2][4][2]) {
    asm volatile("" : "+v"(tid));
    const int wid = __builtin_amdgcn_readfirstlane(tid >> 6), lane = tid & 63, wr = wid >> 2, wc = wid & 3, fr = lane & 15, fq = lane >> 4;
    const int K = g.K, nt = K / BK, lda = g.lda ? g.lda : K, ldb = g.ldb ? g.ldb : K;
    unsigned voffA[2], voffB[2];
#pragma unroll
    for (int i = 0; i < 2; ++i) { int R, C; stage_rc(tid * 16 + i * 8192, R, C); const int Rb = Epi::PERM ? ((R & ~31) + perm32(R & 31)) : R;
        voffA[i] = (unsigned)(R * lda + C) * 2u; voffB[i] = (unsigned)(Rb * ldb + C) * 2u; }
    const __amdgpu_buffer_rsrc_t rA_ = __builtin_amdgcn_make_buffer_rsrc((void*)g.A, 0, 0x7fffffff, 0x00020000), rB_ = __builtin_amdgcn_make_buffer_rsrc((void*)g.Bt, 0, 0x7fffffff, 0x00020000);
    const size_t kstep = (size_t)(BK * 2);
    const size_t hstepA = (size_t)HALF * lda * 2, hstepB = (size_t)HALF * ldb * 2;
    const size_t tstepA = 2 * hstepA, tstepB = 2 * hstepB;
    const unsigned ldsw = (unsigned)wid * 1024u;
    const int aoff = lds_byte(wr * 64 + fr, fq * 8), boff = lds_byte(wc * 32 + fr, fq * 8);
#define PG8_SA(b, h) (((b) * 2 + (h)) * HTB)
#define PG8_SB(b, h) ((4 + (b) * 2 + (h)) * HTB)
#define PG8_STAGE(bufoff, gbase, voff, R_, BASE_) do { const int so_ = (int)((const char*)(gbase) - (const char*)(BASE_)); _Pragma("unroll") for (int _i = 0; _i < 2; ++_i) \
        __builtin_amdgcn_raw_ptr_buffer_load_lds(R_, (PG8_LAS void*)(lds + (bufoff) + ldsw + _i * 8192), 16, (voff)[_i], so_, 0, 0); } while (0)
#define PG8_LDA(dst, b, h) do { _Pragma("unroll") for (int m = 0; m < 4; ++m) _Pragma("unroll") for (int k = 0; k < 2; ++k) dst[m][k] = *(const PG8_LAS bf16x8*)(lds + PG8_SA(b, h) + aoff + m * 2048 + k * 1024); } while (0)
#define PG8_LDB(dst, b, h) do { _Pragma("unroll") for (int n = 0; n < 2; ++n) _Pragma("unroll") for (int k = 0; k < 2; ++k) dst[n][k] = *(const PG8_LAS bf16x8*)(lds + PG8_SB(b, h) + boff + n * 2048 + k * 1024); } while (0)
#define PG8_MMA(ai, bj, At, Bt) do { __builtin_amdgcn_s_setprio(1); _Pragma("unroll") for (int m = 0; m < 4; ++m) _Pragma("unroll") for (int n = 0; n < 2; ++n) { \
        if constexpr (F8) { typedef int v4i_ __attribute__((ext_vector_type(4))); typedef int v8i_ __attribute__((ext_vector_type(8))); \
            const v8i_ b8_ = __builtin_shufflevector(__builtin_bit_cast(v4i_, Bt[n][0]), __builtin_bit_cast(v4i_, Bt[n][1]), 0, 1, 2, 3, 4, 5, 6, 7); \
            const v8i_ a8_ = __builtin_shufflevector(__builtin_bit_cast(v4i_, At[m][0]), __builtin_bit_cast(v4i_, At[m][1]), 0, 1, 2, 3, 4, 5, 6, 7); \
            asm volatile("v_mfma_scale_f32_16x16x128_f8f6f4 %0, %1, %2, %0, %3, %3 op_sel_hi:[0,0,0]" : "+v"(acc[ai][bj][m][n]) : "v"(b8_), "v"(a8_), "v"(sc8_)); } \
        else { _Pragma("unroll") for (int k = 0; k < 2; ++k) acc[ai][bj][m][n] = __builtin_amdgcn_mfma_f32_16x16x32_bf16(Bt[n][k], At[m][k], acc[ai][bj][m][n], 0, 0, 0); } } \
        __builtin_amdgcn_s_setprio(0); } while (0)
#define PG8_WAIT_V(n) asm volatile("s_waitcnt vmcnt(" #n ")" ::: "memory")
#define PG8_WAIT_L(n) asm volatile("s_waitcnt lgkmcnt(" #n ")" ::: "memory")
#define PG8_BAR __builtin_amdgcn_s_barrier()
#define PG8_SCHED __builtin_amdgcn_sched_barrier(0)
    int sc8_ = 127; if constexpr (F8) asm volatile("" : "+v"(sc8_));
    Unit cur, nxt; int ui = 0;
    if (!S.next(0, cur)) return;
    if constexpr (!KEEP_IN) {
#pragma unroll
    for (int a = 0; a < 2; ++a)
#pragma unroll
        for (int b = 0; b < 2; ++b)
#pragma unroll
            for (int m = 0; m < 4; ++m)
#pragma unroll
                for (int n = 0; n < 2; ++n) acc[a][b][m][n] = (f32x4){0.f, 0.f, 0.f, 0.f};
    }
    bf16x8 At[4][2], B0[2][2], B1[2][2];
    const char* cA = (const char*)g.A + (size_t)cur.pm * tstepA; const char* cB = (const char*)g.Bt + (size_t)cur.pn * tstepB;
    S.a_ready(cur);
    PG8_STAGE(PG8_SB(0, 0), cB, voffB, rB_, g.Bt); PG8_STAGE(PG8_SA(0, 0), cA, voffA, rA_, g.A); PG8_STAGE(PG8_SB(0, 1), cB + hstepB, voffB, rB_, g.Bt); PG8_STAGE(PG8_SA(0, 1), cA + hstepA, voffA, rA_, g.A);
    if (wr == 1) PG8_BAR;
    PG8_WAIT_V(4); PG8_BAR;
    PG8_STAGE(PG8_SB(1, 0), cB + kstep, voffB, rB_, g.Bt); PG8_STAGE(PG8_SA(1, 0), cA + kstep, voffA, rA_, g.A); PG8_STAGE(PG8_SB(1, 1), cB + hstepB + kstep, voffB, rB_, g.Bt);
    PG8_WAIT_V(6); PG8_BAR;
    for (;;) {
        const bool has_next = S.next(ui + 1, nxt);
        const char* nA = has_next ? (const char*)g.A + (size_t)nxt.pm * tstepA : cA; const char* nB = has_next ? (const char*)g.Bt + (size_t)nxt.pn * tstepB : cB;
        for (int t = 0; t < nt; t += 2) {
            const bool last = (t == nt - 2);
            const char* a1 = cA + (size_t)(t + 1) * kstep;
            const char* a2 = last ? nA : cA + (size_t)(t + 2) * kstep; const char* b2 = last ? nB : cB + (size_t)(t + 2) * kstep;
            const char* a3 = a2 + kstep; const char* b3 = b2 + kstep;
            if (last && has_next) S.a_ready(nxt);
            PG8_LDB(B0, 0, 0); PG8_SCHED; PG8_LDA(At, 0, 0); PG8_STAGE(PG8_SA(1, 1), a1 + hstepA, voffA, rA_, g.A);
            PG8_WAIT_L(8); PG8_BAR; PG8_WAIT_L(0); PG8_MMA(0, 0, At, B0); PG8_BAR; PG8_SCHED;
            PG8_LDB(B1, 0, 1); PG8_STAGE(PG8_SB(0, 0), b2, voffB, rB_, g.Bt);
            PG8_BAR; PG8_WAIT_L(0); PG8_MMA(0, 1, At, B1); PG8_BAR;
            PG8_LDA(At, 0, 1); PG8_STAGE(PG8_SA(0, 0), a2, voffA, rA_, g.A);
            PG8_BAR; PG8_WAIT_L(0); PG8_MMA(1, 0, At, B0); PG8_BAR; PG8_SCHED;
            PG8_STAGE(PG8_SB(0, 1), b2 + hstepB, voffB, rB_, g.Bt);
            PG8_WAIT_V(6); PG8_BAR; PG8_MMA(1, 1, At, B1); PG8_BAR;
            PG8_LDB(B0, 1, 0); PG8_SCHED; PG8_LDA(At, 1, 0); PG8_STAGE(PG8_SA(0, 1), a2 + hstepA, voffA, rA_, g.A);
            PG8_WAIT_L(8); PG8_BAR; PG8_WAIT_L(0); PG8_MMA(0, 0, At, B0); PG8_BAR; PG8_SCHED;
            PG8_LDB(B1, 1, 1); PG8_STAGE(PG8_SB(1, 0), b3, voffB, rB_, g.Bt);
            PG8_BAR; PG8_WAIT_L(0); PG8_MMA(0, 1, At, B1); PG8_BAR;
            PG8_LDA(At, 1, 1); PG8_STAGE(PG8_SA(1, 0), a3, voffA, rA_, g.A);
            PG8_BAR; PG8_WAIT_L(0); PG8_MMA(1, 0, At, B0); PG8_BAR; PG8_SCHED;
            PG8_STAGE(PG8_SB(1, 1), b3 + hstepB, voffB, rB_, g.Bt);
            PG8_WAIT_V(6); PG8_BAR; PG8_MMA(1, 1, At, B1); PG8_BAR;
        }
        if constexpr (F8) {
#define PG8_PIN8(ai, bj, TXT) asm volatile(TXT : "+v"(acc[ai][bj][0][0]), "+v"(acc[ai][bj][0][1]), "+v"(acc[ai][bj][1][0]), "+v"(acc[ai][bj][1][1]), "+v"(acc[ai][bj][2][0]), "+v"(acc[ai][bj][2][1]), "+v"(acc[ai][bj][3][0]), "+v"(acc[ai][bj][3][1]))
            PG8_PIN8(0, 0, "s_nop 15\n\ts_nop 15"); PG8_PIN8(0, 1, ""); PG8_PIN8(1, 0, ""); PG8_PIN8(1, 1, "");
#undef PG8_PIN8
        }
        if constexpr (!Epi::AFTER_DRAIN && !KEEP_OUT) { E(acc, cur, wr, wc, fr, fq); S.done(cur); }
        if (!has_next) break;
#pragma unroll
        for (int a = 0; a < 2; ++a)
#pragma unroll
            for (int b = 0; b < 2; ++b)
#pragma unroll
                for (int m = 0; m < 4; ++m)
#pragma unroll
                    for (int n = 0; n < 2; ++n) acc[a][b][m][n] = (f32x4){0.f, 0.f, 0.f, 0.f};
        cur = nxt; cA = nA; cB = nB; ++ui;
    }
    PG8_WAIT_V(0);
    if (wr == 0) PG8_BAR;
    PG8_BAR;
    if constexpr (Epi::AFTER_DRAIN && !KEEP_OUT) { E.fused(acc, cur, wr, wc, fr, fq, lds, wid, lane); S.done(cur); }
#undef PG8_SA
#undef PG8_SB
#undef PG8_STAGE
#undef PG8_LDA
#undef PG8_LDB
#undef PG8_MMA
#undef PG8_WAIT_V
#undef PG8_WAIT_L
#undef PG8_BAR
#undef PG8_SCHED
}
template <class Epi, class Sched, bool F8 = false>
__device__ __forceinline__ void gemm_phase(PG8_LAS unsigned char* lds, const Gemm g, const Sched& S, const Epi& E, int tid) {
    f32x4 acc[2][2][4][2];
    gemm_phase_core<Epi, Sched, false, false, F8>(lds, g, S, E, tid, acc);
}
}

namespace pg8 {
typedef const f32x4 (&AccRef)[2][2][4][2];
__device__ __forceinline__ u32x4 pack8(const f32x4 a, const f32x4 b) {
    unsigned x, y, z, w;
    asm volatile("s_nop 0\n\tv_cvt_pk_bf16_f32 %0, %4, %5\n\tv_cvt_pk_bf16_f32 %1, %6, %7\n\tv_cvt_pk_bf16_f32 %2, %8, %9\n\tv_cvt_pk_bf16_f32 %3, %10, %11"
        : "=&v"(x), "=&v"(y), "=&v"(z), "=&v"(w) : "v"(a[0]), "v"(a[1]), "v"(a[2]), "v"(a[3]), "v"(b[0]), "v"(b[1]), "v"(b[2]), "v"(b[3]));
    return (u32x4){x, y, z, w}; }
__device__ __forceinline__ void unpack8(const u32x4 w, f32x4& a, f32x4& b) {
    a[0] = __uint_as_float(w.x << 16); a[1] = __uint_as_float(w.x & 0xffff0000u); a[2] = __uint_as_float(w.y << 16); a[3] = __uint_as_float(w.y & 0xffff0000u);
    b[0] = __uint_as_float(w.z << 16); b[1] = __uint_as_float(w.z & 0xffff0000u); b[2] = __uint_as_float(w.w << 16); b[3] = __uint_as_float(w.w & 0xffff0000u); }
struct EpiWin {
    static constexpr bool PERM = true, AFTER_DRAIN = false;
    bf16_t* P; const float* gqa; const float* gka; const float* gqb; const float* gkb; const float* gqc; const float* gkc; LAS float* part; float zs = 1.0f;
    __device__ __forceinline__ void operator()(AccRef acc, const Unit& u, int wr, int wc, int fr_, int fq_) const {
        int fr = fr_, fq = fq_; asm volatile("" : "+v"(fr), "+v"(fq));
        const int row0 = u.pm * BM + wr * 64 + fr, pn = u.pn, colt = pn * BM, cw = wc * 32 + 8 * fq;
        const bool isv = (pn == 5) || (pn == 10) || (pn == 11) || (pn >= 16);
        if (isv) {
            const bool gate = pn >= 18;
#pragma unroll
            for (int ai = 0; ai < 2; ++ai)
#pragma unroll
                for (int m = 0; m < 4; ++m) { bf16_t* pp = P + (size_t)(row0 + ai * HALF + m * 16) * DIN + colt + cw;
#pragma unroll
                    for (int bj = 0; bj < 2; ++bj) { f32x4 v0 = acc[ai][bj][m][0], v1 = acc[ai][bj][m][1];
                        if (gate) {
#pragma unroll
                            for (int e = 0; e < 4; ++e) { v0[e] = sigmoidf(v0[e] * zs); v1[e] = sigmoidf(v1[e] * zs); } }
                        *(u32x4*)(pp + bj * HALF) = pack8(v0, v1); } }
            return;
        }
        int type; float qs; f32x4 g1, g2; const int grpA = wc >> 1, fA = 16 * (wc & 1) + 4 * fq, grpC = wc & 1, fC = 4 * fq;
        if (pn < 4) { type = 0; qs = 0.12751743f; g1 = *(const f32x4*)(gqa + 64 * grpA + fA); g2 = *(const f32x4*)(gqa + 64 * grpA + 32 + fA); }
        else if (pn == 4) { type = 0; qs = 1.f; g1 = *(const f32x4*)(gka + 64 * grpA + fA); g2 = *(const f32x4*)(gka + 64 * grpA + 32 + fA); }
        else if (pn < 8) { type = 1; qs = 0.12751743f; g1 = *(const f32x4*)(gqb + cw); g2 = *(const f32x4*)(gqb + cw + 4); }
        else if (pn < 10) { type = 1; qs = 1.f; g1 = *(const f32x4*)(gkb + cw); g2 = *(const f32x4*)(gkb + cw + 4); }
        else if (pn < 14) { type = 2; qs = 0.18033688f; g1 = *(const f32x4*)(gqc + 32 * grpC + fC); g2 = *(const f32x4*)(gqc + 32 * grpC + 16 + fC); }
        else { type = 2; qs = 1.f; g1 = *(const f32x4*)(gkc + 32 * grpC + fC); g2 = *(const f32x4*)(gkc + 32 * grpC + 16 + fC); }
        const int prow = wr * 64 + fr;
#pragma unroll
        for (int ai = 0; ai < 2; ++ai)
#pragma unroll
            for (int m = 0; m < 4; ++m)
#pragma unroll
                for (int bj = 0; bj < 2; ++bj) { const f32x4 a = acc[ai][bj][m][0], b = acc[ai][bj][m][1];
                    float s = (a[0] * a[0] + a[1] * a[1]) + (a[2] * a[2] + a[3] * a[3]) + (b[0] * b[0] + b[1] * b[1]) + (b[2] * b[2] + b[3] * b[3]);
                    s += swz_xor<16>(s);
                    { auto rr = __builtin_amdgcn_permlane32_swap(__float_as_uint(s), __float_as_uint(s), false, false); s = __uint_as_float(rr[0]) + __uint_as_float(rr[1]); }
                    if (fq == 0) part[((ai * HALF + m * 16 + prow) * 2 + bj) * 4 + wc] = s; }
        asm volatile("s_waitcnt lgkmcnt(0)" ::: "memory"); __builtin_amdgcn_s_barrier(); asm volatile("" ::: "memory");
        f32x4 inv = {0.f, 0.f, 0.f, 0.f}; const int grp = type == 0 ? grpA : grpC;
        if (type != 1) { const int f0 = type == 0 ? fA : fC; const float kf = type == 0 ? (13.287712379549449f / 32.0f) : (13.287712379549449f / 16.0f);
#pragma unroll
            for (int e = 0; e < 4; ++e) inv[e] = __builtin_amdgcn_exp2f(-(float)(f0 + e) * kf); }
        const bool rope = (type != 1) && (u.pm * BM < SEQ);
        const float invn = type == 2 ? (1.0f / 64.0f) : (1.0f / 128.0f);
#pragma unroll
        for (int ai = 0; ai < 2; ++ai)
#pragma unroll
            for (int m = 0; m < 4; ++m) {
                f32x4 cs = {1.f, 1.f, 1.f, 1.f}, sn = {0.f, 0.f, 0.f, 0.f};
                if (rope) { const float pos = grp ? (float)(m * 16 + fr) : (float)(4 * u.pm + 2 * ai + wr);
#pragma unroll
                    for (int e = 0; e < 4; ++e) { const float rev = __builtin_amdgcn_fractf(pos * inv[e] * 0.15915494309189535f); cs[e] = __builtin_amdgcn_cosf(rev); sn[e] = __builtin_amdgcn_sinf(rev); } }
                bf16_t* pp = P + (size_t)(row0 + ai * HALF + m * 16) * DIN + colt + cw;
#pragma unroll
                for (int bj = 0; bj < 2; ++bj) {
                    const f32x4 pq = *(const LAS f32x4*)(part + ((ai * HALF + m * 16 + prow) * 2 + bj) * 4);
                    const float tot = type == 2 ? ((wc & 2) ? pq[2] + pq[3] : pq[0] + pq[1]) : (pq[0] + pq[1]) + (pq[2] + pq[3]);
                    const float rstd = qs * __builtin_amdgcn_rsqf(tot * invn + EPS);
                    f32x4 v0, v1;
#pragma unroll
                    for (int e = 0; e < 4; ++e) { const float y1 = acc[ai][bj][m][0][e] * rstd * g1[e], y2 = acc[ai][bj][m][1][e] * rstd * g2[e];
                        v0[e] = y1 * cs[e] - y2 * sn[e]; v1[e] = y2 * cs[e] + y1 * sn[e]; }
                    *(u32x4*)(pp + bj * HALF) = pack8(v0, v1); }
                asm volatile("" ::: "memory"); }
    }
};
struct EpiGate {
    static constexpr bool PERM = true, AFTER_DRAIN = false;
    bf16_t* P;
    __device__ __forceinline__ void operator()(AccRef acc, const Unit& u, int wr, int wc, int fr, int fq) const {
        const int row0 = u.pm * BM + wr * 64 + fr, col0 = C_G + u.pn * BM + wc * 32 + 8 * fq;
#pragma unroll
        for (int ai = 0; ai < 2; ++ai)
#pragma unroll
            for (int m = 0; m < 4; ++m) { bf16_t* pp = P + (size_t)(row0 + ai * HALF + m * 16) * DIN + col0;
#pragma unroll
                for (int bj = 0; bj < 2; ++bj) { f32x4 v0 = acc[ai][bj][m][0], v1 = acc[ai][bj][m][1];
#pragma unroll
                    for (int e = 0; e < 4; ++e) { v0[e] = __builtin_amdgcn_rcpf(1.0f + __builtin_amdgcn_exp2f(v0[e] * (-1.4426950408889634f / 32.0f))); v1[e] = __builtin_amdgcn_rcpf(1.0f + __builtin_amdgcn_exp2f(v1[e] * (-1.4426950408889634f / 32.0f))); }
                    *(u32x4*)(pp + bj * HALF) = pack8(v0, v1); } }
    }
};
struct GateOrder {
    int first, count, stride;
    __device__ __forceinline__ void init(int c, int G) { stride = 1; if (G != 256) { first = c; stride = G; count = (33 * 24 - c + G - 1) / G; } else if (c < 82) { first = 2 * c; count = 2; } else if (c < 188) { first = 164 + 4 * (c - 82); count = 4; } else { first = 588 + 3 * (c - 188); count = 3; } }
    __device__ __forceinline__ bool next(int i, Unit& u) const { if (i >= count) return false; const int g = first + i * stride; u.pm = g / 24; u.pn = g % 24; return true; }
    __device__ __forceinline__ void a_ready(const Unit&) const {}
    __device__ __forceinline__ void done(const Unit&) const {}
};
template <int STEP> struct EpiBr {
    static constexpr bool PERM = true, AFTER_DRAIN = false;
    float* mf; bf16_t* mb; const bf16_t* P;
    __device__ __forceinline__ void operator()(AccRef acc, const Unit& u, int wr, int wc, int fr, int fq) const {
        const int row0 = u.pm * BM + wr * 64 + fr, col0 = u.pn * BM + wc * 32 + 8 * fq;
#pragma unroll
        for (int am = 0; am < 4; ++am) { const int ai = am >> 1, m0 = (am & 1) * 2;
            u32x4 gw[2][2]; f32x4 old0[2][2], old1[2][2];
#pragma unroll
            for (int mm = 0; mm < 2; ++mm)
#pragma unroll
                for (int bj = 0; bj < 2; ++bj) { const size_t row = (size_t)(row0 + ai * HALF + (m0 + mm) * 16); const int col = col0 + bj * HALF;
                    gw[mm][bj] = *(const u32x4*)(P + row * DIN + C_G + STEP * DM + col);
                    if (STEP > 0) { old0[mm][bj] = *(const f32x4*)(mf + row * DM + col); old1[mm][bj] = *(const f32x4*)(mf + row * DM + col + 4); } }
#pragma unroll
            for (int mm = 0; mm < 2; ++mm)
#pragma unroll
                for (int bj = 0; bj < 2; ++bj) { const size_t row = (size_t)(row0 + ai * HALF + (m0 + mm) * 16); const int col = col0 + bj * HALF;
                    f32x4 g0, g1; unpack8(gw[mm][bj], g0, g1);
                    f32x4 v0 = g0 * acc[ai][bj][m0 + mm][0], v1 = g1 * acc[ai][bj][m0 + mm][1];
                    if (STEP > 0) { v0 += old0[mm][bj]; v1 += old1[mm][bj]; }
                    float* mp = mf + row * DM + col;
                    if (STEP < 2) { *(f32x4*)mp = v0; *(f32x4*)(mp + 4) = v1; } else *(u32x4*)(mb + row * DM + col) = pack8(v0, v1); }
            asm volatile("" ::: "memory");
        }
    }
};

struct EpiBrChain {
    static constexpr bool PERM = true, AFTER_DRAIN = false;
    bf16_t* mb; const bf16_t* P;
    template <int GS> __device__ __forceinline__ void scale(f32x4 (&acc)[2][2][4][2], const Unit& u, int tid) const {
        asm volatile("" : "+v"(tid));
        const int wid = __builtin_amdgcn_readfirstlane(tid >> 6), lane = tid & 63, wr = wid >> 2, wc = wid & 3, fr = lane & 15, fq = lane >> 4;
        const bf16_t* gp0 = P + (size_t)(u.pm * BM + wr * 64 + fr) * DIN + C_G + GS * DM + u.pn * BM + wc * 32 + 8 * fq;
        typedef const __attribute__((address_space(1))) u32x4 gq;
        u32x4 cn[2], cd[2], nn[2], nd[2];
#define GLD(n_, d_, g_) do { const bf16_t* gp_ = gp0 + (size_t)(((g_) >> 2) * HALF + ((g_) & 3) * 16) * DIN; _Pragma("unroll") for (int bj = 0; bj < 2; ++bj) { n_[bj] = *(gq*)(gp_ + bj * HALF); d_[bj] = *(gq*)(gp_ + DM + bj * HALF); } } while (0)
        GLD(cn, cd, 0);
#pragma unroll
        for (int g = 0; g < 8; ++g) { const int ai = g >> 2, m = g & 3;
            if (g < 7) GLD(nn, nd, g + 1);
#pragma unroll
            for (int bj = 0; bj < 2; ++bj) { f32x4 n0, n1, d0, d1; unpack8(cn[bj], n0, n1); unpack8(cd[bj], d0, d1);
#pragma unroll
                for (int e = 0; e < 4; ++e) { const float a0 = GS ? fmaxf(n0[e], 1e-15f) : n0[e], a1 = GS ? fmaxf(n1[e], 1e-15f) : n1[e];
                    acc[ai][bj][m][0][e] *= a0 * __builtin_amdgcn_rcpf(fmaxf(d0[e], 1e-15f)); acc[ai][bj][m][1][e] *= a1 * __builtin_amdgcn_rcpf(fmaxf(d1[e], 1e-15f)); } }
            asm volatile("" : "+v"(acc[ai][0][m][0]), "+v"(acc[ai][0][m][1]), "+v"(acc[ai][1][m][0]), "+v"(acc[ai][1][m][1]) :: "memory");
#pragma unroll
            for (int bj = 0; bj < 2; ++bj) { cn[bj] = nn[bj]; cd[bj] = nd[bj]; }
        }
#undef GLD
    }
    __device__ __forceinline__ void operator()(AccRef acc, const Unit& u, int wr, int wc, int fr_, int fq) const {
        int fr = fr_; asm volatile("" : "+v"(fr));
        const int row0 = u.pm * BM + wr * 64 + fr, col0 = u.pn * BM + wc * 32 + 8 * fq;
#pragma unroll
        for (int am = 0; am < 4; ++am) { const int ai = am >> 1, m0 = (am & 1) * 2;
            u32x4 gw[2][2];
#pragma unroll
            for (int mm = 0; mm < 2; ++mm)
#pragma unroll
                for (int bj = 0; bj < 2; ++bj) gw[mm][bj] = *(const __attribute__((address_space(1))) u32x4*)(P + (size_t)(row0 + ai * HALF + (m0 + mm) * 16) * DIN + C_G + 2 * DM + col0 + bj * HALF);
#pragma unroll
            for (int mm = 0; mm < 2; ++mm)
#pragma unroll
                for (int bj = 0; bj < 2; ++bj) { f32x4 g0, g1; unpack8(gw[mm][bj], g0, g1);
#pragma unroll
                    for (int e = 0; e < 4; ++e) { g0[e] = fmaxf(g0[e], 1e-15f); g1[e] = fmaxf(g1[e], 1e-15f); }
                    *(u32x4*)(mb + (size_t)(row0 + ai * HALF + (m0 + mm) * 16) * DM + col0 + bj * HALF) = pack8(g0 * acc[ai][bj][m0 + mm][0], g1 * acc[ai][bj][m0 + mm][1]); }
            asm volatile("" ::: "memory"); }
    }
};
struct EpiRes {
    static constexpr bool PERM = false, AFTER_DRAIN = false;
    const float* h; const float* gx; const float* gc; float* dst;
    __device__ __forceinline__ void operator()(AccRef acc, const Unit& u, int wr, int wc, int fr, int fq) const {
        const int row0 = u.pm * BM + wr * 64 + fr, col0 = u.pn * BM + wc * 32 + 4 * fq;
        const float* gp = (u.pm * BM < SEQ ? gx : gc) + col0;
        f32x4 gv[2][2];
#pragma unroll
        for (int bj = 0; bj < 2; ++bj)
#pragma unroll
            for (int n = 0; n < 2; ++n) gv[bj][n] = *(const f32x4*)(gp + bj * HALF + n * 16);
#pragma unroll
        for (int am = 0; am < 4; ++am) { const int ai = am >> 1, m0 = (am & 1) * 2;
            f32x4 old[2][2][2];
#pragma unroll
            for (int mm = 0; mm < 2; ++mm)
#pragma unroll
                for (int bj = 0; bj < 2; ++bj)
#pragma unroll
                    for (int n = 0; n < 2; ++n) old[mm][bj][n] = *(const f32x4*)(h + (size_t)(row0 + ai * HALF + (m0 + mm) * 16) * DM + col0 + bj * HALF + n * 16);
#pragma unroll
            for (int mm = 0; mm < 2; ++mm)
#pragma unroll
                for (int bj = 0; bj < 2; ++bj)
#pragma unroll
                    for (int n = 0; n < 2; ++n) *(f32x4*)(dst + (size_t)(row0 + ai * HALF + (m0 + mm) * 16) * DM + col0 + bj * HALF + n * 16) = old[mm][bj][n] + gv[bj][n] * acc[ai][bj][m0 + mm][n];
            asm volatile("" ::: "memory"); }
    }
};
__device__ __forceinline__ float dpp_ror1(float v)  { return __int_as_float(__builtin_amdgcn_update_dpp(__float_as_int(v), __float_as_int(v), 0x121, 0xf, 0xf, false)); }
__device__ __forceinline__ float dpp_ror15(float v) { return __int_as_float(__builtin_amdgcn_update_dpp(__float_as_int(v), __float_as_int(v), 0x12f, 0xf, 0xf, false)); }
struct EpiUp {
    static constexpr bool PERM = true, AFTER_DRAIN = false;
    bf16_t* act; float* E; const float* cw; const float* cb;
    __device__ __forceinline__ void operator()(AccRef acc, const Unit& u, int wr, int wc, int fr, int fq) const {
        const int ch0 = u.pn * 128 + wc * 32 + 8 * fq, ycol0 = u.pn * BM + wc * 32 + 8 * fq;
#pragma unroll
        for (int nn = 0; nn < 2; ++nn) {
            const int ch = ch0 + 4 * nn;
            const f32x4 wa0 = *(const f32x4*)(cw + ch), wa1 = *(const f32x4*)(cw + DUP + ch), wa2 = *(const f32x4*)(cw + 2 * DUP + ch), ba = *(const f32x4*)(cb + ch);
            const f32x4 wg0 = *(const f32x4*)(cw + DFF + ch), wg1 = *(const f32x4*)(cw + DUP + DFF + ch), wg2 = *(const f32x4*)(cw + 2 * DUP + DFF + ch), bg = *(const f32x4*)(cb + DFF + ch);
#pragma unroll
            for (int ai = 0; ai < 2; ++ai) {
                const int blk = 4 * u.pm + 2 * ai + wr;
#pragma unroll
                for (int m = 0; m < 4; ++m) {
                    const f32x4 ya = acc[ai][0][m][nn], yg = acc[ai][1][m][nn];
                    const f32x4 pa = acc[ai][0][m > 0 ? m - 1 : 0][nn], pg = acc[ai][1][m > 0 ? m - 1 : 0][nn];
                    const f32x4 na = acc[ai][0][m < 3 ? m + 1 : 3][nn], ng = acc[ai][1][m < 3 ? m + 1 : 3][nn];
                    f32x4 o, ha4, hg4;
#pragma unroll
                    for (int e = 0; e < 4; ++e) {
                        const float ua = dpp_ror1(fr == 15 ? pa[e] : ya[e]), ug = dpp_ror1(fr == 15 ? pg[e] : yg[e]);
                        const float da = dpp_ror15(fr == 0 ? na[e] : ya[e]), dg = dpp_ror15(fr == 0 ? ng[e] : yg[e]);
                        ha4[e] = ba[e] + wa0[e] * ua + wa1[e] * ya[e] + wa2[e] * da;
                        hg4[e] = bg[e] + wg0[e] * ug + wg1[e] * yg[e] + wg2[e] * dg;
                    }
                    {
                        f32x4 t = hg4 * -1.4426950408889634f;
#pragma unroll
                        for (int e = 0; e < 4; ++e) t[e] = __builtin_amdgcn_exp2f(t[e]);
                        t = t + 1.0f;
#pragma unroll
                        for (int e = 0; e < 4; ++e) t[e] = __builtin_amdgcn_rcpf(t[e]);
                        o = (hg4 * ha4) * t;
                    }
                    const int row = u.pm * BM + ai * HALF + wr * 64 + m * 16 + fr;
                    const bool edge = (m == 0 && fr == 0) || (m == 3 && fr == 15);
                    if (!edge) { u32x2 w; w.x = cvt_pk_bf16(o[0], o[1]); w.y = cvt_pk_bf16(o[2], o[3]); *(u32x2*)(act + (size_t)row * DFF + ch) = w; }
                    if ((m == 0 && fr < 2) || (m == 3 && fr >= 14)) {
                        const int slot = (m == 0) ? fr : fr - 12;
                        float* ep = E + ((size_t)blk * 4 + slot) * DUP + ycol0 + 4 * nn; *(f32x4*)ep = ya; *(f32x4*)(ep + HALF) = yg;
                    }
                }
            }
        }
    }
};
struct EpiY {
    static constexpr bool PERM = false, AFTER_DRAIN = false;
    float* Y;
    __device__ __forceinline__ void operator()(AccRef acc, const Unit& u, int wr, int wc, int fr, int fq) const {
        const int row0 = u.pm * BM + wr * 64 + fr, col0 = u.pn * BM + wc * 32 + 4 * fq;
#pragma unroll
        for (int ai = 0; ai < 2; ++ai)
#pragma unroll
            for (int m = 0; m < 4; ++m) { float* yp = Y + (size_t)(row0 + ai * HALF + m * 16) * DUP + col0;
#pragma unroll
                for (int bj = 0; bj < 2; ++bj)
#pragma unroll
                    for (int n = 0; n < 2; ++n) *(f32x4*)(yp + bj * HALF + n * 16) = acc[ai][bj][m][n]; }
    }
};
}

namespace att {
constexpr int D = 128, NW = 8, QBLK = 32, KVBLK = 64, LDP = DIN;
constexpr int SHM_V = KVBLK * D * 2, SHM_K = SHM_V;
constexpr int TILE_B = SHM_K + SHM_V, NRING = 4;
constexpr int OFF_WS = NRING * TILE_B, OFF_BIAS = OFF_WS + NW * 64 * 4, BIAS_PAD = 64, BIAS_N = 15 * 31, SHM_TOTAL = OFF_BIAS + (2 * BIAS_PAD + 480) * 4;
#define KSWZ(row, colB) ((row) * 256 + ((colB) ^ (((row) & 7) << 4)))
#define SBAR() __builtin_amdgcn_sched_barrier(0)
#define LAUNDER(p) asm volatile("" : "+v"(p))
__device__ __forceinline__ int crow(int r, int hi) { return (r & 3) + 8 * (r >> 2) + 4 * hi; }

struct Unit {
    const bf16_t* Q;
    const bf16_t* K;
    const bf16_t* V;
    int nt, key0;
    int rsA, r0;
    bf16_t* O; int ldo;
    float* S;
    const float* gsub; float lam, osc;
    float shift;
    int tmask;
    int var;
};

template <bool SUM = true>
__device__ __forceinline__ void halfSM(f32x16& p, float& l_reg, bf16x8& paX, bf16x8& paY) {
#pragma unroll
    for (int r = 0; r < 16; ++r) p[r] = __builtin_amdgcn_exp2f(p[r]);
    if constexpr (SUM) { float ps = 0;
#pragma unroll
        for (int r = 0; r < 16; ++r) ps += p[r];
        l_reg += ps; }
#define PK4(P, BASE, OUT) do { unsigned a0, a1, b0, b1; \
    asm volatile("s_nop 0\n\tv_cvt_pk_bf16_f32 %0, %4, %5\n\tv_cvt_pk_bf16_f32 %1, %6, %7\n\tv_cvt_pk_bf16_f32 %2, %8, %9\n\tv_cvt_pk_bf16_f32 %3, %10, %11" \
        : "=&v"(a0), "=&v"(a1), "=&v"(b0), "=&v"(b1) : "v"(P[BASE + 0]), "v"(P[BASE + 1]), "v"(P[BASE + 2]), "v"(P[BASE + 3]), "v"(P[BASE + 4]), "v"(P[BASE + 5]), "v"(P[BASE + 6]), "v"(P[BASE + 7])); \
    auto r0 = __builtin_amdgcn_permlane32_swap(a0, b0, false, false); auto r1 = __builtin_amdgcn_permlane32_swap(a1, b1, false, false); \
    u32x4 w = {r0[0], r1[0], r0[1], r1[1]}; OUT = *reinterpret_cast<bf16x8*>(&w); } while (0)
    PK4(p, 0, paX); PK4(p, 8, paY);
#undef PK4
}
template <int NDQ, int DB, bool SHIFT>
__device__ __forceinline__ void qkt(f32x16& p0, f32x16& p1, const char* Ks, const bf16x8* qr, int r32, int hi, float shift) {
    p0 = f32x16{}; p1 = f32x16{};
#pragma unroll
    for (int d0 = 0; d0 < NDQ; ++d0) { const int cb = ((DB + d0) * 16 + hi * 8) * 2;
        const bf16x8 b0 = *reinterpret_cast<const bf16x8*>(Ks + KSWZ(r32, cb));
        const bf16x8 b1 = *reinterpret_cast<const bf16x8*>(Ks + KSWZ(32 + r32, cb));
        p0 = __builtin_amdgcn_mfma_f32_32x32x16_bf16(b0, qr[d0], p0, 0, 0, 0);
        p1 = __builtin_amdgcn_mfma_f32_32x32x16_bf16(b1, qr[d0], p1, 0, 0, 0); }
    if (SHIFT && shift != 0.f) {
        const short one = hi == 0 ? (short)0x3f80 : (short)0, ms = hi == 0 ? (short)f2bf(-shift) : (short)0;
        const bf16x8 af = {one, 0, 0, 0, 0, 0, 0, 0}, bf = {ms, 0, 0, 0, 0, 0, 0, 0};
        p0 = __builtin_amdgcn_mfma_f32_32x32x16_bf16(af, bf, p0, 0, 0, 0);
        p1 = __builtin_amdgcn_mfma_f32_32x32x16_bf16(af, bf, p1, 0, 0, 0); }
}
__device__ __forceinline__ int v_st(int k, int c) { const int kk = (k & ~0xC) | ((k & 4) << 1) | ((k & 8) >> 1); return ((kk >> 3) * 4 + (c >> 5)) * 512 + ((kk & 7) * 32 + (c & 31)) * 2; }
__device__ __forceinline__ int v_rd_base(int lane) { return ((lane & 3) << 3) | (((lane >> 2) & 3) << 6) | (((lane >> 4) & 1) << 5) | (((lane >> 5) & 1) << 8); }
constexpr int v_rd_off(int d0, int ks, int half) { return d0 * 512 + ks * 4096 + half * 2048; }
template <int OFF> __device__ __forceinline__ s16x4 tr_read(int vb) {
    s16x4 r; asm volatile("ds_read_b64_tr_b16 %0, %1 offset:%2" : "=&v"(r) : "v"(vb), "i"(OFF) : "memory"); return r;
}
template <int D0> __device__ __forceinline__ void pv_one(f32x16& od, int vb, bf16x8 pa0, bf16x8 pa1, bf16x8 pa2, bf16x8 pa3) {
    const s16x4 l0 = tr_read<v_rd_off(D0, 0, 0)>(vb), h0 = tr_read<v_rd_off(D0, 0, 1)>(vb), l1 = tr_read<v_rd_off(D0, 1, 0)>(vb), h1 = tr_read<v_rd_off(D0, 1, 1)>(vb);
    const s16x4 l2 = tr_read<v_rd_off(D0, 2, 0)>(vb), h2 = tr_read<v_rd_off(D0, 2, 1)>(vb), l3 = tr_read<v_rd_off(D0, 3, 0)>(vb), h3 = tr_read<v_rd_off(D0, 3, 1)>(vb);
    asm volatile("s_waitcnt lgkmcnt(0)" ::: "memory"); SBAR();
#define PK(L, H) (bf16x8){L[0], L[1], L[2], L[3], H[0], H[1], H[2], H[3]}
    od = __builtin_amdgcn_mfma_f32_32x32x16_bf16(pa0, PK(l0, h0), od, 0, 0, 0);
    od = __builtin_amdgcn_mfma_f32_32x32x16_bf16(pa1, PK(l1, h1), od, 0, 0, 0);
    od = __builtin_amdgcn_mfma_f32_32x32x16_bf16(pa2, PK(l2, h2), od, 0, 0, 0);
    od = __builtin_amdgcn_mfma_f32_32x32x16_bf16(pa3, PK(l3, h3), od, 0, 0, 0);
#undef PK
}
__device__ __forceinline__ void pv_d0(f32x16* o, int vb, bf16x8 pa0, bf16x8 pa1, bf16x8 pa2, bf16x8 pa3) {
    pv_one<0>(o[0], vb, pa0, pa1, pa2, pa3); pv_one<1>(o[1], vb, pa0, pa1, pa2, pa3); pv_one<2>(o[2], vb, pa0, pa1, pa2, pa3); pv_one<3>(o[3], vb, pa0, pa1, pa2, pa3);
}


template <int OFF> __device__ __forceinline__ bf16x8 k_read(int addr) { bf16x8 r; asm volatile("ds_read_b128 %0, %1 offset:%2" : "=&v"(r) : "v"(addr), "i"(OFF) : "memory"); return r; }
#define LWAIT(n) do { asm volatile("s_waitcnt lgkmcnt(" #n ")" ::: "memory"); SBAR(); } while (0)
template <int D0> __device__ __forceinline__ void v_read8(s16x4 (&v)[8], int vb) {
    v[0] = tr_read<v_rd_off(D0, 0, 0)>(vb); v[1] = tr_read<v_rd_off(D0, 0, 1)>(vb); v[2] = tr_read<v_rd_off(D0, 1, 0)>(vb); v[3] = tr_read<v_rd_off(D0, 1, 1)>(vb);
    v[4] = tr_read<v_rd_off(D0, 2, 0)>(vb); v[5] = tr_read<v_rd_off(D0, 2, 1)>(vb); v[6] = tr_read<v_rd_off(D0, 3, 0)>(vb); v[7] = tr_read<v_rd_off(D0, 3, 1)>(vb);
}
__device__ __forceinline__ void pv_mma(f32x16& od, const s16x4 (&v)[8], bf16x8 pa0, bf16x8 pa1, bf16x8 pa2, bf16x8 pa3) {
#define PK(L, H) (bf16x8){L[0], L[1], L[2], L[3], H[0], H[1], H[2], H[3]}
    od = __builtin_amdgcn_mfma_f32_32x32x16_bf16(pa0, PK(v[0], v[1]), od, 0, 0, 0);
    od = __builtin_amdgcn_mfma_f32_32x32x16_bf16(pa1, PK(v[2], v[3]), od, 0, 0, 0);
    od = __builtin_amdgcn_mfma_f32_32x32x16_bf16(pa2, PK(v[4], v[5]), od, 0, 0, 0);
    od = __builtin_amdgcn_mfma_f32_32x32x16_bf16(pa3, PK(v[6], v[7]), od, 0, 0, 0);
#undef PK
}
template <int NDQ, int DB, bool SHIFT>
__device__ __forceinline__ void x_phase(f32x16& p0, f32x16& p1, f32x16 (&o)[4], const bf16x8* qr, const int (&ka)[4], int kd, int vb, bool do_pv, s16x4 (&va)[8],
                                        bf16x8 pa0, bf16x8 pa1, bf16x8 pa2, bf16x8 pa3, float shift, int hi, int var, f32x16& osum) {
    bf16x8 kf[2 * NDQ]; s16x4 vbk[8];
    const bf16x8 ones_ = {(short)0x3f80, (short)0x3f80, (short)0x3f80, (short)0x3f80, (short)0x3f80, (short)0x3f80, (short)0x3f80, (short)0x3f80};
#define OSUM(pa_) do { if constexpr (NDQ == 4) osum = __builtin_amdgcn_mfma_f32_32x32x16_bf16(pa_, ones_, osum, 0, 0, 0); } while (0)
    int kb[4];
#pragma unroll
    for (int b = 0; b < 4; ++b) kb[b] = ka[b] + (DB >= 4 ? kd : 0);
    asm volatile("s_waitcnt lgkmcnt(0)" ::: "memory");
    SBAR();
#pragma unroll
    for (int b = 0; b < 4; ++b) { kf[2 * b] = k_read<0>(kb[b]); kf[2 * b + 1] = k_read<8192>(kb[b]); }
    if (do_pv) {
        v_read8<1>(vbk, vb); LWAIT(8); pv_mma(o[0], va, pa0, pa1, pa2, pa3); OSUM(pa0); SBAR();
        v_read8<2>(va, vb);  LWAIT(8); pv_mma(o[1], vbk, pa0, pa1, pa2, pa3); OSUM(pa1); SBAR();
        v_read8<3>(vbk, vb); LWAIT(8); pv_mma(o[2], va, pa0, pa1, pa2, pa3); OSUM(pa2); SBAR();
    }
    if constexpr (NDQ == 8) {
#pragma unroll
        for (int b = 0; b < 4; ++b) { kf[8 + 2 * b] = k_read<0>(ka[b] + kd); kf[8 + 2 * b + 1] = k_read<8192>(ka[b] + kd); }
        if (do_pv) { LWAIT(8); pv_mma(o[3], vbk, pa0, pa1, pa2, pa3); SBAR(); } else LWAIT(8);
    } else { if (do_pv) { LWAIT(0); pv_mma(o[3], vbk, pa0, pa1, pa2, pa3); OSUM(pa3); SBAR(); } else LWAIT(0); }
#undef OSUM
    p0 = f32x16{}; p1 = f32x16{};
#pragma unroll
    for (int d0 = 0; d0 < 4; ++d0) { p0 = __builtin_amdgcn_mfma_f32_32x32x16_bf16(kf[2 * d0], qr[d0], p0, 0, 0, 0); p1 = __builtin_amdgcn_mfma_f32_32x32x16_bf16(kf[2 * d0 + 1], qr[d0], p1, 0, 0, 0); }
    SBAR();
    if constexpr (NDQ == 8) {
        LWAIT(0);
#pragma unroll
        for (int d0 = 4; d0 < 8; ++d0) { p0 = __builtin_amdgcn_mfma_f32_32x32x16_bf16(kf[2 * d0], qr[d0], p0, 0, 0, 0); p1 = __builtin_amdgcn_mfma_f32_32x32x16_bf16(kf[2 * d0 + 1], qr[d0], p1, 0, 0, 0); }
        SBAR();
    }
    if (SHIFT && shift != 0.f) {
        const short one = hi == 0 ? (short)0x3f80 : (short)0, ms = hi == 0 ? (short)f2bf(-shift) : (short)0;
        const bf16x8 af = {one, 0, 0, 0, 0, 0, 0, 0}, bfr = {ms, 0, 0, 0, 0, 0, 0, 0};
        p0 = __builtin_amdgcn_mfma_f32_32x32x16_bf16(af, bfr, p0, 0, 0, 0); p1 = __builtin_amdgcn_mfma_f32_32x32x16_bf16(af, bfr, p1, 0, 0, 0); SBAR();
    }
}

struct NaCtx { int rsA, rq, rsq, cq, csq; const float* bias; };
template <bool NA, int HALF_>
__device__ __forceinline__ void na_hook(f32x16& p, int t, const NaCtx& n, int hi) {
    if constexpr (NA) {
        if (t >= 4) {
            const int kr = n.rsA + t - 4;
            if (kr < n.rsq || kr >= n.rsq + 8) {
#pragma unroll
                for (int r = 0; r < 16; ++r) p[r] = -1e30f;
            } else {
                const float* brow = n.bias + (kr - n.rq + 7) * 31 + 15 - n.cq + 32 * HALF_;
#pragma unroll
                for (int rg = 0; rg < 16; rg += 8) {
                    float b[8];
#pragma unroll
                    for (int r = 0; r < 8; ++r) b[r] = brow[crow(rg + r, hi)];
                    asm volatile("s_waitcnt lgkmcnt(0)" ::: "memory");
#pragma unroll
                    for (int r = 0; r < 8; ++r) { const int kc = crow(rg + r, hi) + 32 * HALF_; p[rg + r] = (kc >= n.csq && kc < n.csq + 16) ? p[rg + r] + b[r] : -1e30f; }
                }
            }
        }
    }
}

template <int NDQ, int DB, bool NA, int EPI, bool SHIFT>
__device__ __forceinline__ void attn_body(const Unit& u, char* lds, int tid) {
    asm volatile("" : "+v"(tid));
    const int wid = __builtin_amdgcn_readfirstlane(tid >> 6), lane = tid & 63, r32 = lane & 31, hi = lane >> 5;
    const bool trail = wid >= 4;
    float* li_l = (float*)(lds + OFF_WS) + wid * 64;
    float l_reg = 0; f32x16 o[4] = {}; bf16x8 qr[NDQ]; const float shift = u.shift;
    f32x16 osum = {};
    typedef __attribute__((address_space(1))) const bf16x8 gbf16x8;
    const bf16_t* Qw = u.Q + (long)(wid * QBLK + r32) * LDP + hi * 8 + DB * 16;
#pragma unroll
    for (int d0 = 0; d0 < NDQ; ++d0) qr[d0] = *(gbf16x8*)(Qw + d0 * 16);
    const int vb0 = (int)(uintptr_t)lds + SHM_K + v_rd_base(lane);
    int ka0[4];
#pragma unroll
    for (int b = 0; b < 4; ++b) ka0[b] = (int)(uintptr_t)lds + r32 * 256 + 16 * ((2 * b) ^ (hi ^ (r32 & 7))) + 128 * ((r32 >> 3) & 1);
    const int kd = 128 - 256 * ((r32 >> 3) & 1);
    NaCtx na;
    if constexpr (NA) { na.rsA = u.rsA; na.rq = u.r0 + (wid >> 1); na.rsq = min(max(na.rq - 4, 0), 120); na.cq = 32 * (wid & 1) + r32; na.csq = min(max(na.cq - 8, 0), 48); na.bias = (const float*)(lds + OFF_BIAS) + BIAS_PAD; }
    unsigned koff[2], voff[2];
#pragma unroll
    for (int i = 0; i < 2; ++i) { const int G = wid * 128 + i * 64 + lane;
        { const int row = G >> 4, g = (G & 15) ^ (row & 15); koff[i] = (unsigned)(row * LDP + g * 8) * 2u; }
        { const int sub = G >> 5, r8 = (G >> 2) & 7, c4 = G & 3, kk = (sub >> 2) * 8 + r8, cg = (sub & 3) * 4 + c4, k = (kk & ~0xC) | ((kk & 4) << 1) | ((kk & 8) >> 1); voff[i] = (unsigned)(k * LDP + cg * 8) * 2u; } }
    const char* Kg = (const char*)u.K; const char* Vg = (const char*)u.V;
    LAS unsigned char* ldsL = (LAS unsigned char*)(unsigned)(uintptr_t)lds;
#define TROW(t) (NA ? ((t) < 4 ? SEQ + 64 * ((t) & u.tmask) : (u.rsA + (((t) - 4) & u.tmask)) * 64) : u.key0 + 64 * ((t) & u.tmask))
    const __amdgpu_buffer_rsrc_t rK_ = __builtin_amdgcn_make_buffer_rsrc((void*)launder_uniform(Kg), 0, 0x7fffffff, 0x00020000);
    const __amdgpu_buffer_rsrc_t rV_ = __builtin_amdgcn_make_buffer_rsrc((void*)launder_uniform(Vg), 0, 0x7fffffff, 0x00020000);
#define DMA_TILE(t, boff) do { const int rb_ = __builtin_amdgcn_readfirstlane((TROW(t)) * (LDP * 2)); _Pragma("unroll") for (int i_ = 0; i_ < 2; ++i_) { \
        __builtin_amdgcn_raw_ptr_buffer_load_lds(rK_, (LAS void*)(ldsL + (boff) + wid * 2048 + i_ * 1024), 16, koff[i_], rb_, 0, 0); \
        __builtin_amdgcn_raw_ptr_buffer_load_lds(rV_, (LAS void*)(ldsL + (boff) + SHM_K + wid * 2048 + i_ * 1024), 16, voff[i_], rb_, 0, 0); } } while (0)
#define VWAIT() asm volatile("s_waitcnt vmcnt(0)" ::: "memory")
#define PBAR() do { asm volatile("s_waitcnt lgkmcnt(0)" ::: "memory"); __builtin_amdgcn_s_barrier(); asm volatile("" ::: "memory"); } while (0)
    bf16x8 pa0, pa1, pa2, pa3; f32x16 p0, p1; s16x4 va[8]; const int NT = u.nt;
#if MK_ATT_1BAR
#define SLOT(t) (((t) & (NRING - 1)) * TILE_B)
#define ENDI(k) do { if ((k) + 2 < NT) asm volatile("s_waitcnt vmcnt(4)" ::: "memory"); else VWAIT(); PBAR(); } while (0)
    DMA_TILE(0, 0); DMA_TILE(1, TILE_B); VWAIT(); PBAR();
    if (trail && 2 < NT) DMA_TILE(2, 2 * TILE_B);
    int b_prev = 3 * TILE_B, b_cur = 0;
    for (int i = 0; i < NT; ++i) {
        { int ka[4];
#pragma unroll
          for (int b = 0; b < 4; ++b) ka[b] = ka0[b] + b_cur;
          x_phase<NDQ, DB, SHIFT>(p0, p1, o, qr, ka, kd, vb0 + b_prev, i >= 1, va, pa0, pa1, pa2, pa3, shift, hi, 0, osum); }
        if (trail) ENDI(i);
        { const int td = trail ? i + 3 : i + 2; if (td < NT) DMA_TILE(td, SLOT(td)); }
        na_hook<NA, 0>(p0, i, na, hi); halfSM<NDQ != 4>(p0, l_reg, pa0, pa1); SBAR();
        na_hook<NA, 1>(p1, i, na, hi); halfSM<NDQ != 4>(p1, l_reg, pa2, pa3);
        asm volatile("" : "+v"(l_reg));
        SBAR(); v_read8<0>(va, vb0 + b_cur);
        if (!trail) ENDI(i); else { asm volatile("" ::: "memory"); SBAR(); }
        b_prev = b_cur; b_cur = (b_cur + TILE_B) & (NRING * TILE_B - 1);
    }
#undef SLOT
#undef ENDI
#else
    DMA_TILE(0, 0); DMA_TILE(1, TILE_B); VWAIT(); PBAR();
    if (trail) PBAR();
    int b_prev = 3 * TILE_B, b_cur = 0;
    for (int i = 0; i < NT; ++i) {
        { int ka[4];
#pragma unroll
          for (int b = 0; b < 4; ++b) ka[b] = ka0[b] + b_cur;
          x_phase<NDQ, DB, SHIFT>(p0, p1, o, qr, ka, kd, vb0 + b_prev, i >= 1, va, pa0, pa1, pa2, pa3, shift, hi, u.var, osum); }
        VWAIT();
        PBAR();
        if (i + 2 < NT && !(u.var & 8)) DMA_TILE(i + 2, (b_cur + 2 * TILE_B) & (NRING * TILE_B - 1));
        if (!(u.var & 2)) { na_hook<NA, 0>(p0, i, na, hi); halfSM<NDQ != 4>(p0, l_reg, pa0, pa1); SBAR();
        na_hook<NA, 1>(p1, i, na, hi); halfSM<NDQ != 4>(p1, l_reg, pa2, pa3); }
        asm volatile("" : "+v"(l_reg));
        SBAR(); if (!(u.var & 16)) v_read8<0>(va, vb0 + b_cur);
        PBAR();
        b_prev = b_cur; b_cur = (b_cur + TILE_B) & (NRING * TILE_B - 1);
    }
#endif
    {
        s16x4 vbk[8];
        v_read8<1>(vbk, vb0 + b_prev); LWAIT(8); pv_mma(o[0], va, pa0, pa1, pa2, pa3); SBAR();
        v_read8<2>(va, vb0 + b_prev);  LWAIT(8); pv_mma(o[1], vbk, pa0, pa1, pa2, pa3); SBAR();
        v_read8<3>(vbk, vb0 + b_prev); LWAIT(8); pv_mma(o[2], va, pa0, pa1, pa2, pa3); SBAR();
        LWAIT(0); pv_mma(o[3], vbk, pa0, pa1, pa2, pa3); SBAR();
        if constexpr (NDQ == 4) { const bf16x8 ones_ = {(short)0x3f80, (short)0x3f80, (short)0x3f80, (short)0x3f80, (short)0x3f80, (short)0x3f80, (short)0x3f80, (short)0x3f80};
            osum = __builtin_amdgcn_mfma_f32_32x32x16_bf16(pa0, ones_, osum, 0, 0, 0); osum = __builtin_amdgcn_mfma_f32_32x32x16_bf16(pa1, ones_, osum, 0, 0, 0);
            osum = __builtin_amdgcn_mfma_f32_32x32x16_bf16(pa2, ones_, osum, 0, 0, 0); osum = __builtin_amdgcn_mfma_f32_32x32x16_bf16(pa3, ones_, osum, 0, 0, 0); SBAR(); }
    }
#if !MK_ATT_1BAR
    if (!trail) PBAR();
#endif
    float rli[16];
    if constexpr (NDQ == 4) {
#pragma unroll
        for (int r = 0; r < 16; ++r) rli[r] = __builtin_amdgcn_rcpf(osum[r]);
    } else {
    { auto rr = __builtin_amdgcn_permlane32_swap(__float_as_uint(l_reg), __float_as_uint(l_reg), false, false); l_reg = __uint_as_float(rr[0]) + __uint_as_float(rr[1]); }
    if (hi == 0) li_l[r32] = l_reg; asm volatile("s_waitcnt lgkmcnt(0)" ::: "memory");
#pragma unroll
    for (int r = 0; r < 16; ++r) rli[r] = __builtin_amdgcn_rcpf(li_l[crow(r, hi)]);
    }
    if constexpr (EPI == 0) {
        bf16_t* Ow = u.O + (long)(wid * QBLK) * u.ldo + r32; LAUNDER(Ow);
#pragma unroll
        for (int r = 0; r < 16; ++r) { const int orow = crow(r, hi);
#pragma unroll
            for (int d0 = 0; d0 < 4; ++d0) Ow[(long)orow * u.ldo + d0 * 32] = f2bf(o[d0][r] * rli[r]); }
    } else if constexpr (EPI == 1) {
        float* Sw = u.S + (long)(wid * QBLK) * 512 + r32; LAUNDER(Sw);
#pragma unroll
        for (int r = 0; r < 16; ++r) { const int orow = crow(r, hi);
#pragma unroll
            for (int d0 = 0; d0 < 4; ++d0) Sw[(long)orow * 512 + d0 * 32] = o[d0][r] * rli[r]; }
    } else {
        const float* Sw = u.S + (long)(wid * QBLK) * 512 + r32; bf16_t* Ow = u.O + (long)(wid * QBLK) * u.ldo + r32; LAUNDER(Sw); LAUNDER(Ow);
        float gg[4];
#pragma unroll
        for (int d0 = 0; d0 < 4; ++d0) gg[d0] = u.gsub[d0 * 32 + r32] * u.osc;
#pragma unroll
        for (int r = 0; r < 16; ++r) { const int orow = crow(r, hi); float v[4]; float ss = 0.f;
#pragma unroll
            for (int d0 = 0; d0 < 4; ++d0) { v[d0] = Sw[(long)orow * 512 + d0 * 32] - u.lam * (o[d0][r] * rli[r]); ss += v[d0] * v[d0]; }
            ss = half_sum(ss);
            const float rstd = __builtin_amdgcn_rsqf(ss * (1.0f / 128.0f) + EPS);
#pragma unroll
            for (int d0 = 0; d0 < 4; ++d0) Ow[(long)orow * u.ldo + d0 * 32] = f2bf(v[d0] * rstd * gg[d0]); asm volatile("" ::: "memory"); }
    }
    asm volatile("s_waitcnt vmcnt(0) lgkmcnt(0)" ::: "memory");
    __builtin_amdgcn_s_barrier();
    asm volatile("" ::: "memory");
#undef TROW
#undef DMA_TILE
#undef VWAIT
#undef PBAR
}
}

__device__ __forceinline__ int q_pop(unsigned* ctr, char* lds, int tid_) {
    volatile int* slot = (volatile int*)(lds + att::SHM_TOTAL);
    __syncthreads();
    if (tid_ == 0) *slot = (int)__hip_atomic_fetch_add(ctr, 1u, __ATOMIC_RELAXED, __HIP_MEMORY_SCOPE_AGENT);
    __syncthreads();
    return *slot;
}
__device__ __forceinline__ void phase_attn(int wid_k, int l, char* lds, int rep) {
    PHASE_ENTER(cin)
    unsigned* qctr = (unsigned*)(c.ws + WS_CTL + 16384) + (l + 4 * rep) * 256;
    bf16_t* const oa_ = rep ? (bf16_t*)(c.ws + WS_ACT) : c.oa(); bf16_t* const ob_ = oa_ + 1024; bf16_t* const oc_ = oa_ + 1536; float* const ocs_ = rep ? (float*)(c.ws + WS_ACT + (size_t)MT * 2048 * 2) : c.ocs();
    const bool last = (l == DEPTH - 1);
    const float lam = c.lam()[l], osc = 1.0f - (0.8f - 0.6f * expf(-0.3f * (float)l));
    float shA, shB, shC;
    {
        const int lane = tid_ & 63;
        const float mA = 11.313708f * vmax_abs(c.in[I_GQA] + l * 128, 128, lane) * vmax_abs(c.in[I_GKA] + l * 128, 128, lane) * 1.4426950f;
        const float mB = (11.313708f * vmax_abs(c.in[I_GQB] + l * 128, 128, lane) * vmax_abs(c.in[I_GKB] + l * 128, 128, lane) + vmax_abs(c.in[I_RPB] + (size_t)l * 4 * att::BIAS_N, 4 * att::BIAS_N, lane)) * 1.4426950f;
        const float mC = 8.0f * vmax_abs(c.in[I_GQC] + l * 64, 64, lane) * vmax_abs(c.in[I_GKC] + l * 64, 64, lane) * 1.4426950f;
#define SGPR_F(x_) __uint_as_float(__builtin_amdgcn_readfirstlane(__float_as_uint(x_)))
        shA = SGPR_F(fmaxf(0.f, mA - 100.f)); shB = SGPR_F(fmaxf(0.f, mB - 100.f)); shC = SGPR_F(fmaxf(0.f, mC - 100.f));
#undef SGPR_F
    }
    for (;;) {
        const int id = q_pop(qctr + 0, lds, tid_);
        if (id >= 128 + (last ? 0 : 4)) break;
        att::Unit u{}; u.tmask = (rep && MK_ATT_VARIANT == 1) ? 0 : ~0; u.var = rep ? MK_ATT_VARIANT : 0; int head, qrow0;
        if (id < 128) { head = id >> 5; qrow0 = (id & 31) * 256; u.nt = MT / 64; u.key0 = 0; }
        else { head = id - 128; qrow0 = SEQ; u.nt = CTX / 64; u.key0 = SEQ; }
        u.Q = c.P() + (size_t)qrow0 * DIN + C_QC + head * 128; u.K = c.P() + C_KC + head * 128; u.V = c.P() + C_VC + head * 128;
        u.O = oc_ + (size_t)qrow0 * 2048 + head * 128; u.ldo = 2048; u.S = ocs_ + (size_t)qrow0 * 512 + head * 128;
        u.gsub = c.in[I_GSUB] + l * 128; u.lam = lam; u.osc = osc; u.shift = shC;
        if (__builtin_expect(shC != 0.f, 0)) { att::attn_body<4, 0, false, 1, true>(u, lds, tid_); att::attn_body<4, 4, false, 2, true>(u, lds, tid_); }
        else { att::attn_body<4, 0, false, 1, false>(u, lds, tid_); att::attn_body<4, 4, false, 2, false>(u, lds, tid_); }
    }
    for (;;) {
        const int id = q_pop(qctr + 64, lds, tid_);
        if (id >= 256 + (last ? 0 : 12)) break;
        att::Unit u{}; u.tmask = (rep && MK_ATT_VARIANT == 1) ? 0 : ~0; u.var = rep ? MK_ATT_VARIANT : 0;
        if (id < 256) { const int head = id >> 5, qb = id & 31;
            u.Q = c.P() + (size_t)(qb * 256) * DIN + C_QA + head * 128; u.K = c.P() + C_KA + (head >> 2) * 128; u.V = c.P() + C_VA + (head >> 2) * 128;
            u.nt = MT / 64; u.key0 = 0; u.O = oa_ + (size_t)(qb * 256) * 2048 + head * 128; u.ldo = 2048; }
        else if (id < 264) { const int head = id - 256;
            u.Q = c.P() + (size_t)SEQ * DIN + C_QA + head * 128; u.K = c.P() + C_KA + (head >> 2) * 128; u.V = c.P() + C_VA + (head >> 2) * 128;
            u.nt = CTX / 64; u.key0 = SEQ; u.O = oa_ + (size_t)SEQ * 2048 + head * 128; u.ldo = 2048; }
        else { const int head = id - 264;
            u.Q = c.P() + (size_t)SEQ * DIN + C_QB + head * 128; u.K = c.P() + C_KB + head * 128; u.V = c.P() + C_VB + head * 128;
            u.nt = CTX / 64; u.key0 = SEQ; u.O = ob_ + (size_t)SEQ * 2048 + head * 128; u.ldo = 2048; }
        u.shift = id < 264 ? shA : shB;
        if (__builtin_expect(u.shift != 0.f, 0)) att::attn_body<8, 0, false, 0, true>(u, lds, tid_); else att::attn_body<8, 0, false, 0, false>(u, lds, tid_);
    }
    for (;;) {
        const int id = q_pop(qctr + 128, lds, tid_);
        if (id >= 128) break;
        const int head = id >> 5, qb = id & 31, r0 = qb * 4;
        float* bt = (float*)(lds + att::OFF_BIAS);
        for (int i = tid_; i < 2 * att::BIAS_PAD + 480; i += 512) { const int k = i - att::BIAS_PAD; bt[i] = (k >= 0 && k < att::BIAS_N) ? c.in[I_RPB][((size_t)l * 4 + head) * att::BIAS_N + k] * 1.4426950408889634f : 0.f; }
        __syncthreads();
        att::Unit u{}; u.tmask = (rep && MK_ATT_VARIANT == 1) ? 0 : ~0; u.var = rep ? MK_ATT_VARIANT : 0;
        u.Q = c.P() + (size_t)(qb * 256) * DIN + C_QB + head * 128; u.K = c.P() + C_KB + head * 128; u.V = c.P() + C_VB + head * 128;
        u.nt = 16; u.r0 = r0; u.rsA = min(max(r0 - 4, 0), 116);
        u.O = ob_ + (size_t)(qb * 256) * 2048 + head * 128; u.ldo = 2048; u.shift = shB;
        att::attn_body<8, 0, true, 0, true>(u, lds, tid_);
    }
    if (!rep && l + 1 < DEPTH && CONV_NATT > 0) {
        for (;;) {
            const int ch = q_pop(qctr + 192, lds, tid_);
            if (ch >= CONV_NATT / CONV_CHUNK) break;
            __syncthreads();
            conv_run(c, lds, tid_of(wid_k), ch * CONV_CHUNK, ch * CONV_CHUNK + CONV_CHUNK, 1, 1, l + 1);
        }
    }
}

constexpr int PH_PER_LAYER = 10, PH_FINAL = 1 + DEPTH * PH_PER_LAYER, N_PHASES = PH_FINAL + 1;

__global__ void __launch_bounds__(512, 2) fwd(Args a) {
    extern __shared__ __attribute__((aligned(16))) unsigned char lds_raw[];
    char* lds = (char*)lds_raw;
    volatile LAS unsigned* xbw = (volatile LAS unsigned*)(LAS unsigned char*)(lds_raw) + (LDS_BYTES - 16) / 4;
    const int wid_k = __builtin_amdgcn_readfirstlane(threadIdx.x >> 6);
    if (tid_of(wid_k) == 0) { xbw[0] = 0u; xbw[1] = 0u; xbw[2] = 0u; xbw[3] = 0u; }
    __syncthreads();
    const int lo = a.ph_lo, hi = a.ph_hi;
    if (hi - lo > 1) { Ctx c = make_ctx(); (void)xcd_barrier_post((unsigned*)(c.ws + WS_CTL), xbw, tid_of(wid_k)); }
#define IN(k) (lo <= (k) && (k) < hi)
#define SEAM(k) do { if (IN((k) + 1)) { Ctx cb_ = make_ctx(); XcdBarrier b2_; b2_.bar = (unsigned*)(cb_.ws + WS_CTL); b2_.x = xb_xcc_id(); b2_.st = xbw; xcd_barrier(b2_, tid_of(wid_k)); if (MK_PROBE == 10) xcd_barrier(b2_, tid_of(wid_k)); } } while (0)

    if (IN(0)) { phase_prologue(wid_k, lds); if (MK_PROBE == 1) { __syncthreads(); phase_prologue(wid_k, lds); } SEAM(0); }
    for (int l = 0; l < DEPTH; ++l) {
        const int pb = 1 + l * PH_PER_LAYER; const bool lastl = (l == DEPTH - 1);
#define FRESH() Ctx c = make_ctx(); int tid_ = tid_of(wid_k); PG8_LAS unsigned char* ldsL = (PG8_LAS unsigned char*)lds_raw; (void)tid_; (void)ldsL; \
        const bf16_t* wl = c.wt() + (size_t)l * LAYER_ELEMS; const float* modx = c.mod() + ((size_t)l * 2 + 0) * NMOD; const float* modc = c.mod() + ((size_t)l * 2 + 1) * NMOD; (void)wl; (void)modx; (void)modc;
        if (IN(pb + 0)) { phase_norm(wid_k, l, 0); if (MK_PROBE == 4) phase_norm(wid_k, l, 0); SEAM(pb + 0); }
#define FASTG(Aptr, Bptr, MM, NN, KK, EPI) do { pg8::Gemm g_{Aptr, Bptr, MM, NN, KK}; pg8::StaticOrder S_; S_.init(MM, NN, (int)gridDim.x, (int)blockIdx.x); pg8::gemm_phase(ldsL, g_, S_, EPI, tid_); } while (0)
#if MK_FAST_GEMM
        if (IN(pb + 1)) { FRESH(); pg8::EpiWin e{c.P(), c.in[I_GQA] + l * 128, c.in[I_GKA] + l * 128, c.in[I_GQB] + l * 128, c.in[I_GKB] + l * 128, c.in[I_GQC] + l * 64, c.in[I_GKC] + l * 64, (LAS float*)(ldsL + pg8::STAGE_BYTES)};
#if MK_GATE_FP8
            {
                pg8::Gemm gq_{c.u(), wl + O_WIN, MT, C_G, DM}; pg8::StaticOrder Sq_; Sq_.init(MT, C_G, (int)gridDim.x, (int)blockIdx.x); pg8::gemm_phase(ldsL, gq_, Sq_, e, tid_);
                pg8::EpiGate eg{c.P()};
                pg8::Gemm gg_{(const bf16_t*)(c.ws + WS_U8), (const bf16_t*)(c.ws + WS_WG8 + (size_t)l * NGATE * DM), MT, NGATE, DM / 2};
                pg8::GateOrder Sg_; Sg_.init((int)blockIdx.x, (int)gridDim.x); pg8::gemm_phase<pg8::EpiGate, pg8::GateOrder, true>(ldsL, gg_, Sg_, eg, tid_);
            }
#else
            FASTG(c.u(), wl + O_WIN, MT, DIN, DM, e);
#endif
            if (IN(pb + 3)) SEAM(pb + 2); }
#else
        if (IN(pb + 1)) { FRESH(); SEpiWin e{c.R(), c.P()}; simple_gemm(wid_k, c.u(), wl + O_WIN, MT, DIN, DM, e); SEAM(pb + 1); }
#endif
#if !MK_FAST_GEMM
        if (IN(pb + 2)) { phase_qknorm(wid_k, l); SEAM(pb + 2); }
#endif
        if (IN(pb + 3)) { phase_attn(wid_k, l, lds, 0); if (MK_PROBE == 2) { __syncthreads(); phase_attn(wid_k, l, lds, 1); } SEAM(pb + 3); }
        if (IN(pb + 4)) {
            for (int rp_ = 0; rp_ < (MK_PROBE == 7 ? 2 : 1); ++rp_) { FRESH(); pg8::EpiBrChain e{c.mb(), c.P()};
                pg8::StaticOrder S_; S_.init(SEQ, DM, (int)gridDim.x, (int)blockIdx.x); pg8::Unit u_;
                for (int ui_ = 0; S_.next(ui_, u_); ++ui_) {
                    pg8::OneUnit O_{u_}; f32x4 acc_[2][2][4][2];
                    { pg8::Gemm g_{c.oa(), wl + O_BRA, SEQ, DM, 1024, DM, DM}; pg8::gemm_phase_core<pg8::EpiBrChain, pg8::OneUnit, false, true>(ldsL, g_, O_, e, tid_, acc_); }
                    e.scale<0>(acc_, u_, tid_);
                    { pg8::Gemm g_{c.ob(), wl + O_BRA + 1024, SEQ, DM, 512, DM, DM}; pg8::gemm_phase_core<pg8::EpiBrChain, pg8::OneUnit, true, true>(ldsL, g_, O_, e, tid_, acc_); }
                    e.scale<1>(acc_, u_, tid_);
                    { pg8::Gemm g_{c.oc(), wl + O_BRA + 1536, SEQ, DM, 512, DM, DM}; pg8::gemm_phase_core<pg8::EpiBrChain, pg8::OneUnit, true, false>(ldsL, g_, O_, e, tid_, acc_); }
                } }
            if (!lastl) { FRESH(); SEpiBr4 e{c.mb(), c.P()}; slab_gemm5<true>(wid_k, lds, c.oa(), DM, wl + O_BRA, DM, SEQ, CTX, DM, DM, e); }
            SEAM(pb + 4);
        }
#if MK_FAST_GEMM
        if (IN(pb + 5)) { FRESH(); pg8::EpiRes e{l == 0 ? c.in[I_X] : c.h(), modx + 2 * DM, modc + 2 * DM, c.h()}; FASTG(c.mb(), wl + O_WO, SEQ, DM, DM, e); if (MK_PROBE == 8) { pg8::EpiRes e2{c.mf(), modx + 2 * DM, modc + 2 * DM, c.mf()}; FASTG(c.mb(), wl + O_WO, SEQ, DM, DM, e2); }
            if (!lastl) { SEpiRes4 es{c.h(), modx + 2 * DM, modc + 2 * DM, l == 0 ? c.in[I_CTX] - (size_t)SEQ * DM : c.h()}; slab_gemm5<false>(wid_k, lds, c.mb(), DM, wl + O_WO, DM, SEQ, CTX, DM, DM, es); } SEAM(pb + 5); }
#else
        if (IN(pb + 5)) { FRESH(); SEpiRes e{c.h(), modx + 2 * DM, modc + 2 * DM, c.h()}; simple_gemm(wid_k, c.mb(), wl + O_WO, MT, DM, DM, e); SEAM(pb + 5); }
#endif
        if (IN(pb + 6)) { phase_norm(wid_k, l, 1); if (MK_PROBE == 4) phase_norm(wid_k, l, 1); SEAM(pb + 6); }
#if MK_FAST_GEMM
        if (IN(pb + 7)) { FRESH(); pg8::EpiUp e{c.act(), c.edge(), c.in[I_CONVW] + (size_t)l * 3 * DUP, c.in[I_CONVB] + (size_t)l * DUP}; FASTG(c.u(), wl + O_WUP, (lastl ? SEQ : MT), DUP, DM, e); if (MK_PROBE == 6) FASTG(c.u(), wl + O_WUP, (lastl ? SEQ : MT), DUP, DM, e);
            if (!lastl && MK_CONV_NUP > 0) {
                unsigned* fq_ = (unsigned*)(c.ws + WS_CTL + 16384) + l * 256 + 224;
                for (;;) { const int ch = q_pop(fq_, lds, tid_of(wid_k)); if (ch >= MK_CONV_NUP / CONV_CHUNK) break; __syncthreads();
                    conv_run(c, lds, tid_of(wid_k), CONV_NATT + ch * CONV_CHUNK, CONV_NATT + ch * CONV_CHUNK + CONV_CHUNK, 1, 1, l + 1); } }
            SEAM(pb + 7); }
#else
        if (IN(pb + 7)) { FRESH(); SEpiY e{c.Y()}; simple_gemm(wid_k, c.u(), wl + O_WUP, MT, DUP, DM, e); SEAM(pb + 7); }
#endif
#if MK_FAST_GEMM
        if (IN(pb + 8)) { phase_convfix(wid_k, l); if (MK_PROBE == 3) phase_convfix(wid_k, l); SEAM(pb + 8); }
#else
        if (IN(pb + 8)) { phase_conv(wid_k, l); SEAM(pb + 8); }
#endif
#if MK_FAST_GEMM
        if (IN(pb + 9)) { FRESH(); pg8::EpiRes e{c.h(), modx + 5 * DM, modc + 5 * DM, lastl ? c.out : c.h()}; FASTG(c.act(), wl + O_WDN, SEQ, DM, DFF, e); if (MK_PROBE == 9) { pg8::EpiRes e2{c.mf(), modx + 5 * DM, modc + 5 * DM, c.mf()}; FASTG(c.act(), wl + O_WDN, SEQ, DM, DFF, e2); }
            if (!lastl) { SEpiRes4 es{c.h(), modx + 5 * DM, modc + 5 * DM, c.h()}; slab_gemm5<false>(wid_k, lds, c.act(), DFF, wl + O_WDN, DFF, SEQ, CTX, DM, DFF, es); SEAM(pb + 9); } }
#else
        if (IN(pb + 9)) { FRESH(); SEpiRes e{c.h(), modx + 5 * DM, modc + 5 * DM, c.h()}; simple_gemm(wid_k, c.act(), wl + O_WDN, MT, DM, DFF, e); SEAM(pb + 9); }
#endif
#undef FASTG
#undef FRESH
    }
#if !MK_FAST_GEMM
    if (IN(PH_FINAL)) phase_copy_out(wid_k);
#endif
#undef IN
#undef SEAM
}

extern "C" void kernel_launch(void* const* d_in, const int* in_sizes, int n_in, void* d_out, int out_size, void* d_ws, size_t ws_size, hipStream_t stream) {
    static int grid = 0;
    if (grid == 0) {
        if (n_in != 29 || out_size != SEQ * DM || ws_size < WS_END) { fprintf(stderr, "kernel_launch: unexpected shapes: n_in %d out %d ws %zu (need %zu)\n", n_in, out_size, ws_size, (size_t)WS_END); grid = -1; return; }
        int dev = 0, cus = 0, per_cu = 0;
        if (hipGetDevice(&dev) != hipSuccess || hipDeviceGetAttribute(&cus, hipDeviceAttributeMultiprocessorCount, dev) != hipSuccess) { grid = -1; return; }
        if (hipFuncSetAttribute((const void*)fwd, hipFuncAttributeMaxDynamicSharedMemorySize, LDS_BYTES) != hipSuccess) { fprintf(stderr, "kernel_launch: hipFuncSetAttribute failed\n"); grid = -1; return; }
        if (hipOccupancyMaxActiveBlocksPerMultiprocessor(&per_cu, (const void*)fwd, 512, LDS_BYTES) != hipSuccess || per_cu < 1) fprintf(stderr, "kernel_launch: occupancy query reports %d\n", per_cu);
        (void)hipGetLastError();
        grid = cus;
    }
    if (grid < 0) return;
    (void)hipMemsetAsync((char*)d_ws + WS_CTL, 0, CTL_BYTES, stream);
    Args a{};
    for (int i = 0; i < 29; ++i) a.in[i] = (const float*)d_in[i];
    a.out = (float*)d_out; a.ws = (unsigned char*)d_ws;
#if MK_ONE_LAUNCH
    a.ph_lo = 0; a.ph_hi = N_PHASES;
    hipLaunchKernelGGL(fwd, dim3(grid), dim3(512), LDS_BYTES, stream, a);
#else
    for (int p = 0; p < N_PHASES; ++p) { a.ph_lo = p; a.ph_hi = p + 1; hipLaunchKernelGGL(fwd, dim3(grid), dim3(512), LDS_BYTES, stream, a); }
#endif
    const hipError_t le = hipPeekAtLastError();
    if (le != hipSuccess) fprintf(stderr, "kernel_launch: launch failed: %s\n", hipGetErrorName(le));
}
```

```cpp
#include <hip/hip_runtime.h>
#include <cstdio>
#include <cstdint>
#include <cstddef>

#define LAS __attribute__((address_space(3)))
typedef unsigned short bf16_t;
typedef short bf16x8 __attribute__((ext_vector_type(8)));
typedef short s16x4 __attribute__((ext_vector_type(4)));
typedef float f32x4 __attribute__((ext_vector_type(4)));
typedef float f32x16 __attribute__((ext_vector_type(16)));
typedef unsigned u32x4 __attribute__((ext_vector_type(4)));
typedef unsigned u32x2 __attribute__((ext_vector_type(2)));

#ifndef MK_FAST_GEMM
#define MK_FAST_GEMM 1
#endif
#ifndef MK_PROBE
#define MK_PROBE 0
#endif
#ifndef MK_ATT_VARIANT
#define MK_ATT_VARIANT 0
#endif
#ifndef MK_GATE_FP8
#define MK_GATE_FP8 1
#endif
#ifndef MK_ATT_1BAR
#define MK_ATT_1BAR 1
#endif
#ifndef MK_ONE_LAUNCH
#define MK_ONE_LAUNCH 1
#endif

constexpr int DM = 2048, SEQ = 8192, CTX = 256, MT = SEQ + CTX, DEPTH = 4;
constexpr int DIN = 10752, DFF = 5504, DUP = 2 * DFF, NMOD = 6 * DM;
constexpr int RW = 3328;
constexpr int C_QA = 0, C_KA = 1024, C_VA = 1280, C_QB = 1536, C_KB = 2048, C_VB = 2560, C_QC = 3072, C_KC = 3584, C_VC = 4096, C_G = 4608;
constexpr float EPS = 1e-6f;

constexpr size_t O_WIN = 0, O_BRA = O_WIN + (size_t)DIN * DM, O_BRB = O_BRA + (size_t)DM * 1024, O_BRC = O_BRB + (size_t)DM * 512,
                 O_WO = O_BRC + (size_t)DM * 512, O_WUP = O_WO + (size_t)DM * DM, O_WDN = O_WUP + (size_t)DUP * DM, LAYER_ELEMS = O_WDN + (size_t)DM * DFF;

constexpr size_t al256(size_t x) { return (x + 255) / 256 * 256; }
constexpr size_t WS_CTL = 0, CTL_BYTES = 65536;
constexpr size_t WS_MOD = WS_CTL + CTL_BYTES;
constexpr size_t WS_LAM = al256(WS_MOD + (size_t)DEPTH * 2 * NMOD * 4);
constexpr size_t WS_H = al256(WS_LAM + 256);
constexpr size_t WS_U = al256(WS_H + (size_t)MT * DM * 4);
constexpr size_t WS_WT = al256(WS_U + (size_t)MT * DM * 2);
constexpr size_t WS_P = al256(WS_WT + (size_t)DEPTH * LAYER_ELEMS * 2);
constexpr size_t WS_R = al256(WS_P + (size_t)MT * DIN * 2);
constexpr size_t WS_U8 = WS_R;
constexpr size_t WS_WG8 = al256(WS_U8 + (size_t)MT * DM);
constexpr int NGATE = 3 * DM;
static_assert(WS_WG8 + (size_t)DEPTH * NGATE * DM <= WS_R + (size_t)MT * RW * 4, "fp8 buffers fit the R region");
constexpr size_t WS_OA = al256(WS_R + (size_t)MT * RW * 4);
constexpr size_t WS_OB = al256(WS_OA + (size_t)MT * 1024 * 2);
constexpr size_t WS_OC = al256(WS_OB + (size_t)MT * 512 * 2);
constexpr size_t WS_OCS = al256(WS_OC + (size_t)MT * 512 * 2);
constexpr size_t WS_MF = al256(WS_OCS + (size_t)MT * 512 * 4);
constexpr size_t WS_MB = al256(WS_MF + (size_t)MT * DM * 4);
constexpr size_t WS_PEND = al256(WS_MB + (size_t)MT * DM * 2);
constexpr size_t WS_Y = WS_P;
static_assert(WS_Y + (size_t)MT * DUP * 4 <= WS_PEND, "Y alias");
constexpr int NBLK64 = MT / 64;
constexpr size_t WS_EDGE = WS_P;
constexpr size_t WS_ACT = WS_PEND;
constexpr size_t WS_END = al256(WS_ACT + (size_t)MT * DFF * 2);

constexpr int LDS_BYTES = 147456;

__device__ __forceinline__ unsigned cvt_pk_bf16(float lo, float hi) { unsigned r; asm volatile("s_nop 0\n\tv_cvt_pk_bf16_f32 %0, %1, %2" : "=v"(r) : "v"(lo), "v"(hi)); return r; }
__device__ __forceinline__ bf16_t f2bf(float x) { return (bf16_t)(cvt_pk_bf16(x, 0.f) & 0xffffu); }
__device__ __forceinline__ float sat8(float x) { return __builtin_amdgcn_fmed3f(x, -448.0f, 448.0f); }
__device__ __forceinline__ unsigned pk4_fp8(float a, float b, float c, float d) { unsigned w = __builtin_amdgcn_cvt_pk_fp8_f32(sat8(a), sat8(b), 0u, false); return __builtin_amdgcn_cvt_pk_fp8_f32(sat8(c), sat8(d), w, true); }
__device__ __forceinline__ float bf2f(bf16_t b) { return __uint_as_float(((unsigned)b) << 16); }
template <int O> __device__ __forceinline__ float swz_xor(float v) { return __int_as_float(__builtin_amdgcn_ds_swizzle(__float_as_int(v), (O << 10) | 0x1f)); }
__device__ __forceinline__ float half_sum(float v) { v += swz_xor<16>(v); v += swz_xor<8>(v); v += swz_xor<4>(v); v += swz_xor<2>(v); v += swz_xor<1>(v); return v; }
__device__ __forceinline__ float wave_sum(float v) {
    v = half_sum(v);
    auto rr = __builtin_amdgcn_permlane32_swap(__float_as_uint(v), __float_as_uint(v), false, false);
    return __uint_as_float(rr[0]) + __uint_as_float(rr[1]);
}
__device__ __forceinline__ float wave_max(float v) {
    v = fmaxf(v, swz_xor<16>(v)); v = fmaxf(v, swz_xor<8>(v)); v = fmaxf(v, swz_xor<4>(v)); v = fmaxf(v, swz_xor<2>(v)); v = fmaxf(v, swz_xor<1>(v));
    auto rr = __builtin_amdgcn_permlane32_swap(__float_as_uint(v), __float_as_uint(v), false, false);
    return fmaxf(__uint_as_float(rr[0]), __uint_as_float(rr[1]));
}
__device__ __forceinline__ float vmax_abs(const float* v, int n, int lane) {
    float m = 0.f; for (int i = lane; i < n; i += 64) m = fmaxf(m, fabsf(v[i]));
    return __uint_as_float(__builtin_amdgcn_readfirstlane(__float_as_uint(wave_max(m))));
}
__device__ __forceinline__ float siluf(float x) { return x * __builtin_amdgcn_rcpf(1.0f + __builtin_amdgcn_exp2f(x * -1.4426950408889634f)); }
__device__ __forceinline__ float sigmoidf(float x) { return __builtin_amdgcn_rcpf(1.0f + __builtin_amdgcn_exp2f(x * -1.4426950408889634f)); }

__device__ __forceinline__ int tid_of(int wid_k) { int z; asm volatile("s_mov_b32 %0, 0" : "=s"(z)); return wid_k * 64 + (int)__builtin_amdgcn_mbcnt_hi(~0u, __builtin_amdgcn_mbcnt_lo(~0u, (unsigned)z)); }

#define XB_TMO      128
#define XB_XCNT(j)  (256  + 64 * (j))
#define XB_XSUB(j)  (1280 + 64 * (j))
#define XB_XGEN(j)  (2304 + 64 * (j))
#define XB_TOP      3328
#define XB_TOPGEN   3392
#define XCD_BAR_WORDS 3456
#define XB_SPIN_CAP (1u << 18)
__device__ __forceinline__ unsigned xb_ld(unsigned* p)              { return __hip_atomic_load(p, __ATOMIC_RELAXED, __HIP_MEMORY_SCOPE_AGENT); }
__device__ __forceinline__ unsigned xb_add(unsigned* p, unsigned v) { return __hip_atomic_fetch_add(p, v, __ATOMIC_RELAXED, __HIP_MEMORY_SCOPE_AGENT); }
__device__ __forceinline__ unsigned xb_xcc_id() { return (unsigned)__builtin_amdgcn_s_getreg((3 << 11) | 20) & 0xFu; }
#define XB_SPIN(cond, bar) do { unsigned _sp = 0; while (cond) { __builtin_amdgcn_s_sleep(1); \
    if ((++_sp & 255u) == 0u) { if (xb_ld(&(bar)[XB_TMO])) break; if (_sp > XB_SPIN_CAP) { atomicAdd(&(bar)[XB_TMO], 1u); break; } } } } while (0)
struct XcdBarrier { unsigned* bar; unsigned x; volatile LAS unsigned* st; };
__device__ __forceinline__ XcdBarrier xcd_barrier_post(unsigned* bar, volatile LAS unsigned* st, int tid) {
    XcdBarrier b; b.bar = bar; b.x = xb_xcc_id(); b.st = st;
    if (tid == 0) (void)xb_add(&bar[XB_XCNT(b.x)], 1u);
    return b;
}
__device__ __forceinline__ void xcd_barrier_complete(unsigned* bar, unsigned x, unsigned& nloc, unsigned& nx) {
    const unsigned G = gridDim.x * gridDim.y * gridDim.z;
    unsigned sum, cnt, mine, sp = 0u;
    for (;;) {
        sum = 0u; cnt = 0u; mine = 0u;
#pragma unroll
        for (unsigned j = 0; j < 16; ++j) { const unsigned c = xb_ld(&bar[XB_XCNT(j)]); sum += c; cnt += (c > 0u) ? 1u : 0u; }
        mine = xb_ld(&bar[XB_XCNT(x)]);
        if (sum == G) break;
        __builtin_amdgcn_s_sleep(1);
        if ((++sp & 255u) == 0u) { if (xb_ld(&bar[XB_TMO])) break; if (sp > XB_SPIN_CAP) { atomicAdd(&bar[XB_TMO], 1u); break; } }
    }
    nloc = mine > 0u ? mine : 1u; nx = cnt > 0u ? cnt : 1u;
}
__device__ __forceinline__ void xcd_barrier(const XcdBarrier& b, int tid) {
    asm volatile("s_waitcnt vmcnt(0)" ::: "memory");
    __syncthreads();
    if (tid == 0) {
        unsigned* bar = b.bar;
        __builtin_amdgcn_s_waitcnt(0);
        unsigned nloc = b.st[0], nx = b.st[1];
        if (nloc == 0u) { xcd_barrier_complete(bar, b.x, nloc, nx); b.st[0] = nloc; b.st[1] = nx; }
        const unsigned old = xb_add(&bar[XB_XSUB(b.x)], 1u);
        const unsigned gen = old / nloc;
        if (old + 1u == (gen + 1u) * nloc) {
            __builtin_amdgcn_fence(__ATOMIC_RELEASE, "agent");
            asm volatile("s_waitcnt vmcnt(0)" ::: "memory");
            const unsigned og = xb_add(&bar[XB_TOP], 1u);
            const unsigned tg = og / nx;
            if (og + 1u == (tg + 1u) * nx) xb_add(&bar[XB_TOPGEN], 1u);
            else XB_SPIN(xb_ld(&bar[XB_TOPGEN]) == tg, bar);
            __builtin_amdgcn_fence(__ATOMIC_ACQUIRE, "agent");
            xb_add(&bar[XB_XGEN(b.x)], 1u);
            asm volatile("s_waitcnt vmcnt(0)" ::: "memory");
        } else {
            XB_SPIN(xb_ld(&bar[XB_XGEN(b.x)]) == gen, bar);
            __builtin_amdgcn_fence(__ATOMIC_ACQUIRE, "agent");
            asm volatile("s_waitcnt vmcnt(0)" ::: "memory");
        }
    }
    __syncthreads();
}

template <class T> __device__ __forceinline__ T* launder_uniform(T* p) {
    const unsigned long long v = (unsigned long long)p; unsigned lo = (unsigned)v, hi = (unsigned)(v >> 32);
    asm volatile("" : "+v"(lo), "+v"(hi));
    lo = __builtin_amdgcn_readfirstlane(lo); hi = __builtin_amdgcn_readfirstlane(hi);
    return (T*)(((unsigned long long)hi << 32) | lo);
}
struct Args { const float* in[29]; float* out; unsigned char* ws; int ph_lo, ph_hi; };
enum { I_X = 0, I_C, I_CTX, I_CCTX, I_WMOD, I_BMOD, I_GN1, I_WIN, I_GQA, I_GKA, I_GQB, I_GKB, I_RPB, I_GQC, I_GKC, I_LQ1, I_LK1, I_LQ2, I_LK2, I_GSUB,
       I_WBRA, I_WBRB, I_WBRC, I_WO, I_GN2, I_WUP, I_CONVW, I_CONVB, I_WDN };
struct Ctx {
    const float* const* in; float* out; unsigned char* ws;
    __device__ __forceinline__ float* mod() const { return (float*)(ws + WS_MOD); }
    __device__ __forceinline__ float* lam() const { return (float*)(ws + WS_LAM); }
    __device__ __forceinline__ float* h() const { return (float*)(ws + WS_H); }
    __device__ __forceinline__ bf16_t* u() const { return (bf16_t*)(ws + WS_U); }
    __device__ __forceinline__ bf16_t* wt() const { return (bf16_t*)(ws + WS_WT); }
    __device__ __forceinline__ bf16_t* P() const { return (bf16_t*)(ws + WS_P); }
    __device__ __forceinline__ float* R() const { return (float*)(ws + WS_R); }
    __device__ __forceinline__ bf16_t* oa() const { return (bf16_t*)(ws + WS_OA); }
    __device__ __forceinline__ bf16_t* ob() const { return (bf16_t*)(ws + WS_OA) + 1024; }
    __device__ __forceinline__ bf16_t* oc() const { return (bf16_t*)(ws + WS_OA) + 1536; }
    __device__ __forceinline__ float* ocs() const { return (float*)(ws + WS_OCS); }
    __device__ __forceinline__ float* mf() const { return (float*)(ws + WS_MF); }
    __device__ __forceinline__ bf16_t* mb() const { return (bf16_t*)(ws + WS_MB); }
    __device__ __forceinline__ float* Y() const { return (float*)(ws + WS_Y); }
    __device__ __forceinline__ float* edge() const { return (float*)(ws + WS_EDGE); }
    __device__ __forceinline__ bf16_t* act() const { return (bf16_t*)(ws + WS_ACT); }
};
__device__ __forceinline__ unsigned long long kernarg_u64(int off) {
    unsigned long long v; auto kp = __builtin_amdgcn_kernarg_segment_ptr();
    asm volatile("s_load_dwordx2 %0, %1, %2\n\ts_waitcnt lgkmcnt(0)" : "=s"(v) : "s"(kp), "i"(off));
    return v;
}
__device__ __forceinline__ Ctx make_ctx() {
    Ctx c; c.in = (const float* const*)__builtin_amdgcn_kernarg_segment_ptr();
    c.out = (float*)kernarg_u64(29 * 8); c.ws = (unsigned char*)kernarg_u64(30 * 8);
    return c;
}
#define PHASE_ENTER(cin) Ctx c = make_ctx(); int tid_ = tid_of(wid_k);

__device__ __forceinline__ int win_src_col(int j) {
    if (j < C_VA) { const int s = j & 127, hb = j - s, grp = s >> 6, sp = s & 63, i = sp >> 3, jj = sp & 7; return hb + 64 * grp + (jj < 4 ? 4 * i + jj : 32 + 4 * i + (jj - 4)); }
    if (j >= C_QC && j < C_VC) { const int s = j & 63, hb = j - s, grp = s >> 5, sp = s & 31, i = sp >> 3, jj = sp & 7; return hb + 32 * grp + (jj < 4 ? 4 * i + jj : 16 + 4 * i + (jj - 4)); }
    return j;
}
__device__ __forceinline__ int wup_src_col(int j) { const int pn = j >> 8, bj = (j >> 7) & 1, s = j & 127; return bj * DFF + 128 * pn + s; }

constexpr int T_WIN = (DIN / 256) * (DM / 64), T_BRA = (DM / 256) * (1024 / 64), T_BRB = (DM / 256) * (512 / 64), T_WO = (DM / 256) * (DM / 64), T_WUP = (DUP / 256) * (DM / 64), T_WDN = (DM / 256) * (DFF / 64);
constexpr int T_LAYER = T_WIN + T_BRA + 2 * T_BRB + T_WO + T_WUP + T_WDN;
#ifndef MK_CONV_NDEF
#define MK_CONV_NDEF 3848
#endif
#ifndef MK_CONV_NUP
#define MK_CONV_NUP 1536
#endif
constexpr int CONV_NDEF = MK_CONV_NDEF, CONV_CHUNK = 8, CONV_NP = T_LAYER + (DEPTH - 1) * (T_LAYER - CONV_NDEF), CONV_NATT = CONV_NDEF - MK_CONV_NUP;
static_assert(MK_CONV_NUP >= 0 && MK_CONV_NUP <= MK_CONV_NDEF && MK_CONV_NUP % 8 == 0, "w_up share of the deferred tiles");
static_assert(CONV_NDEF >= 0 && CONV_NDEF < T_LAYER && CONV_NDEF % CONV_CHUNK == 0, "deferred tile count");
__device__ __forceinline__ void conv_run(const Ctx& c, char* lds, int tid, int p0, int pend, int pstep, int mode, int L) {
        asm volatile("" : "+v"(tid));
        float* tile = (float*)lds;
        struct WD { const float* src; bf16_t* dst; int K, N, kind, ldd, l, j0, k0; };
#define WDEC(t_, d_) do { const int l_ = (t_) / T_LAYER; int r_ = (t_) % T_LAYER; bf16_t* wl_ = c.wt() + (size_t)l_ * LAYER_ELEMS; d_.l = l_; d_.kind = 0; d_.ldd = 0; \
            if (r_ < T_WIN) { d_.src = c.in[I_WIN] + (size_t)l_ * DM * DIN; d_.dst = wl_ + O_WIN; d_.K = DM; d_.N = DIN; d_.kind = 1; } \
            else if ((r_ -= T_WIN) < T_BRA) { d_.src = c.in[I_WBRA] + (size_t)l_ * 1024 * DM; d_.dst = wl_ + O_BRA; d_.K = 1024; d_.N = DM; d_.ldd = DM; }             \
            else if ((r_ -= T_BRA) < T_BRB) { d_.src = c.in[I_WBRB] + (size_t)l_ * 512 * DM; d_.dst = wl_ + O_BRA + 1024; d_.K = 512; d_.N = DM; d_.ldd = DM; }      \
            else if ((r_ -= T_BRB) < T_BRB) { d_.src = c.in[I_WBRC] + (size_t)l_ * 512 * DM; d_.dst = wl_ + O_BRA + 1536; d_.K = 512; d_.N = DM; d_.ldd = DM; }      \
            else if ((r_ -= T_BRB) < T_WO) { d_.src = c.in[I_WO] + (size_t)l_ * DM * DM; d_.dst = wl_ + O_WO; d_.K = DM; d_.N = DM; } \
            else if ((r_ -= T_WO) < T_WUP) { d_.src = c.in[I_WUP] + (size_t)l_ * DM * DUP; d_.dst = wl_ + O_WUP; d_.K = DM; d_.N = DUP; d_.kind = 2; } \
            else { r_ -= T_WUP; d_.src = c.in[I_WDN] + (size_t)l_ * DFF * DM; d_.dst = wl_ + O_WDN; d_.K = DFF; d_.N = DM; } \
            const int nkt_ = d_.K / 64; d_.j0 = (r_ / nkt_) * 256; d_.k0 = (r_ % nkt_) * 64; } while (0)
#define WLOAD(d_) do { _Pragma("unroll") for (int s = 0; s < 4; ++s) { const int j = d_.j0 + 64 * s + j4; const int sc = d_.kind == 1 ? win_src_col(j) : (d_.kind == 2 ? wup_src_col(j) : j); \
            _Pragma("unroll") for (int i = 0; i < 2; ++i) v[s][i] = *(const f32x4*)(d_.src + (size_t)(d_.k0 + (tid >> 4) + 32 * i) * d_.N + sc); } } while (0)
        const int j4 = (tid & 15) * 4; f32x4 v[4][2];
#define TMAP(p_) (mode ? L * T_LAYER + (p_) : ((p_) < T_LAYER ? (p_) : (1 + ((p_) - T_LAYER) / (T_LAYER - CONV_NDEF)) * T_LAYER + CONV_NDEF + ((p_) - T_LAYER) % (T_LAYER - CONV_NDEF)))
        WD cur, nxt; int p = p0;
        if (p < pend) { const int t = TMAP(p); WDEC(t, cur); WLOAD(cur); }
        for (; p < pend; p += pstep) {
#pragma unroll
            for (int s = 0; s < 4; ++s)
#pragma unroll
                for (int i = 0; i < 2; ++i) { float* tp = tile + s * (64 * 65) + ((tid >> 4) + 32 * i) * 65 + j4; tp[0] = v[s][i][0]; tp[1] = v[s][i][1]; tp[2] = v[s][i][2]; tp[3] = v[s][i][3]; }
            __syncthreads();
            nxt = cur;
            if (p + pstep < pend) { const int t = TMAP(p + pstep); WDEC(t, nxt); WLOAD(nxt); }
            {
                const int jj = tid >> 3, kk = (tid & 7) * 8;
#pragma unroll
                for (int s = 0; s < 4; ++s) { const float* ts = tile + s * (64 * 65);
                    if (MK_GATE_FP8 && MK_FAST_GEMM && cur.kind == 1 && cur.j0 + 64 * s >= C_G) {
                        u32x2 w8;
                        w8.x = pk4_fp8(ts[(kk + 0) * 65 + jj] * 32.f, ts[(kk + 1) * 65 + jj] * 32.f, ts[(kk + 2) * 65 + jj] * 32.f, ts[(kk + 3) * 65 + jj] * 32.f);
                        w8.y = pk4_fp8(ts[(kk + 4) * 65 + jj] * 32.f, ts[(kk + 5) * 65 + jj] * 32.f, ts[(kk + 6) * 65 + jj] * 32.f, ts[(kk + 7) * 65 + jj] * 32.f);
                        *(u32x2*)(c.ws + WS_WG8 + ((size_t)cur.l * NGATE + (cur.j0 + 64 * s + jj - C_G)) * DM + cur.k0 + kk) = w8;
                        continue; }
                    u32x4 w;
                    w.x = cvt_pk_bf16(ts[(kk + 0) * 65 + jj], ts[(kk + 1) * 65 + jj]); w.y = cvt_pk_bf16(ts[(kk + 2) * 65 + jj], ts[(kk + 3) * 65 + jj]);
                    w.z = cvt_pk_bf16(ts[(kk + 4) * 65 + jj], ts[(kk + 5) * 65 + jj]); w.w = cvt_pk_bf16(ts[(kk + 6) * 65 + jj], ts[(kk + 7) * 65 + jj]);
                    *(u32x4*)(cur.dst + (size_t)(cur.j0 + 64 * s + jj) * (cur.ldd ? cur.ldd : cur.K) + cur.k0 + kk) = w; }
            }
            __syncthreads();
            cur = nxt;
        }
#undef WDEC
#undef WLOAD
#undef TMAP
}

__device__ __forceinline__ void phase_prologue(int wid_k, char* lds) {
    PHASE_ENTER(cin)
    const int tid = tid_, lane = tid & 63, wid = tid >> 6, G = gridDim.x, b = blockIdx.x;
    if (!MK_FAST_GEMM) {
        const f32x4* x4 = (const f32x4*)c.in[I_X]; const f32x4* c4 = (const f32x4*)c.in[I_CTX]; f32x4* h4 = (f32x4*)c.h();
        const size_t nx = (size_t)SEQ * DM / 4, nc = (size_t)CTX * DM / 4;
        for (size_t i = (size_t)b * 512 + tid; i < nx + nc; i += (size_t)G * 512) h4[i] = i < nx ? x4[i] : c4[i - nx];
    }
    if (b == 0 && wid < DEPTH) {
        const int l = wid;
        const float p1 = wave_sum(c.in[I_LQ1][l * 64 + lane] * c.in[I_LK1][l * 64 + lane]);
        const float p2 = wave_sum(c.in[I_LQ2][l * 64 + lane] * c.in[I_LK2][l * 64 + lane]);
        if (lane == 0) c.lam()[l] = expf(p1) - expf(p2) + (0.8f - 0.6f * expf(-0.3f * (float)l));
    }
    {
        float* sc0 = (float*)lds; float* sc1 = sc0 + DM; float* part = sc1 + DM;
        for (int k = tid; k < DM; k += 512) { sc0[k] = siluf(c.in[I_C][k]); sc1[k] = siluf(c.in[I_CCTX][k]); }
        __syncthreads();
        for (int blk = b; blk < DEPTH * NMOD / 64; blk += G) {
            const int l = blk / (NMOD / 64), j = (blk % (NMOD / 64)) * 64 + lane;
            const float* w = c.in[I_WMOD] + (size_t)l * DM * NMOD + j;
            float a0 = 0.f, a1 = 0.f;
            const int kb = wid * 256;
#pragma unroll 32
            for (int k = 0; k < 256; ++k) { const float wv = w[(size_t)(kb + k) * NMOD]; a0 += sc0[kb + k] * wv; a1 += sc1[kb + k] * wv; }
            part[(wid * 64 + lane) * 2 + 0] = a0; part[(wid * 64 + lane) * 2 + 1] = a1;
            __syncthreads();
            if (wid < 2) {
                float s = c.in[I_BMOD][l * NMOD + j];
#pragma unroll
                for (int w8 = 0; w8 < 8; ++w8) s += part[(w8 * 64 + lane) * 2 + wid];
                c.mod()[((size_t)l * 2 + wid) * NMOD + j] = s;
            }
            __syncthreads();
        }
    }
    conv_run(c, lds, tid, b, CONV_NP, G, 0, 0);
}

__device__ __forceinline__ void phase_norm(int wid_k, int l, int which) {
    PHASE_ENTER(cin)
    const int lane = tid_ & 63, wid = tid_ >> 6;
    const float* g = c.in[which ? I_GN2 : I_GN1] + l * DM;
#define NORM_ROWPTR(r_) ((MK_FAST_GEMM && l == 0 && which == 0) ? ((r_) < SEQ ? c.in[I_X] + (size_t)(r_) * DM : c.in[I_CTX] + (size_t)((r_) - SEQ) * DM) : c.h() + (size_t)(r_) * DM)
    const int row0 = blockIdx.x * 8 + wid, rstep = gridDim.x * 8;
    f32x4 v[8], vn[8];
    if (row0 < MT) { const float* hr = NORM_ROWPTR(row0);
#pragma unroll
        for (int i = 0; i < 8; ++i) v[i] = *(const f32x4*)(hr + i * 256 + lane * 4); }
    for (int row = row0; row < MT; row += rstep) {
        if (row + rstep < MT) { const float* hn = NORM_ROWPTR(row + rstep);
#pragma unroll
            for (int i = 0; i < 8; ++i) vn[i] = *(const f32x4*)(hn + i * 256 + lane * 4); }
        const float* md = c.mod() + ((size_t)l * 2 + (row >= SEQ ? 1 : 0)) * NMOD;
        const float* sh = md + (which ? 3 : 0) * DM; const float* sc = md + (which ? 4 : 1) * DM;
        float ss = 0.f;
#pragma unroll
        for (int i = 0; i < 8; ++i) ss += v[i][0] * v[i][0] + v[i][1] * v[i][1] + v[i][2] * v[i][2] + v[i][3] * v[i][3];
        ss = wave_sum(ss);
        const float rstd = __builtin_amdgcn_rsqf(ss * (1.0f / DM) + EPS);
#pragma unroll
        for (int i = 0; i < 8; ++i) {
            const int col = i * 256 + lane * 4;
            const f32x4 gg = *(const f32x4*)(g + col), s1 = *(const f32x4*)(sc + col), s0 = *(const f32x4*)(sh + col);
            f32x4 o;
#pragma unroll
            for (int e = 0; e < 4; ++e) o[e] = (v[i][e] * rstd * gg[e]) * (1.0f + s1[e]) + s0[e];
            u32x2 w; w.x = cvt_pk_bf16(o[0], o[1]); w.y = cvt_pk_bf16(o[2], o[3]);
            *(u32x2*)(c.u() + (size_t)row * DM + col) = w;
            if (MK_GATE_FP8 && MK_FAST_GEMM && which == 0) *(unsigned*)(c.ws + WS_U8 + (size_t)row * DM + col) = pk4_fp8(o[0], o[1], o[2], o[3]);
        }
#pragma unroll
        for (int i = 0; i < 8; ++i) v[i] = vn[i];
    }
#undef NORM_ROWPTR
}

__device__ __forceinline__ void rope_cs(float pos, int f, float inv_nf, float& cs, float& sn) {
    const float inv = __builtin_amdgcn_exp2f(-(float)f * inv_nf * 13.287712379549449f);
    const float ang = pos * inv;
    float rev = ang * 0.15915494309189535f; rev -= floorf(rev);
    cs = __builtin_amdgcn_cosf(rev); sn = __builtin_amdgcn_sinf(rev);
}
__device__ __forceinline__ void phase_qknorm(int wid_k, int l) {
    PHASE_ENTER(cin)
    const int lane = tid_ & 63, wid = tid_ >> 6;
    const int i = lane >> 2, j = lane & 3;
    const long nitems = (long)MT * 26;
    for (long it = (long)blockIdx.x * 8 + wid; it < nitems; it += (long)gridDim.x * 8) {
        const int row = (int)(it / 26), g = (int)(it % 26);
        const int rc = g * 128, pc = rc < 1280 ? rc : (rc < 2304 ? rc + 256 : rc + 768);
        const float* rp = c.R() + (size_t)row * RW + rc;
        const float x1 = rp[8 * i + j], x2 = rp[8 * i + 4 + j];
        float ss = x1 * x1 + x2 * x2;
        int type; const float* gv;
        if (g < 8) { type = 0; gv = c.in[I_GQA] + l * 128; } else if (g < 10) { type = 0; gv = c.in[I_GKA] + l * 128; }
        else if (g < 14) { type = 1; gv = c.in[I_GQB] + l * 128; } else if (g < 18) { type = 1; gv = c.in[I_GKB] + l * 128; }
        else if (g < 22) { type = 2; gv = c.in[I_GQC] + l * 64; } else { type = 2; gv = c.in[I_GKC] + l * 64; }
        ss = half_sum(ss);
        if (type != 2) { auto rr = __builtin_amdgcn_permlane32_swap(__float_as_uint(ss), __float_as_uint(ss), false, false); ss = __uint_as_float(rr[0]) + __uint_as_float(rr[1]); }
        const float rstd = 1.0f / sqrtf(ss * (type == 2 ? 1.0f / 64.0f : 1.0f / 128.0f) + EPS);
        float y1, y2;
        if (type == 1) { y1 = x1 * rstd * gv[8 * i + j]; y2 = x2 * rstd * gv[8 * i + 4 + j]; }
        else {
            int d1, d2, f; float inv_nf; int grp;
            if (type == 0) { grp = i >> 3; f = 4 * (i & 7) + j; d1 = 64 * grp + f; d2 = d1 + 32; inv_nf = 1.0f / 32.0f; }
            else { const int ip = i & 7; grp = ip >> 2; f = 4 * (ip & 3) + j; d1 = 32 * grp + f; d2 = d1 + 16; inv_nf = 1.0f / 16.0f; }
            y1 = x1 * rstd * gv[d1]; y2 = x2 * rstd * gv[d2];
            if (row < SEQ) {
                const float pos = (float)(grp ? (row & 63) : (row >> 6));
                float cs, sn; rope_cs(pos, f, inv_nf, cs, sn);
                const float o1 = y1 * cs - y2 * sn, o2 = y2 * cs + y1 * sn; y1 = o1; y2 = o2;
            }
        }
        const float qs = (g < 8 || (g >= 10 && g < 14)) ? 0.12751743f : ((g >= 18 && g < 22) ? 0.18033688f : 1.0f);
        bf16_t* pp = c.P() + (size_t)row * DIN + pc;
        pp[8 * i + j] = f2bf(y1 * qs); pp[8 * i + 4 + j] = f2bf(y2 * qs);
    }
}

__device__ __forceinline__ void phase_conv(int wid_k, int l) {
    PHASE_ENTER(cin)
    const float* cw = c.in[I_CONVW] + (size_t)l * 3 * DUP; const float* cb = c.in[I_CONVB] + (size_t)l * DUP;
    const long n = (long)MT * DFF;
    for (long idx = (long)blockIdx.x * 512 + tid_; idx < n; idx += (long)gridDim.x * 512) {
        const int row = (int)(idx / DFF), col = (int)(idx % DFF);
        const int ya = 256 * (col >> 7) + (col & 127), yg = ya + 128;
        const bool up = (row != 0 && row != SEQ), dn = (row != SEQ - 1 && row != MT - 1);
        const float* y = c.Y() + (size_t)row * DUP;
        float ha = cb[col] + cw[DUP + col] * y[ya], hg = cb[DFF + col] + cw[DUP + DFF + col] * y[yg];
        if (up) { ha += cw[col] * y[ya - DUP]; hg += cw[DFF + col] * y[yg - DUP]; }
        if (dn) { ha += cw[2 * DUP + col] * y[ya + DUP]; hg += cw[2 * DUP + DFF + col] * y[yg + DUP]; }
        c.act()[idx] = f2bf(siluf(hg) * ha);
    }
}


__device__ __forceinline__ void phase_convfix(int wid_k, int l) {
    PHASE_ENTER(cin)
    const float* cw = c.in[I_CONVW] + (size_t)l * 3 * DUP; const float* cb = c.in[I_CONVB] + (size_t)l * DUP; const float* E = c.edge();
    const int nrows = (l == DEPTH - 1 ? SEQ / 64 : NBLK64) * 2;
    const long n = (long)nrows * (DFF / 4);
    for (long idx = (long)blockIdx.x * 512 + tid_; idx < n; idx += (long)gridDim.x * 512) {
        const int br = (int)(idx / (DFF / 4)), ch = (int)(idx % (DFF / 4)) * 4, b = br >> 1, lastrow = br & 1, row = 64 * b + (lastrow ? 63 : 0);
        const int ya = 256 * (ch >> 7) + (ch & 127), yg = ya + 128;
        const float* eb = E + (size_t)b * 4 * DUP;
        f32x4 ua = {0.f, 0.f, 0.f, 0.f}, ug = ua, da = ua, dg = ua, ma, mg;
        if (!lastrow) {
            if (row != 0 && row != SEQ) { ua = *(const f32x4*)(eb - DUP + ya); ug = *(const f32x4*)(eb - DUP + yg); }
            ma = *(const f32x4*)(eb + ya); mg = *(const f32x4*)(eb + yg); da = *(const f32x4*)(eb + DUP + ya); dg = *(const f32x4*)(eb + DUP + yg);
        } else {
            ua = *(const f32x4*)(eb + 2 * DUP + ya); ug = *(const f32x4*)(eb + 2 * DUP + yg); ma = *(const f32x4*)(eb + 3 * DUP + ya); mg = *(const f32x4*)(eb + 3 * DUP + yg);
            if (row != SEQ - 1 && row != MT - 1) { da = *(const f32x4*)(eb + 4 * DUP + ya); dg = *(const f32x4*)(eb + 4 * DUP + yg); }
        }
        const f32x4 wa0 = *(const f32x4*)(cw + ch), wa1 = *(const f32x4*)(cw + DUP + ch), wa2 = *(const f32x4*)(cw + 2 * DUP + ch), ba = *(const f32x4*)(cb + ch);
        const f32x4 wg0 = *(const f32x4*)(cw + DFF + ch), wg1 = *(const f32x4*)(cw + DUP + DFF + ch), wg2 = *(const f32x4*)(cw + 2 * DUP + DFF + ch), bg = *(const f32x4*)(cb + DFF + ch);
        f32x4 o;
#pragma unroll
        for (int e = 0; e < 4; ++e) { const float ha = ba[e] + wa0[e] * ua[e] + wa1[e] * ma[e] + wa2[e] * da[e], hg = bg[e] + wg0[e] * ug[e] + wg1[e] * mg[e] + wg2[e] * dg[e]; o[e] = siluf(hg) * ha; }
        u32x2 w; w.x = cvt_pk_bf16(o[0], o[1]); w.y = cvt_pk_bf16(o[2], o[3]);
        *(u32x2*)(c.act() + (size_t)row * DFF + ch) = w;
    }
}

__device__ __forceinline__ void phase_copy_out(int wid_k) {
    PHASE_ENTER(cin)
    const f32x4* h4 = (const f32x4*)c.h(); f32x4* o4 = (f32x4*)c.out; const size_t n = (size_t)SEQ * DM / 4;
    for (size_t i = (size_t)blockIdx.x * 512 + tid_; i < n; i += (size_t)gridDim.x * 512) o4[i] = h4[i];
}

template <class Epi>
__device__ __forceinline__ void simple_gemm(int wid_k, const bf16_t* A, const bf16_t* Bt, int M, int N, int K, const Epi& epi) {
    int tid_ = tid_of(wid_k); A = launder_uniform(A); Bt = launder_uniform(Bt);
    const int lane = tid_ & 63, wid = tid_ >> 6, wm = wid >> 2, wn = wid & 3, fr = lane & 15, fq = lane >> 4;
    const int ntn = N / 128, ntiles = (M / 128) * ntn;
    for (int t = blockIdx.x; t < ntiles; t += gridDim.x) {
        const int tm = t / ntn, tn = t % ntn, row0 = tm * 128 + wm * 64, col0 = tn * 128 + wn * 32;
        f32x4 acc[4][2];
#pragma unroll
        for (int m = 0; m < 4; ++m)
#pragma unroll
            for (int n = 0; n < 2; ++n) acc[m][n] = (f32x4){0.f, 0.f, 0.f, 0.f};
        const bf16_t* ap = A + (size_t)(row0 + fr) * K + fq * 8; const bf16_t* bp = Bt + (size_t)(col0 + fr) * K + fq * 8;
        for (int k0 = 0; k0 < K; k0 += 32) {
            bf16x8 a[4], b[2];
#pragma unroll
            for (int m = 0; m < 4; ++m) a[m] = *(const bf16x8*)(ap + (size_t)m * 16 * K + k0);
#pragma unroll
            for (int n = 0; n < 2; ++n) b[n] = *(const bf16x8*)(bp + (size_t)n * 16 * K + k0);
#pragma unroll
            for (int m = 0; m < 4; ++m)
#pragma unroll
                for (int n = 0; n < 2; ++n) acc[m][n] = __builtin_amdgcn_mfma_f32_16x16x32_bf16(a[m], b[n], acc[m][n], 0, 0, 0);
        }
#pragma unroll
        for (int m = 0; m < 4; ++m)
#pragma unroll
            for (int n = 0; n < 2; ++n)
#pragma unroll
                for (int j = 0; j < 4; ++j) epi(row0 + m * 16 + fq * 4 + j, col0 + n * 16 + fr, acc[m][n][j]);
    }
}

template <class Epi>
__device__ __forceinline__ void slab_gemm(int wid_k, const bf16_t* A, int lda, const bf16_t* Bt, int ldb, int row_base, int M, int N, int K, const Epi& epi) {
    int tid_ = tid_of(wid_k); A = launder_uniform(A); Bt = launder_uniform(Bt);
    const int lane = tid_ & 63, wid = tid_ >> 6, fr = lane & 15, fq = lane >> 4;
    const int ntn = N / 16, ntiles = (M / 128) * ntn;
    for (int t = blockIdx.x; t < ntiles; t += gridDim.x) {
        const int tm = t / ntn, tn = t % ntn, row0 = row_base + tm * 128 + wid * 16, col0 = tn * 16;
        f32x4 acc0 = {0.f, 0.f, 0.f, 0.f}, acc1 = acc0;
        const bf16_t* ap = A + (size_t)(row0 + fr) * lda + fq * 8; const bf16_t* bp = Bt + (size_t)(col0 + fr) * ldb + fq * 8;
#pragma unroll 8
        for (int k0 = 0; k0 < K; k0 += 64) {
            const bf16x8 a0 = *(const bf16x8*)(ap + k0), b0 = *(const bf16x8*)(bp + k0), a1 = *(const bf16x8*)(ap + k0 + 32), b1 = *(const bf16x8*)(bp + k0 + 32);
            acc0 = __builtin_amdgcn_mfma_f32_16x16x32_bf16(a0, b0, acc0, 0, 0, 0);
            acc1 = __builtin_amdgcn_mfma_f32_16x16x32_bf16(a1, b1, acc1, 0, 0, 0);
        }
#pragma unroll
        for (int j = 0; j < 4; ++j) epi(row0 + fq * 4 + j, col0 + fr, acc0[j] + acc1[j]);
    }
}

template <class Epi4>
__device__ __forceinline__ void slab_gemm4(int wid_k, char* lds, const bf16_t* A, int lda, const bf16_t* Bt, int ldb, int row_base, int M, int N, int K, const Epi4& epi) {
    int tid_ = tid_of(wid_k); A = launder_uniform(A); Bt = launder_uniform(Bt);
    const int lane = tid_ & 63, wid = __builtin_amdgcn_readfirstlane(tid_ >> 6), r32 = lane & 31, hi = lane >> 5, ch = wid & 1, kq = wid >> 1, kl = K >> 2;
    float* part = (float*)lds;
    const int ntn = N / 64, ntiles = (M / 32) * ntn;
    typedef const __attribute__((address_space(1))) bf16x8 gfrag;
    for (int t = blockIdx.x; t < ntiles; t += gridDim.x) {
        const int tm = t / ntn, tn = t % ntn, row0 = row_base + tm * 32, col0 = tn * 64 + ch * 32;
        const bf16_t* ap = A + (size_t)(row0 + r32) * lda + kq * kl + hi * 8; const bf16_t* bp = Bt + (size_t)(col0 + r32) * ldb + kq * kl + hi * 8;
        f32x16 acc = {};
        bf16x8 fa0[8], fb0[8], fa1[8], fb1[8];
#define SLAB_LD(FA, FB, kb_) do { _Pragma("unroll") for (int i = 0; i < 8; ++i) { const int kk_ = (kb_) + 16 * i; if (kk_ < kl) { FA[i] = *(gfrag*)(ap + kk_); FB[i] = *(gfrag*)(bp + kk_); } else { FA[i] = (bf16x8){0, 0, 0, 0, 0, 0, 0, 0}; FB[i] = FA[i]; } } } while (0)
#define SLAB_MM(FA, FB) do { _Pragma("unroll") for (int i = 0; i < 8; ++i) acc = __builtin_amdgcn_mfma_f32_32x32x16_bf16(FA[i], FB[i], acc, 0, 0, 0); } while (0)
        SLAB_LD(fa0, fb0, 0);
        for (int k0 = 0; k0 < kl; k0 += 256) {
            if (k0 + 128 < kl) SLAB_LD(fa1, fb1, k0 + 128);
            SLAB_MM(fa0, fb0);
            if (k0 + 256 < kl) SLAB_LD(fa0, fb0, k0 + 256);
            if (k0 + 128 < kl) SLAB_MM(fa1, fb1);
        }
#undef SLAB_LD
#undef SLAB_MM
        float* pw = part + ((kq * 2 + ch) * 32) * 32 + r32;
#pragma unroll
        for (int i = 0; i < 16; ++i) pw[((i & 3) + 8 * (i >> 2) + 4 * hi) * 32] = acc[i];
        __syncthreads();
#pragma unroll
        for (int j = 0; j < 4; ++j) { const int o = (tid_ & 255) + 256 * j, c2 = tid_ >> 8, rr = o >> 5, cc = o & 31;
            const float* pp = part + (c2 * 32 + rr) * 32 + cc;
            epi(row_base + tm * 32 + rr, tn * 64 + c2 * 32 + cc, pp[0], pp[2 * 1024], pp[4 * 1024], pp[6 * 1024]); }
        __syncthreads();
    }
}
template <bool QUART, class Epi4>
__device__ __forceinline__ void slab_gemm5(int wid_k, char* lds, const bf16_t* A, int lda, const bf16_t* Bt, int ldb, int row_base, int M, int N, int K, const Epi4& epi) {
    int tid_ = tid_of(wid_k); A = launder_uniform(A); Bt = launder_uniform(Bt);
    const int lane = tid_ & 63, wid = __builtin_amdgcn_readfirstlane(tid_ >> 6), r32 = lane & 31, hi = lane >> 5, ch = wid & 1, kq = wid >> 1, kl = K >> 2, ns = K >> 7;
    constexpr int STG = 24576, NSTG = 5;
    float* part = (float*)lds;
    LAS unsigned char* ldsL = (LAS unsigned char*)(unsigned)(uintptr_t)lds;
    const int ntn = N / 64, ntiles = (M / 32) * ntn;
    for (int t = blockIdx.x; t < ntiles; t += gridDim.x) {
        const int tm = t / ntn, tn = t % ntn, row0 = row_base + tm * 32, col0 = tn * 64;
        const char* gsrc[3];
#pragma unroll
        for (int j = 0; j < 3; ++j) { const int J = 3 * wid + j, isA = J < 8, G = (isA ? J : J - 8) * 64 + lane, row = G >> 4, lc = (G & 15) ^ (row & 15);
            const bf16_t* rp = isA ? A + (size_t)(row0 + row) * lda : Bt + (size_t)(col0 + row) * ldb;
            gsrc[j] = (const char*)(rp + (QUART ? (lc >> 2) * kl + (lc & 3) * 8 : lc * 8)); }
        const size_t sstep = QUART ? 64 : 256;
#define S5_DMA(st_, si_) do { _Pragma("unroll") for (int j = 0; j < 3; ++j) \
            __builtin_amdgcn_global_load_lds((const unsigned*)(gsrc[j] + (size_t)(si_) * sstep), (LAS unsigned*)(ldsL + (st_) * STG + (3 * wid + j) * 1024), 16, 0, 0); } while (0)
        int aoff[2], boff[2];
#pragma unroll
        for (int m = 0; m < 2; ++m) { const int lc = QUART ? 4 * kq + 2 * m + hi : 2 * kq + 8 * m + hi;
            aoff[m] = r32 * 256 + ((lc ^ (r32 & 15)) << 4); boff[m] = 8192 + (ch * 32 + r32) * 256 + ((lc ^ (r32 & 15)) << 4); }
        f32x16 acc = {};
#pragma unroll
        for (int s = 0; s < NSTG - 1; ++s) if (s < ns) S5_DMA(s, s);
        int st = 0;
        for (int s = 0; s < ns; ++s) {
            const int rem = ns - 1 - s;
            if (rem >= 3) asm volatile("s_waitcnt vmcnt(9)" ::: "memory"); else if (rem == 2) asm volatile("s_waitcnt vmcnt(6)" ::: "memory");
            else if (rem == 1) asm volatile("s_waitcnt vmcnt(3)" ::: "memory"); else asm volatile("s_waitcnt vmcnt(0)" ::: "memory");
            __builtin_amdgcn_s_barrier(); asm volatile("" ::: "memory");
            if (s + NSTG - 1 < ns) { const int sn = st == 0 ? NSTG - 1 : st - 1; S5_DMA(sn, s + NSTG - 1); }
            const LAS unsigned char* sb = ldsL + st * STG;
            const bf16x8 a0 = *(const LAS bf16x8*)(sb + aoff[0]), b0 = *(const LAS bf16x8*)(sb + boff[0]), a1 = *(const LAS bf16x8*)(sb + aoff[1]), b1 = *(const LAS bf16x8*)(sb + boff[1]);
            acc = __builtin_amdgcn_mfma_f32_32x32x16_bf16(a0, b0, acc, 0, 0, 0);
            acc = __builtin_amdgcn_mfma_f32_32x32x16_bf16(a1, b1, acc, 0, 0, 0);
            st = st == NSTG - 1 ? 0 : st + 1;
        }
#undef S5_DMA
        asm volatile("s_waitcnt lgkmcnt(0)" ::: "memory"); __builtin_amdgcn_s_barrier(); asm volatile("" ::: "memory");
        float* pw = part + ((kq * 2 + ch) * 32) * 32 + r32;
#pragma unroll
        for (int i = 0; i < 16; ++i) pw[((i & 3) + 8 * (i >> 2) + 4 * hi) * 32] = acc[i];
        __syncthreads();
#pragma unroll
        for (int j = 0; j < 4; ++j) { const int o = (tid_ & 255) + 256 * j, c2 = tid_ >> 8, rr = o >> 5, cc = o & 31;
            const float* pp = part + (c2 * 32 + rr) * 32 + cc;
            epi(row_base + tm * 32 + rr, tn * 64 + c2 * 32 + cc, pp[0], pp[2 * 1024], pp[4 * 1024], pp[6 * 1024]); }
        __syncthreads();
    }
}
struct SEpiRes4 {
    float* h; const float* gx; const float* gc; const float* src;
    __device__ __forceinline__ void operator()(int row, int col, float p0, float p1, float p2, float p3) const { const size_t o = (size_t)row * DM + col; h[o] = src[o] + (row < SEQ ? gx[col] : gc[col]) * ((p0 + p1) + (p2 + p3)); }
};
struct SEpiBr4 {
    bf16_t* mb; const bf16_t* P;
    __device__ __forceinline__ void operator()(int row, int col, float p0, float p1, float p2, float p3) const { const bf16_t* g = P + (size_t)row * DIN + C_G + col;
        mb[(size_t)row * DM + col] = f2bf(bf2f(g[0]) * (p0 + p1) + bf2f(g[DM]) * p2 + bf2f(g[2 * DM]) * p3); }
};
struct SEpiWin {
    float* R; bf16_t* P;
    __device__ __forceinline__ void operator()(int row, int col, float v) const {
        const bool isv = (col >= C_VA && col < C_QB) || (col >= C_VB && col < C_QC) || (col >= C_VC);
        if (!isv) { const int rc = col < C_VA ? col : (col < C_VB ? col - 256 : col - 768); R[(size_t)row * RW + rc] = v; }
        else P[(size_t)row * DIN + col] = f2bf(col >= C_G ? sigmoidf(v) : v);
    }
};
template <int STEP> struct SEpiBr {
    float* mf; bf16_t* mb; const bf16_t* P;
    __device__ __forceinline__ void operator()(int row, int col, float v) const {
        const float g = bf2f(P[(size_t)row * DIN + C_G + STEP * DM + col]);
        const size_t o = (size_t)row * DM + col;
        if (STEP == 0) mf[o] = g * v; else if (STEP == 1) mf[o] += g * v; else mb[o] = f2bf(mf[o] + g * v);
    }
};
struct SEpiRes {
    float* h; const float* gx; const float* gc; const float* src;
    __device__ __forceinline__ void operator()(int row, int col, float v) const { const size_t o = (size_t)row * DM + col; h[o] = src[o] + (row < SEQ ? gx[col] : gc[col]) * v; }
};
struct SEpiY { float* Y; __device__ __forceinline__ void operator()(int row, int col, float v) const { Y[(size_t)row * DUP + col] = v; } };

namespace pg8 {
#define PG8_LAS __attribute__((address_space(3)))
constexpr int BM = 256, BK = 64, HALF = 128, HTB = HALF * BK * 2  , STAGE_BYTES = 8 * HTB, NXCD = 8, WGM = 8;
__host__ __device__ __forceinline__ int lds_byte(int r, int c) { const int st = (r >> 4) * 2 + (c >> 5), rr = r & 15, cc = c & 31, ob = rr * 64 + cc * 2; return st * 1024 + (ob ^ (((ob >> 9) & 1) << 5)); }
__host__ __device__ __forceinline__ void stage_rc(int b, int& R, int& C) { const int st = b / 1024, sb = b % 1024, swz = sb ^ (((sb >> 9) & 1) << 5); R = (st >> 1) * 16 + swz / 64; C = (st & 1) * 32 + (swz % 64) / 2; }
__host__ __device__ __forceinline__ int perm32(int rho) { const int n = rho >> 4, i = rho & 15; return 8 * (i >> 2) + 4 * n + (i & 3); }
struct Unit { int pm, pn; };
struct Gemm { const bf16_t* A; const bf16_t* Bt; int M, N, K; int lda = 0, ldb = 0; };
struct OneUnit { Unit u; __device__ __forceinline__ bool next(int i, Unit& o) const { o = u; return i == 0; } __device__ __forceinline__ void a_ready(const Unit&) const {} __device__ __forceinline__ void done(const Unit&) const {} };
struct StaticOrder {
    int nM, nN, nwg, G, c;
    __host__ __device__ __forceinline__ void init(int M, int N, int G_, int c_) { nM = M / BM; nN = N / BM; nwg = nM * nN; G = G_; c = c_; }
    __host__ __device__ __forceinline__ bool next(int i, Unit& u) const {
        const long L = (long)i * G + c; if (L >= nwg) return false;
        int wgid = (int)L; { const int q = nwg / NXCD, r = nwg % NXCD, xcd = wgid % NXCD, off = wgid / NXCD; wgid = (xcd < r ? xcd * (q + 1) : r * (q + 1) + (xcd - r) * q) + off; }
        const int nig = WGM * nN, gid = wgid / nig, fm = gid * WGM, gsz = (nM - fm) < WGM ? (nM - fm) : WGM;
        u.pm = fm + ((wgid % nig) % gsz); u.pn = (wgid % nig) / gsz; return true;
    }
    __device__ __forceinline__ void a_ready(const Unit&) const {}
    __device__ __forceinline__ void done(const Unit&) const {}
};
template <class Epi, class Sched, bool KEEP_IN, bool KEEP_OUT, bool F8 = false>
__device__ __forceinline__ void gemm_phase_core(PG8_LAS unsigned char* lds, const Gemm g, const Sched& S, const Epi& E, int tid, f32x4 (&acc)[2][2][4][2]) {
    asm volatile("" : "+v"(tid));
    const int wid = __builtin_amdgcn_readfirstlane(tid >> 6), lane = tid & 63, wr = wid >> 2, wc = wid & 3, fr = lane & 15, fq = lane >> 4;
    const int K = g.K, nt = K / BK, lda = g.lda ? g.lda : K, ldb = g.ldb ? g.ldb : K;
    unsigned voffA[2], voffB[2];
#pragma unroll
    for (int i = 0; i < 2; ++i) { int R, C; stage_rc(tid * 16 + i * 8192, R, C); const int Rb = Epi::PERM ? ((R & ~31) + perm32(R & 31)) : R;
        voffA[i] = (unsigned)(R * lda + C) * 2u; voffB[i] = (unsigned)(Rb * ldb + C) * 2u; }
    const __amdgpu_buffer_rsrc_t rA_ = __builtin_amdgcn_make_buffer_rsrc((void*)g.A, 0, 0x7fffffff, 0x00020000), rB_ = __builtin_amdgcn_make_buffer_rsrc((void*)g.Bt, 0, 0x7fffffff, 0x00020000);
    const size_t kstep = (size_t)(BK * 2);
    const size_t hstepA = (size_t)HALF * lda * 2, hstepB = (size_t)HALF * ldb * 2;
    const size_t tstepA = 2 * hstepA, tstepB = 2 * hstepB;
    const unsigned ldsw = (unsigned)wid * 1024u;
    const int aoff = lds_byte(wr * 64 + fr, fq * 8), boff = lds_byte(wc * 32 + fr, fq * 8);
#define PG8_SA(b, h) (((b) * 2 + (h)) * HTB)
#define PG8_SB(b, h) ((4 + (b) * 2 + (h)) * HTB)
#define PG8_STAGE(bufoff, gbase, voff, R_, BASE_) do { const int so_ = (int)((const char*)(gbase) - (const char*)(BASE_)); _Pragma("unroll") for (int _i = 0; _i < 2; ++_i) \
        __builtin_amdgcn_raw_ptr_buffer_load_lds(R_, (PG8_LAS void*)(lds + (bufoff) + ldsw + _i * 8192), 16, (voff)[_i], so_, 0, 0); } while (0)
#define PG8_LDA(dst, b, h) do { _Pragma("unroll") for (int m = 0; m < 4; ++m) _Pragma("unroll") for (int k = 0; k < 2; ++k) dst[m][k] = *(const PG8_LAS bf16x8*)(lds + PG8_SA(b, h) + aoff + m * 2048 + k * 1024); } while (0)
#define PG8_LDB(dst, b, h) do { _Pragma("unroll") for (int n = 0; n < 2; ++n) _Pragma("unroll") for (int k = 0; k < 2; ++k) dst[n][k] = *(const PG8_LAS bf16x8*)(lds + PG8_SB(b, h) + boff + n * 2048 + k * 1024); } while (0)
#define PG8_MMA(ai, bj, At, Bt) do { __builtin_amdgcn_s_setprio(1); _Pragma("unroll") for (int m = 0; m < 4; ++m) _Pragma("unroll") for (int n = 0; n < 2; ++n) { \
        if constexpr (F8) { typedef int v4i_ __attribute__((ext_vector_type(4))); typedef int v8i_ __attribute__((ext_vector_type(8))); \
            const v8i_ b8_ = __builtin_shufflevector(__builtin_bit_cast(v4i_, Bt[n][0]), __builtin_bit_cast(v4i_, Bt[n][1]), 0, 1, 2, 3, 4, 5, 6, 7); \
            const v8i_ a8_ = __builtin_shufflevector(__builtin_bit_cast(v4i_, At[m][0]), __builtin_bit_cast(v4i_, At[m][1]), 0, 1, 2, 3, 4, 5, 6, 7); \
            asm volatile("v_mfma_scale_f32_16x16x128_f8f6f4 %0, %1, %2, %0, %3, %3 op_sel_hi:[0,0,0]" : "+v"(acc[ai][bj][m][n]) : "v"(b8_), "v"(a8_), "v"(sc8_)); } \
        else { _Pragma("unroll") for (int k = 0; k < 2; ++k) acc[ai][bj][m][n] = __builtin_amdgcn_mfma_f32_16x16x32_bf16(Bt[n][k], At[m][k], acc[ai][bj][m][n], 0, 0, 0); } } \
        __builtin_amdgcn_s_setprio(0); } while (0)
#define PG8_WAIT_V(n) asm volatile("s_waitcnt vmcnt(" #n ")" ::: "memory")
#define PG8_WAIT_L(n) asm volatile("s_waitcnt lgkmcnt(" #n ")" ::: "memory")
#define PG8_BAR __builtin_amdgcn_s_barrier()
#define PG8_SCHED __builtin_amdgcn_sched_barrier(0)
    int sc8_ = 127; if constexpr (F8) asm volatile("" : "+v"(sc8_));
    Unit cur, nxt; int ui = 0;
    if (!S.next(0, cur)) return;
    if constexpr (!KEEP_IN) {
#pragma unroll
    for (int a = 0; a < 2; ++a)
#pragma unroll
        for (int b = 0; b < 2; ++b)
#pragma unroll
            for (int m = 0; m < 4; ++m)
#pragma unroll
                for (int n = 0; n < 2; ++n) acc[a][b][m][n] = (f32x4){0.f, 0.f, 0.f, 0.f};
    }
    bf16x8 At[4][2], B0[2][2], B1[2][2];
    const char* cA = (const char*)g.A + (size_t)cur.pm * tstepA; const char* cB = (const char*)g.Bt + (size_t)cur.pn * tstepB;
    S.a_ready(cur);
    PG8_STAGE(PG8_SB(0, 0), cB, voffB, rB_, g.Bt); PG8_STAGE(PG8_SA(0, 0), cA, voffA, rA_, g.A); PG8_STAGE(PG8_SB(0, 1), cB + hstepB, voffB, rB_, g.Bt); PG8_STAGE(PG8_SA(0, 1), cA + hstepA, voffA, rA_, g.A);
    if (wr == 1) PG8_BAR;
    PG8_WAIT_V(4); PG8_BAR;
    PG8_STAGE(PG8_SB(1, 0), cB + kstep, voffB, rB_, g.Bt); PG8_STAGE(PG8_SA(1, 0), cA + kstep, voffA, rA_, g.A); PG8_STAGE(PG8_SB(1, 1), cB + hstepB + kstep, voffB, rB_, g.Bt);
    PG8_WAIT_V(6); PG8_BAR;
    for (;;) {
        const bool has_next = S.next(ui + 1, nxt);
        const char* nA = has_next ? (const char*)g.A + (size_t)nxt.pm * tstepA : cA; const char* nB = has_next ? (const char*)g.Bt + (size_t)nxt.pn * tstepB : cB;
        for (int t = 0; t < nt; t += 2) {
            const bool last = (t == nt - 2);
            const char* a1 = cA + (size_t)(t + 1) * kstep;
            const char* a2 = last ? nA : cA + (size_t)(t + 2) * kstep; const char* b2 = last ? nB : cB + (size_t)(t + 2) * kstep;
            const char* a3 = a2 + kstep; const char* b3 = b2 + kstep;
            if (last && has_next) S.a_ready(nxt);
            PG8_LDB(B0, 0, 0); PG8_SCHED; PG8_LDA(At, 0, 0); PG8_STAGE(PG8_SA(1, 1), a1 + hstepA, voffA, rA_, g.A);
            PG8_WAIT_L(8); PG8_BAR; PG8_WAIT_L(0); PG8_MMA(0, 0, At, B0); PG8_BAR; PG8_SCHED;
            PG8_LDB(B1, 0, 1); PG8_STAGE(PG8_SB(0, 0), b2, voffB, rB_, g.Bt);
            PG8_BAR; PG8_WAIT_L(0); PG8_MMA(0, 1, At, B1); PG8_BAR;
            PG8_LDA(At, 0, 1); PG8_STAGE(PG8_SA(0, 0), a2, voffA, rA_, g.A);
            PG8_BAR; PG8_WAIT_L(0); PG8_MMA(1, 0, At, B0); PG8_BAR; PG8_SCHED;
            PG8_STAGE(PG8_SB(0, 1), b2 + hstepB, voffB, rB_, g.Bt);
            PG8_WAIT_V(6); PG8_BAR; PG8_MMA(1, 1, At, B1); PG8_BAR;
            PG8_LDB(B0, 1, 0); PG8_SCHED; PG8_LDA(At, 1, 0); PG8_STAGE(PG8_SA(0, 1), a2 + hstepA, voffA, rA_, g.A);
            PG8_WAIT_L(8); PG8_BAR; PG8_WAIT_L(0); PG8_MMA(0, 0, At, B0); PG8_BAR; PG8_SCHED;
            PG8_LDB(B1, 1, 1); PG8_STAGE(PG8_SB(1, 0), b3, voffB, rB_, g.Bt);
            PG8_BAR; PG8_WAIT_L(0); PG8_MMA(0, 1, At, B1); PG8_BAR;
            PG8_LDA(At, 1, 1); PG8_STAGE(PG8_SA(1, 0), a3, voffA, rA_, g.A);
            PG8_BAR; PG8_WAIT_L(0); PG8_MMA(1, 0, At, B0); PG8_BAR; PG8_SCHED;
            PG8_STAGE(PG8_SB(1, 1), b3 + hstepB, voffB, rB_, g.Bt);
            PG8_WAIT_V(6); PG8_BAR; PG8_MMA(1, 1, At, B1); PG8_BAR;
        }
        if constexpr (F8) {
#define PG8_PIN8(ai, bj, TXT) asm volatile(TXT : "+v"(acc[ai][bj][0][0]), "+v"(acc[ai][bj][0][1]), "+v"(acc[ai][bj][1][0]), "+v"(acc[ai][bj][1][1]), "+v"(acc[ai][bj][2][0]), "+v"(acc[ai][bj][2][1]), "+v"(acc[ai][bj][3][0]), "+v"(acc[ai][bj][3][1]))
            PG8_PIN8(0, 0, "s_nop 15\n\ts_nop 15"); PG8_PIN8(0, 1, ""); PG8_PIN8(1, 0, ""); PG8_PIN8(1, 1, "");
#undef PG8_PIN8
        }
        if constexpr (!Epi::AFTER_DRAIN && !KEEP_OUT) { E(acc, cur, wr, wc, fr, fq); S.done(cur); }
        if (!has_next) break;
#pragma unroll
        for (int a = 0; a < 2; ++a)
#pragma unroll
            for (int b = 0; b < 2; ++b)
#pragma unroll
                for (int m = 0; m < 4; ++m)
#pragma unroll
                    for (int n = 0; n < 2; ++n) acc[a][b][m][n] = (f32x4){0.f, 0.f, 0.f, 0.f};
        cur = nxt; cA = nA; cB = nB; ++ui;
    }
    PG8_WAIT_V(0);
    if (wr == 0) PG8_BAR;
    PG8_BAR;
    if constexpr (Epi::AFTER_DRAIN && !KEEP_OUT) { E.fused(acc, cur, wr, wc, fr, fq, lds, wid, lane); S.done(cur); }
#undef PG8_SA
#undef PG8_SB
#undef PG8_STAGE
#undef PG8_LDA
#undef PG8_LDB
#undef PG8_MMA
#undef PG8_WAIT_V
#undef PG8_WAIT_L
#undef PG8_BAR
#undef PG8_SCHED
}
template <class Epi, class Sched, bool F8 = false>
__device__ __forceinline__ void gemm_phase(PG8_LAS unsigned char* lds, const Gemm g, const Sched& S, const Epi& E, int tid) {
    f32x4 acc[2][2][4][2];
    gemm_phase_core<Epi, Sched, false, false, F8>(lds, g, S, E, tid, acc);
}
}

namespace pg8 {
typedef const f32x4 (&AccRef)[2][2][4][2];
__device__ __forceinline__ u32x4 pack8(const f32x4 a, const f32x4 b) {
    unsigned x, y, z, w;
    asm volatile("s_nop 0\n\tv_cvt_pk_bf16_f32 %0, %4, %5\n\tv_cvt_pk_bf16_f32 %1, %6, %7\n\tv_cvt_pk_bf16_f32 %2, %8, %9\n\tv_cvt_pk_bf16_f32 %3, %10, %11"
        : "=&v"(x), "=&v"(y), "=&v"(z), "=&v"(w) : "v"(a[0]), "v"(a[1]), "v"(a[2]), "v"(a[3]), "v"(b[0]), "v"(b[1]), "v"(b[2]), "v"(b[3]));
    return (u32x4){x, y, z, w}; }
__device__ __forceinline__ void unpack8(const u32x4 w, f32x4& a, f32x4& b) {
    a[0] = __uint_as_float(w.x << 16); a[1] = __uint_as_float(w.x & 0xffff0000u); a[2] = __uint_as_float(w.y << 16); a[3] = __uint_as_float(w.y & 0xffff0000u);
    b[0] = __uint_as_float(w.z << 16); b[1] = __uint_as_float(w.z & 0xffff0000u); b[2] = __uint_as_float(w.w << 16); b[3] = __uint_as_float(w.w & 0xffff0000u); }
struct EpiWin {
    static constexpr bool PERM = true, AFTER_DRAIN = false;
    bf16_t* P; const float* gqa; const float* gka; const float* gqb; const float* gkb; const float* gqc; const float* gkc; LAS float* part; float zs = 1.0f;
    __device__ __forceinline__ void operator()(AccRef acc, const Unit& u, int wr, int wc, int fr_, int fq_) const {
        int fr = fr_, fq = fq_; asm volatile("" : "+v"(fr), "+v"(fq));
        const int row0 = u.pm * BM + wr * 64 + fr, pn = u.pn, colt = pn * BM, cw = wc * 32 + 8 * fq;
        const bool isv = (pn == 5) || (pn == 10) || (pn == 11) || (pn >= 16);
        if (isv) {
            const bool gate = pn >= 18;
#pragma unroll
            for (int ai = 0; ai < 2; ++ai)
#pragma unroll
                for (int m = 0; m < 4; ++m) { bf16_t* pp = P + (size_t)(row0 + ai * HALF + m * 16) * DIN + colt + cw;
#pragma unroll
                    for (int bj = 0; bj < 2; ++bj) { f32x4 v0 = acc[ai][bj][m][0], v1 = acc[ai][bj][m][1];
                        if (gate) {
#pragma unroll
                            for (int e = 0; e < 4; ++e) { v0[e] = sigmoidf(v0[e] * zs); v1[e] = sigmoidf(v1[e] * zs); } }
                        *(u32x4*)(pp + bj * HALF) = pack8(v0, v1); } }
            return;
        }
        int type; float qs; f32x4 g1, g2; const int grpA = wc >> 1, fA = 16 * (wc & 1) + 4 * fq, grpC = wc & 1, fC = 4 * fq;
        if (pn < 4) { type = 0; qs = 0.12751743f; g1 = *(const f32x4*)(gqa + 64 * grpA + fA); g2 = *(const f32x4*)(gqa + 64 * grpA + 32 + fA); }
        else if (pn == 4) { type = 0; qs = 1.f; g1 = *(const f32x4*)(gka + 64 * grpA + fA); g2 = *(const f32x4*)(gka + 64 * grpA + 32 + fA); }
        else if (pn < 8) { type = 1; qs = 0.12751743f; g1 = *(const f32x4*)(gqb + cw); g2 = *(const f32x4*)(gqb + cw + 4); }
        else if (pn < 10) { type = 1; qs = 1.f; g1 = *(const f32x4*)(gkb + cw); g2 = *(const f32x4*)(gkb + cw + 4); }
        else if (pn < 14) { type = 2; qs = 0.18033688f; g1 = *(const f32x4*)(gqc + 32 * grpC + fC); g2 = *(const f32x4*)(gqc + 32 * grpC + 16 + fC); }
        else { type = 2; qs = 1.f; g1 = *(const f32x4*)(gkc + 32 * grpC + fC); g2 = *(const f32x4*)(gkc + 32 * grpC + 16 + fC); }
        const int prow = wr * 64 + fr;
#pragma unroll
        for (int ai = 0; ai < 2; ++ai)
#pragma unroll
            for (int m = 0; m < 4; ++m)
#pragma unroll
                for (int bj = 0; bj < 2; ++bj) { const f32x4 a = acc[ai][bj][m][0], b = acc[ai][bj][m][1];
                    float s = (a[0] * a[0] + a[1] * a[1]) + (a[2] * a[2] + a[3] * a[3]) + (b[0] * b[0] + b[1] * b[1]) + (b[2] * b[2] + b[3] * b[3]);
                    s += swz_xor<16>(s);
                    { auto rr = __builtin_amdgcn_permlane32_swap(__float_as_uint(s), __float_as_uint(s), false, false); s = __uint_as_float(rr[0]) + __uint_as_float(rr[1]); }
                    if (fq == 0) part[((ai * HALF + m * 16 + prow) * 2 + bj) * 4 + wc] = s; }
        asm volatile("s_waitcnt lgkmcnt(0)" ::: "memory"); __builtin_amdgcn_s_barrier(); asm volatile("" ::: "memory");
        f32x4 inv = {0.f, 0.f, 0.f, 0.f}; const int grp = type == 0 ? grpA : grpC;
        if (type != 1) { const int f0 = type == 0 ? fA : fC; const float kf = type == 0 ? (13.287712379549449f / 32.0f) : (13.287712379549449f / 16.0f);
#pragma unroll
            for (int e = 0; e < 4; ++e) inv[e] = __builtin_amdgcn_exp2f(-(float)(f0 + e) * kf); }
        const bool rope = (type != 1) && (u.pm * BM < SEQ);
        const float invn = type == 2 ? (1.0f / 64.0f) : (1.0f / 128.0f);
#pragma unroll
        for (int ai = 0; ai < 2; ++ai)
#pragma unroll
            for (int m = 0; m < 4; ++m) {
                f32x4 cs = {1.f, 1.f, 1.f, 1.f}, sn = {0.f, 0.f, 0.f, 0.f};
                if (rope) { const float pos = grp ? (float)(m * 16 + fr) : (float)(4 * u.pm + 2 * ai + wr);
#pragma unroll
                    for (int e = 0; e < 4; ++e) { const float rev = __builtin_amdgcn_fractf(pos * inv[e] * 0.15915494309189535f); cs[e] = __builtin_amdgcn_cosf(rev); sn[e] = __builtin_amdgcn_sinf(rev); } }
                bf16_t* pp = P + (size_t)(row0 + ai * HALF + m * 16) * DIN + colt + cw;
#pragma unroll
                for (int bj = 0; bj < 2; ++bj) {
                    const f32x4 pq = *(const LAS f32x4*)(part + ((ai * HALF + m * 16 + prow) * 2 + bj) * 4);
                    const float tot = type == 2 ? ((wc & 2) ? pq[2] + pq[3] : pq[0] + pq[1]) : (pq[0] + pq[1]) + (pq[2] + pq[3]);
                    const float rstd = qs * __builtin_amdgcn_rsqf(tot * invn + EPS);
                    f32x4 v0, v1;
#pragma unroll
                    for (int e = 0; e < 4; ++e) { const float y1 = acc[ai][bj][m][0][e] * rstd * g1[e], y2 = acc[ai][bj][m][1][e] * rstd * g2[e];
                        v0[e] = y1 * cs[e] - y2 * sn[e]; v1[e] = y2 * cs[e] + y1 * sn[e]; }
                    *(u32x4*)(pp + bj * HALF) = pack8(v0, v1); }
                asm volatile("" ::: "memory"); }
    }
};
struct EpiGate {
    static constexpr bool PERM = true, AFTER_DRAIN = false;
    bf16_t* P;
    __device__ __forceinline__ void operator()(AccRef acc, const Unit& u, int wr, int wc, int fr, int fq) const {
        const int row0 = u.pm * BM + wr * 64 + fr, col0 = C_G + u.pn * BM + wc * 32 + 8 * fq;
#pragma unroll
        for (int ai = 0; ai < 2; ++ai)
#pragma unroll
            for (int m = 0; m < 4; ++m) { bf16_t* pp = P + (size_t)(row0 + ai * HALF + m * 16) * DIN + col0;
#pragma unroll
                for (int bj = 0; bj < 2; ++bj) { f32x4 v0 = acc[ai][bj][m][0], v1 = acc[ai][bj][m][1];
#pragma unroll
                    for (int e = 0; e < 4; ++e) { v0[e] = __builtin_amdgcn_rcpf(1.0f + __builtin_amdgcn_exp2f(v0[e] * (-1.4426950408889634f / 32.0f))); v1[e] = __builtin_amdgcn_rcpf(1.0f + __builtin_amdgcn_exp2f(v1[e] * (-1.4426950408889634f / 32.0f))); }
                    *(u32x4*)(pp + bj * HALF) = pack8(v0, v1); } }
    }
};
struct GateOrder {
    int first, count, stride;
    __device__ __forceinline__ void init(int c, int G) { stride = 1; if (G != 256) { first = c; stride = G; count = (33 * 24 - c + G - 1) / G; } else if (c < 82) { first = 2 * c; count = 2; } else if (c < 188) { first = 164 + 4 * (c - 82); count = 4; } else { first = 588 + 3 * (c - 188); count = 3; } }
    __device__ __forceinline__ bool next(int i, Unit& u) const { if (i >= count) return false; const int g = first + i * stride; u.pm = g / 24; u.pn = g % 24; return true; }
    __device__ __forceinline__ void a_ready(const Unit&) const {}
    __device__ __forceinline__ void done(const Unit&) const {}
};
template <int STEP> struct EpiBr {
    static constexpr bool PERM = true, AFTER_DRAIN = false;
    float* mf; bf16_t* mb; const bf16_t* P;
    __device__ __forceinline__ void operator()(AccRef acc, const Unit& u, int wr, int wc, int fr, int fq) const {
        const int row0 = u.pm * BM + wr * 64 + fr, col0 = u.pn * BM + wc * 32 + 8 * fq;
#pragma unroll
        for (int am = 0; am < 4; ++am) { const int ai = am >> 1, m0 = (am & 1) * 2;
            u32x4 gw[2][2]; f32x4 old0[2][2], old1[2][2];
#pragma unroll
            for (int mm = 0; mm < 2; ++mm)
#pragma unroll
                for (int bj = 0; bj < 2; ++bj) { const size_t row = (size_t)(row0 + ai * HALF + (m0 + mm) * 16); const int col = col0 + bj * HALF;
                    gw[mm][bj] = *(const u32x4*)(P + row * DIN + C_G + STEP * DM + col);
                    if (STEP > 0) { old0[mm][bj] = *(const f32x4*)(mf + row * DM + col); old1[mm][bj] = *(const f32x4*)(mf + row * DM + col + 4); } }
#pragma unroll
            for (int mm = 0; mm < 2; ++mm)
#pragma unroll
                for (int bj = 0; bj < 2; ++bj) { const size_t row = (size_t)(row0 + ai * HALF + (m0 + mm) * 16); const int col = col0 + bj * HALF;
                    f32x4 g0, g1; unpack8(gw[mm][bj], g0, g1);
                    f32x4 v0 = g0 * acc[ai][bj][m0 + mm][0], v1 = g1 * acc[ai][bj][m0 + mm][1];
                    if (STEP > 0) { v0 += old0[mm][bj]; v1 += old1[mm][bj]; }
                    float* mp = mf + row * DM + col;
                    if (STEP < 2) { *(f32x4*)mp = v0; *(f32x4*)(mp + 4) = v1; } else *(u32x4*)(mb + row * DM + col) = pack8(v0, v1); }
            asm volatile("" ::: "memory");
        }
    }
};

struct EpiBrChain {
    static constexpr bool PERM = true, AFTER_DRAIN = false;
    bf16_t* mb; const bf16_t* P;
    template <int GS> __device__ __forceinline__ void scale(f32x4 (&acc)[2][2][4][2], const Unit& u, int tid) const {
        asm volatile("" : "+v"(tid));
        const int wid = __builtin_amdgcn_readfirstlane(tid >> 6), lane = tid & 63, wr = wid >> 2, wc = wid & 3, fr = lane & 15, fq = lane >> 4;
        const bf16_t* gp0 = P + (size_t)(u.pm * BM + wr * 64 + fr) * DIN + C_G + GS * DM + u.pn * BM + wc * 32 + 8 * fq;
        typedef const __attribute__((address_space(1))) u32x4 gq;
        u32x4 cn[2], cd[2], nn[2], nd[2];
#define GLD(n_, d_, g_) do { const bf16_t* gp_ = gp0 + (size_t)(((g_) >> 2) * HALF + ((g_) & 3) * 16) * DIN; _Pragma("unroll") for (int bj = 0; bj < 2; ++bj) { n_[bj] = *(gq*)(gp_ + bj * HALF); d_[bj] = *(gq*)(gp_ + DM + bj * HALF); } } while (0)
        GLD(cn, cd, 0);
#pragma unroll
        for (int g = 0; g < 8; ++g) { const int ai = g >> 2, m = g & 3;
            if (g < 7) GLD(nn, nd, g + 1);
#pragma unroll
            for (int bj = 0; bj < 2; ++bj) { f32x4 n0, n1, d0, d1; unpack8(cn[bj], n0, n1); unpack8(cd[bj], d0, d1);
#pragma unroll
                for (int e = 0; e < 4; ++e) { const float a0 = GS ? fmaxf(n0[e], 1e-15f) : n0[e], a1 = GS ? fmaxf(n1[e], 1e-15f) : n1[e];
                    acc[ai][bj][m][0][e] *= a0 * __builtin_amdgcn_rcpf(fmaxf(d0[e], 1e-15f)); acc[ai][bj][m][1][e] *= a1 * __builtin_amdgcn_rcpf(fmaxf(d1[e], 1e-15f)); } }
            asm volatile("" : "+v"(acc[ai][0][m][0]), "+v"(acc[ai][0][m][1]), "+v"(acc[ai][1][m][0]), "+v"(acc[ai][1][m][1]) :: "memory");
#pragma unroll
            for (int bj = 0; bj < 2; ++bj) { cn[bj] = nn[bj]; cd[bj] = nd[bj]; }
        }
#undef GLD
    }
    __device__ __forceinline__ void operator()(AccRef acc, const Unit& u, int wr, int wc, int fr_, int fq) const {
        int fr = fr_; asm volatile("" : "+v"(fr));
        const int row0 = u.pm * BM + wr * 64 + fr, col0 = u.pn * BM + wc * 32 + 8 * fq;
#pragma unroll
        for (int am = 0; am < 4; ++am) { const int ai = am >> 1, m0 = (am & 1) * 2;
            u32x4 gw[2][2];
#pragma unroll
            for (int mm = 0; mm < 2; ++mm)
#pragma unroll
                for (int bj = 0; bj < 2; ++bj) gw[mm][bj] = *(const __attribute__((address_space(1))) u32x4*)(P + (size_t)(row0 + ai * HALF + (m0 + mm) * 16) * DIN + C_G + 2 * DM + col0 + bj * HALF);
#pragma unroll
            for (int mm = 0; mm < 2; ++mm)
#pragma unroll
                for (int bj = 0; bj < 2; ++bj) { f32x4 g0, g1; unpack8(gw[mm][bj], g0, g1);
#pragma unroll
                    for (int e = 0; e < 4; ++e) { g0[e] = fmaxf(g0[e], 1e-15f); g1[e] = fmaxf(g1[e], 1e-15f); }
                    *(u32x4*)(mb + (size_t)(row0 + ai * HALF + (m0 + mm) * 16) * DM + col0 + bj * HALF) = pack8(g0 * acc[ai][bj][m0 + mm][0], g1 * acc[ai][bj][m0 + mm][1]); }
            asm volatile("" ::: "memory"); }
    }
};
struct EpiRes {
    static constexpr bool PERM = false, AFTER_DRAIN = false;
    const float* h; const float* gx; const float* gc; float* dst;
    __device__ __forceinline__ void operator()(AccRef acc, const Unit& u, int wr, int wc, int fr, int fq) const {
        const int row0 = u.pm * BM + wr * 64 + fr, col0 = u.pn * BM + wc * 32 + 4 * fq;
        const float* gp = (u.pm * BM < SEQ ? gx : gc) + col0;
        f32x4 gv[2][2];
#pragma unroll
        for (int bj = 0; bj < 2; ++bj)
#pragma unroll
            for (int n = 0; n < 2; ++n) gv[bj][n] = *(const f32x4*)(gp + bj * HALF + n * 16);
#pragma unroll
        for (int am = 0; am < 4; ++am) { const int ai = am >> 1, m0 = (am & 1) * 2;
            f32x4 old[2][2][2];
#pragma unroll
            for (int mm = 0; mm < 2; ++mm)
#pragma unroll
                for (int bj = 0; bj < 2; ++bj)
#pragma unroll
                    for (int n = 0; n < 2; ++n) old[mm][bj][n] = *(const f32x4*)(h + (size_t)(row0 + ai * HALF + (m0 + mm) * 16) * DM + col0 + bj * HALF + n * 16);
#pragma unroll
            for (int mm = 0; mm < 2; ++mm)
#pragma unroll
                for (int bj = 0; bj < 2; ++bj)
#pragma unroll
                    for (int n = 0; n < 2; ++n) *(f32x4*)(dst + (size_t)(row0 + ai * HALF + (m0 + mm) * 16) * DM + col0 + bj * HALF + n * 16) = old[mm][bj][n] + gv[bj][n] * acc[ai][bj][m0 + mm][n];
            asm volatile("" ::: "memory"); }
    }
};
__device__ __forceinline__ float dpp_ror1(float v)  { return __int_as_float(__builtin_amdgcn_update_dpp(__float_as_int(v), __float_as_int(v), 0x121, 0xf, 0xf, false)); }
__device__ __forceinline__ float dpp_ror15(float v) { return __int_as_float(__builtin_amdgcn_update_dpp(__float_as_int(v), __float_as_int(v), 0x12f, 0xf, 0xf, false)); }
struct EpiUp {
    static constexpr bool PERM = true, AFTER_DRAIN = false;
    bf16_t* act; float* E; const float* cw; const float* cb;
    __device__ __forceinline__ void operator()(AccRef acc, const Unit& u, int wr, int wc, int fr, int fq) const {
        const int ch0 = u.pn * 128 + wc * 32 + 8 * fq, ycol0 = u.pn * BM + wc * 32 + 8 * fq;
#pragma unroll
        for (int nn = 0; nn < 2; ++nn) {
            const int ch = ch0 + 4 * nn;
            const f32x4 wa0 = *(const f32x4*)(cw + ch), wa1 = *(const f32x4*)(cw + DUP + ch), wa2 = *(const f32x4*)(cw + 2 * DUP + ch), ba = *(const f32x4*)(cb + ch);
            const f32x4 wg0 = *(const f32x4*)(cw + DFF + ch), wg1 = *(const f32x4*)(cw + DUP + DFF + ch), wg2 = *(const f32x4*)(cw + 2 * DUP + DFF + ch), bg = *(const f32x4*)(cb + DFF + ch);
#pragma unroll
            for (int ai = 0; ai < 2; ++ai) {
                const int blk = 4 * u.pm + 2 * ai + wr;
#pragma unroll
                for (int m = 0; m < 4; ++m) {
                    const f32x4 ya = acc[ai][0][m][nn], yg = acc[ai][1][m][nn];
                    const f32x4 pa = acc[ai][0][m > 0 ? m - 1 : 0][nn], pg = acc[ai][1][m > 0 ? m - 1 : 0][nn];
                    const f32x4 na = acc[ai][0][m < 3 ? m + 1 : 3][nn], ng = acc[ai][1][m < 3 ? m + 1 : 3][nn];
                    f32x4 o, ha4, hg4;
#pragma unroll
                    for (int e = 0; e < 4; ++e) {
                        const float ua = dpp_ror1(fr == 15 ? pa[e] : ya[e]), ug = dpp_ror1(fr == 15 ? pg[e] : yg[e]);
                        const float da = dpp_ror15(fr == 0 ? na[e] : ya[e]), dg = dpp_ror15(fr == 0 ? ng[e] : yg[e]);
                        ha4[e] = ba[e] + wa0[e] * ua + wa1[e] * ya[e] + wa2[e] * da;
                        hg4[e] = bg[e] + wg0[e] * ug + wg1[e] * yg[e] + wg2[e] * dg;
                    }
                    {
                        f32x4 t = hg4 * -1.4426950408889634f;
#pragma unroll
                        for (int e = 0; e < 4; ++e) t[e] = __builtin_amdgcn_exp2f(t[e]);
                        t = t + 1.0f;
#pragma unroll
                        for (int e = 0; e < 4; ++e) t[e] = __builtin_amdgcn_rcpf(t[e]);
                        o = (hg4 * ha4) * t;
                    }
                    const int row = u.pm * BM + ai * HALF + wr * 64 + m * 16 + fr;
                    const bool edge = (m == 0 && fr == 0) || (m == 3 && fr == 15);
                    if (!edge) { u32x2 w; w.x = cvt_pk_bf16(o[0], o[1]); w.y = cvt_pk_bf16(o[2], o[3]); *(u32x2*)(act + (size_t)row * DFF + ch) = w; }
                    if ((m == 0 && fr < 2) || (m == 3 && fr >= 14)) {
                        const int slot = (m == 0) ? fr : fr - 12;
                        float* ep = E + ((size_t)blk * 4 + slot) * DUP + ycol0 + 4 * nn; *(f32x4*)ep = ya; *(f32x4*)(ep + HALF) = yg;
                    }
                }
            }
        }
    }
};
struct EpiY {
    static constexpr bool PERM = false, AFTER_DRAIN = false;
    float* Y;
    __device__ __forceinline__ void operator()(AccRef acc, const Unit& u, int wr, int wc, int fr, int fq) const {
        const int row0 = u.pm * BM + wr * 64 + fr, col0 = u.pn * BM + wc * 32 + 4 * fq;
#pragma unroll
        for (int ai = 0; ai < 2; ++ai)
#pragma unroll
            for (int m = 0; m < 4; ++m) { float* yp = Y + (size_t)(row0 + ai * HALF + m * 16) * DUP + col0;
#pragma unroll
                for (int bj = 0; bj < 2; ++bj)
#pragma unroll
                    for (int n = 0; n < 2; ++n) *(f32x4*)(yp + bj * HALF + n * 16) = acc[ai][bj][m][n]; }
    }
};
}

namespace att {
constexpr int D = 128, NW = 8, QBLK = 32, KVBLK = 64, LDP = DIN;
constexpr int SHM_V = KVBLK * D * 2, SHM_K = SHM_V;
constexpr int TILE_B = SHM_K + SHM_V, NRING = 4;
constexpr int OFF_WS = NRING * TILE_B, OFF_BIAS = OFF_WS + NW * 64 * 4, BIAS_PAD = 64, BIAS_N = 15 * 31, SHM_TOTAL = OFF_BIAS + (2 * BIAS_PAD + 480) * 4;
#define KSWZ(row, colB) ((row) * 256 + ((colB) ^ (((row) & 7) << 4)))
#define SBAR() __builtin_amdgcn_sched_barrier(0)
#define LAUNDER(p) asm volatile("" : "+v"(p))
__device__ __forceinline__ int crow(int r, int hi) { return (r & 3) + 8 * (r >> 2) + 4 * hi; }

struct Unit {
    const bf16_t* Q;
    const bf16_t* K;
    const bf16_t* V;
    int nt, key0;
    int rsA, r0;
    bf16_t* O; int ldo;
    float* S;
    const float* gsub; float lam, osc;
    float shift;
    int tmask;
    int var;
};

__device__ __forceinline__ void halfSM(f32x16& p, float& l_reg, bf16x8& paX, bf16x8& paY) {
#pragma unroll
    for (int r = 0; r < 16; ++r) p[r] = __builtin_amdgcn_exp2f(p[r]);
    float ps = 0;
#pragma unroll
    for (int r = 0; r < 16; ++r) ps += p[r];
    l_reg += ps;
#define PK4(P, BASE, OUT) do { unsigned a0, a1, b0, b1; \
    asm volatile("s_nop 0\n\tv_cvt_pk_bf16_f32 %0, %4, %5\n\tv_cvt_pk_bf16_f32 %1, %6, %7\n\tv_cvt_pk_bf16_f32 %2, %8, %9\n\tv_cvt_pk_bf16_f32 %3, %10, %11" \
        : "=&v"(a0), "=&v"(a1), "=&v"(b0), "=&v"(b1) : "v"(P[BASE + 0]), "v"(P[BASE + 1]), "v"(P[BASE + 2]), "v"(P[BASE + 3]), "v"(P[BASE + 4]), "v"(P[BASE + 5]), "v"(P[BASE + 6]), "v"(P[BASE + 7])); \
    auto r0 = __builtin_amdgcn_permlane32_swap(a0, b0, false, false); auto r1 = __builtin_amdgcn_permlane32_swap(a1, b1, false, false); \
    u32x4 w = {r0[0], r1[0], r0[1], r1[1]}; OUT = *reinterpret_cast<bf16x8*>(&w); } while (0)
    PK4(p, 0, paX); PK4(p, 8, paY);
#undef PK4
}
template <int NDQ, int DB, bool SHIFT>
__device__ __forceinline__ void qkt(f32x16& p0, f32x16& p1, const char* Ks, const bf16x8* qr, int r32, int hi, float shift) {
    p0 = f32x16{}; p1 = f32x16{};
#pragma unroll
    for (int d0 = 0; d0 < NDQ; ++d0) { const int cb = ((DB + d0) * 16 + hi * 8) * 2;
        const bf16x8 b0 = *reinterpret_cast<const bf16x8*>(Ks + KSWZ(r32, cb));
        const bf16x8 b1 = *reinterpret_cast<const bf16x8*>(Ks + KSWZ(32 + r32, cb));
        p0 = __builtin_amdgcn_mfma_f32_32x32x16_bf16(b0, qr[d0], p0, 0, 0, 0);
        p1 = __builtin_amdgcn_mfma_f32_32x32x16_bf16(b1, qr[d0], p1, 0, 0, 0); }
    if (SHIFT && shift != 0.f) {
        const short one = hi == 0 ? (short)0x3f80 : (short)0, ms = hi == 0 ? (short)f2bf(-shift) : (short)0;
        const bf16x8 af = {one, 0, 0, 0, 0, 0, 0, 0}, bf = {ms, 0, 0, 0, 0, 0, 0, 0};
        p0 = __builtin_amdgcn_mfma_f32_32x32x16_bf16(af, bf, p0, 0, 0, 0);
        p1 = __builtin_amdgcn_mfma_f32_32x32x16_bf16(af, bf, p1, 0, 0, 0); }
}
__device__ __forceinline__ int v_st(int k, int c) { const int kk = (k & ~0xC) | ((k & 4) << 1) | ((k & 8) >> 1); return ((kk >> 3) * 4 + (c >> 5)) * 512 + ((kk & 7) * 32 + (c & 31)) * 2; }
__device__ __forceinline__ int v_rd_base(int lane) { return ((lane & 3) << 3) | (((lane >> 2) & 3) << 6) | (((lane >> 4) & 1) << 5) | (((lane >> 5) & 1) << 8); }
constexpr int v_rd_off(int d0, int ks, int half) { return d0 * 512 + ks * 4096 + half * 2048; }
template <int OFF> __device__ __forceinline__ s16x4 tr_read(int vb) {
    s16x4 r; asm volatile("ds_read_b64_tr_b16 %0, %1 offset:%2" : "=&v"(r) : "v"(vb), "i"(OFF) : "memory"); return r;
}
template <int D0> __device__ __forceinline__ void pv_one(f32x16& od, int vb, bf16x8 pa0, bf16x8 pa1, bf16x8 pa2, bf16x8 pa3) {
    const s16x4 l0 = tr_read<v_rd_off(D0, 0, 0)>(vb), h0 = tr_read<v_rd_off(D0, 0, 1)>(vb), l1 = tr_read<v_rd_off(D0, 1, 0)>(vb), h1 = tr_read<v_rd_off(D0, 1, 1)>(vb);
    const s16x4 l2 = tr_read<v_rd_off(D0, 2, 0)>(vb), h2 = tr_read<v_rd_off(D0, 2, 1)>(vb), l3 = tr_read<v_rd_off(D0, 3, 0)>(vb), h3 = tr_read<v_rd_off(D0, 3, 1)>(vb);
    asm volatile("s_waitcnt lgkmcnt(0)" ::: "memory"); SBAR();
#define PK(L, H) (bf16x8){L[0], L[1], L[2], L[3], H[0], H[1], H[2], H[3]}
    od = __builtin_amdgcn_mfma_f32_32x32x16_bf16(pa0, PK(l0, h0), od, 0, 0, 0);
    od = __builtin_amdgcn_mfma_f32_32x32x16_bf16(pa1, PK(l1, h1), od, 0, 0, 0);
    od = __builtin_amdgcn_mfma_f32_32x32x16_bf16(pa2, PK(l2, h2), od, 0, 0, 0);
    od = __builtin_amdgcn_mfma_f32_32x32x16_bf16(pa3, PK(l3, h3), od, 0, 0, 0);
#undef PK
}
__device__ __forceinline__ void pv_d0(f32x16* o, int vb, bf16x8 pa0, bf16x8 pa1, bf16x8 pa2, bf16x8 pa3) {
    pv_one<0>(o[0], vb, pa0, pa1, pa2, pa3); pv_one<1>(o[1], vb, pa0, pa1, pa2, pa3); pv_one<2>(o[2], vb, pa0, pa1, pa2, pa3); pv_one<3>(o[3], vb, pa0, pa1, pa2, pa3);
}


template <int OFF> __device__ __forceinline__ bf16x8 k_read(int addr) { bf16x8 r; asm volatile("ds_read_b128 %0, %1 offset:%2" : "=&v"(r) : "v"(addr), "i"(OFF) : "memory"); return r; }
#define LWAIT(n) do { asm volatile("s_waitcnt lgkmcnt(" #n ")" ::: "memory"); SBAR(); } while (0)
template <int D0> __device__ __forceinline__ void v_read8(s16x4 (&v)[8], int vb) {
    v[0] = tr_read<v_rd_off(D0, 0, 0)>(vb); v[1] = tr_read<v_rd_off(D0, 0, 1)>(vb); v[2] = tr_read<v_rd_off(D0, 1, 0)>(vb); v[3] = tr_read<v_rd_off(D0, 1, 1)>(vb);
    v[4] = tr_read<v_rd_off(D0, 2, 0)>(vb); v[5] = tr_read<v_rd_off(D0, 2, 1)>(vb); v[6] = tr_read<v_rd_off(D0, 3, 0)>(vb); v[7] = tr_read<v_rd_off(D0, 3, 1)>(vb);
}
__device__ __forceinline__ void pv_mma(f32x16& od, const s16x4 (&v)[8], bf16x8 pa0, bf16x8 pa1, bf16x8 pa2, bf16x8 pa3) {
#define PK(L, H) (bf16x8){L[0], L[1], L[2], L[3], H[0], H[1], H[2], H[3]}
    od = __builtin_amdgcn_mfma_f32_32x32x16_bf16(pa0, PK(v[0], v[1]), od, 0, 0, 0);
    od = __builtin_amdgcn_mfma_f32_32x32x16_bf16(pa1, PK(v[2], v[3]), od, 0, 0, 0);
    od = __builtin_amdgcn_mfma_f32_32x32x16_bf16(pa2, PK(v[4], v[5]), od, 0, 0, 0);
    od = __builtin_amdgcn_mfma_f32_32x32x16_bf16(pa3, PK(v[6], v[7]), od, 0, 0, 0);
#undef PK
}
template <int NDQ, int DB, bool SHIFT>
__device__ __forceinline__ void x_phase(f32x16& p0, f32x16& p1, f32x16 (&o)[4], const bf16x8* qr, const int (&ka)[4], int kd, int vb, bool do_pv, s16x4 (&va)[8],
                                        bf16x8 pa0, bf16x8 pa1, bf16x8 pa2, bf16x8 pa3, float shift, int hi, int var) {
    bf16x8 kf[2 * NDQ]; s16x4 vbk[8];
    int kb[4];
#pragma unroll
    for (int b = 0; b < 4; ++b) kb[b] = ka[b] + (DB >= 4 ? kd : 0);
    asm volatile("s_waitcnt lgkmcnt(0)" ::: "memory");
    SBAR();
#pragma unroll
    for (int b = 0; b < 4; ++b) { kf[2 * b] = k_read<0>(kb[b]); kf[2 * b + 1] = k_read<8192>(kb[b]); }
    if (do_pv) {
        v_read8<1>(vbk, vb); LWAIT(8); pv_mma(o[0], va, pa0, pa1, pa2, pa3); SBAR();
        v_read8<2>(va, vb);  LWAIT(8); pv_mma(o[1], vbk, pa0, pa1, pa2, pa3); SBAR();
        v_read8<3>(vbk, vb); LWAIT(8); pv_mma(o[2], va, pa0, pa1, pa2, pa3); SBAR();
    }
    if constexpr (NDQ == 8) {
#pragma unroll
        for (int b = 0; b < 4; ++b) { kf[8 + 2 * b] = k_read<0>(ka[b] + kd); kf[8 + 2 * b + 1] = k_read<8192>(ka[b] + kd); }
        if (do_pv) { LWAIT(8); pv_mma(o[3], vbk, pa0, pa1, pa2, pa3); SBAR(); } else LWAIT(8);
    } else { if (do_pv) { LWAIT(0); pv_mma(o[3], vbk, pa0, pa1, pa2, pa3); SBAR(); } else LWAIT(0); }
    p0 = f32x16{}; p1 = f32x16{};
#pragma unroll
    for (int d0 = 0; d0 < 4; ++d0) { p0 = __builtin_amdgcn_mfma_f32_32x32x16_bf16(kf[2 * d0], qr[d0], p0, 0, 0, 0); p1 = __builtin_amdgcn_mfma_f32_32x32x16_bf16(kf[2 * d0 + 1], qr[d0], p1, 0, 0, 0); }
    SBAR();
    if constexpr (NDQ == 8) {
        LWAIT(0);
#pragma unroll
        for (int d0 = 4; d0 < 8; ++d0) { p0 = __builtin_amdgcn_mfma_f32_32x32x16_bf16(kf[2 * d0], qr[d0], p0, 0, 0, 0); p1 = __builtin_amdgcn_mfma_f32_32x32x16_bf16(kf[2 * d0 + 1], qr[d0], p1, 0, 0, 0); }
        SBAR();
    }
    if (SHIFT && shift != 0.f) {
        const short one = hi == 0 ? (short)0x3f80 : (short)0, ms = hi == 0 ? (short)f2bf(-shift) : (short)0;
        const bf16x8 af = {one, 0, 0, 0, 0, 0, 0, 0}, bfr = {ms, 0, 0, 0, 0, 0, 0, 0};
        p0 = __builtin_amdgcn_mfma_f32_32x32x16_bf16(af, bfr, p0, 0, 0, 0); p1 = __builtin_amdgcn_mfma_f32_32x32x16_bf16(af, bfr, p1, 0, 0, 0); SBAR();
    }
}

struct NaCtx { int rsA, rq, rsq, cq, csq; const float* bias; };
template <bool NA, int HALF_>
__device__ __forceinline__ void na_hook(f32x16& p, int t, const NaCtx& n, int hi) {
    if constexpr (NA) {
        if (t >= 4) {
            const int kr = n.rsA + t - 4;
            if (kr < n.rsq || kr >= n.rsq + 8) {
#pragma unroll
                for (int r = 0; r < 16; ++r) p[r] = -1e30f;
            } else {
                const float* brow = n.bias + (kr - n.rq + 7) * 31 + 15 - n.cq + 32 * HALF_;
#pragma unroll
                for (int rg = 0; rg < 16; rg += 8) {
                    float b[8];
#pragma unroll
                    for (int r = 0; r < 8; ++r) b[r] = brow[crow(rg + r, hi)];
                    asm volatile("s_waitcnt lgkmcnt(0)" ::: "memory");
#pragma unroll
                    for (int r = 0; r < 8; ++r) { const int kc = crow(rg + r, hi) + 32 * HALF_; p[rg + r] = (kc >= n.csq && kc < n.csq + 16) ? p[rg + r] + b[r] : -1e30f; }
                }
            }
        }
    }
}

template <int NDQ, int DB, bool NA, int EPI, bool SHIFT>
__device__ __forceinline__ void attn_body(const Unit& u, char* lds, int tid) {
    asm volatile("" : "+v"(tid));
    const int wid = __builtin_amdgcn_readfirstlane(tid >> 6), lane = tid & 63, r32 = lane & 31, hi = lane >> 5;
    const bool trail = wid >= 4;
    float* li_l = (float*)(lds + OFF_WS) + wid * 64;
    float l_reg = 0; f32x16 o[4] = {}; bf16x8 qr[NDQ]; const float shift = u.shift;
    typedef __attribute__((address_space(1))) const bf16x8 gbf16x8;
    const bf16_t* Qw = u.Q + (long)(wid * QBLK + r32) * LDP + hi * 8 + DB * 16;
#pragma unroll
    for (int d0 = 0; d0 < NDQ; ++d0) qr[d0] = *(gbf16x8*)(Qw + d0 * 16);
    const int vb0 = (int)(uintptr_t)lds + SHM_K + v_rd_base(lane);
    int ka0[4];
#pragma unroll
    for (int b = 0; b < 4; ++b) ka0[b] = (int)(uintptr_t)lds + r32 * 256 + 16 * ((2 * b) ^ (hi ^ (r32 & 7))) + 128 * ((r32 >> 3) & 1);
    const int kd = 128 - 256 * ((r32 >> 3) & 1);
    NaCtx na;
    if constexpr (NA) { na.rsA = u.rsA; na.rq = u.r0 + (wid >> 1); na.rsq = min(max(na.rq - 4, 0), 120); na.cq = 32 * (wid & 1) + r32; na.csq = min(max(na.cq - 8, 0), 48); na.bias = (const float*)(lds + OFF_BIAS) + BIAS_PAD; }
    unsigned koff[2], voff[2];
#pragma unroll
    for (int i = 0; i < 2; ++i) { const int G = wid * 128 + i * 64 + lane;
        { const int row = G >> 4, g = (G & 15) ^ (row & 15); koff[i] = (unsigned)(row * LDP + g * 8) * 2u; }
        { const int sub = G >> 5, r8 = (G >> 2) & 7, c4 = G & 3, kk = (sub >> 2) * 8 + r8, cg = (sub & 3) * 4 + c4, k = (kk & ~0xC) | ((kk & 4) << 1) | ((kk & 8) >> 1); voff[i] = (unsigned)(k * LDP + cg * 8) * 2u; } }
    const char* Kg = (const char*)u.K; const char* Vg = (const char*)u.V;
    LAS unsigned char* ldsL = (LAS unsigned char*)(unsigned)(uintptr_t)lds;
#define TROW(t) (NA ? ((t) < 4 ? SEQ + 64 * ((t) & u.tmask) : (u.rsA + (((t) - 4) & u.tmask)) * 64) : u.key0 + 64 * ((t) & u.tmask))
    const __amdgpu_buffer_rsrc_t rK_ = __builtin_amdgcn_make_buffer_rsrc((void*)launder_uniform(Kg), 0, 0x7fffffff, 0x00020000);
    const __amdgpu_buffer_rsrc_t rV_ = __builtin_amdgcn_make_buffer_rsrc((void*)launder_uniform(Vg), 0, 0x7fffffff, 0x00020000);
#define DMA_TILE(t, boff) do { const int rb_ = __builtin_amdgcn_readfirstlane((TROW(t)) * (LDP * 2)); _Pragma("unroll") for (int i_ = 0; i_ < 2; ++i_) { \
        __builtin_amdgcn_raw_ptr_buffer_load_lds(rK_, (LAS void*)(ldsL + (boff) + wid * 2048 + i_ * 1024), 16, koff[i_], rb_, 0, 0); \
        __builtin_amdgcn_raw_ptr_buffer_load_lds(rV_, (LAS void*)(ldsL + (boff) + SHM_K + wid * 2048 + i_ * 1024), 16, voff[i_], rb_, 0, 0); } } while (0)
#define VWAIT() asm volatile("s_waitcnt vmcnt(0)" ::: "memory")
#define PBAR() do { asm volatile("s_waitcnt lgkmcnt(0)" ::: "memory"); __builtin_amdgcn_s_barrier(); asm volatile("" ::: "memory"); } while (0)
    bf16x8 pa0, pa1, pa2, pa3; f32x16 p0, p1; s16x4 va[8]; const int NT = u.nt;
#if MK_ATT_1BAR
#define SLOT(t) (((t) & (NRING - 1)) * TILE_B)
#define ENDI(k) do { if ((k) + 2 < NT) asm volatile("s_waitcnt vmcnt(4)" ::: "memory"); else VWAIT(); PBAR(); } while (0)
    DMA_TILE(0, 0); DMA_TILE(1, TILE_B); VWAIT(); PBAR();
    if (trail && 2 < NT) DMA_TILE(2, 2 * TILE_B);
    int b_prev = 3 * TILE_B, b_cur = 0;
    for (int i = 0; i < NT; ++i) {
        { int ka[4];
#pragma unroll
          for (int b = 0; b < 4; ++b) ka[b] = ka0[b] + b_cur;
          x_phase<NDQ, DB, SHIFT>(p0, p1, o, qr, ka, kd, vb0 + b_prev, i >= 1, va, pa0, pa1, pa2, pa3, shift, hi, 0); }
        if (trail) ENDI(i);
        { const int td = trail ? i + 3 : i + 2; if (td < NT) DMA_TILE(td, SLOT(td)); }
        na_hook<NA, 0>(p0, i, na, hi); halfSM(p0, l_reg, pa0, pa1); SBAR();
        na_hook<NA, 1>(p1, i, na, hi); halfSM(p1, l_reg, pa2, pa3);
        asm volatile("" : "+v"(l_reg));
        SBAR(); v_read8<0>(va, vb0 + b_cur);
        if (!trail) ENDI(i); else { asm volatile("" ::: "memory"); SBAR(); }
        b_prev = b_cur; b_cur = (b_cur + TILE_B) & (NRING * TILE_B - 1);
    }
#undef SLOT
#undef ENDI
#else
    DMA_TILE(0, 0); DMA_TILE(1, TILE_B); VWAIT(); PBAR();
    if (trail) PBAR();
    int b_prev = 3 * TILE_B, b_cur = 0;
    for (int i = 0; i < NT; ++i) {
        { int ka[4];
#pragma unroll
          for (int b = 0; b < 4; ++b) ka[b] = ka0[b] + b_cur;
          x_phase<NDQ, DB, SHIFT>(p0, p1, o, qr, ka, kd, vb0 + b_prev, i >= 1, va, pa0, pa1, pa2, pa3, shift, hi, u.var); }
        VWAIT();
        PBAR();
        if (i + 2 < NT && !(u.var & 8)) DMA_TILE(i + 2, (b_cur + 2 * TILE_B) & (NRING * TILE_B - 1));
        if (!(u.var & 2)) { na_hook<NA, 0>(p0, i, na, hi); halfSM(p0, l_reg, pa0, pa1); SBAR();
        na_hook<NA, 1>(p1, i, na, hi); halfSM(p1, l_reg, pa2, pa3); }
        asm volatile("" : "+v"(l_reg));
        SBAR(); if (!(u.var & 16)) v_read8<0>(va, vb0 + b_cur);
        PBAR();
        b_prev = b_cur; b_cur = (b_cur + TILE_B) & (NRING * TILE_B - 1);
    }
#endif
    {
        s16x4 vbk[8];
        v_read8<1>(vbk, vb0 + b_prev); LWAIT(8); pv_mma(o[0], va, pa0, pa1, pa2, pa3); SBAR();
        v_read8<2>(va, vb0 + b_prev);  LWAIT(8); pv_mma(o[1], vbk, pa0, pa1, pa2, pa3); SBAR();
        v_read8<3>(vbk, vb0 + b_prev); LWAIT(8); pv_mma(o[2], va, pa0, pa1, pa2, pa3); SBAR();
        LWAIT(0); pv_mma(o[3], vbk, pa0, pa1, pa2, pa3); SBAR();
    }
#if !MK_ATT_1BAR
    if (!trail) PBAR();
#endif
    { auto rr = __builtin_amdgcn_permlane32_swap(__float_as_uint(l_reg), __float_as_uint(l_reg), false, false); l_reg = __uint_as_float(rr[0]) + __uint_as_float(rr[1]); }
    if (hi == 0) li_l[r32] = l_reg; asm volatile("s_waitcnt lgkmcnt(0)" ::: "memory");
    float rli[16];
#pragma unroll
    for (int r = 0; r < 16; ++r) rli[r] = __builtin_amdgcn_rcpf(li_l[crow(r, hi)]);
    if constexpr (EPI == 0) {
        bf16_t* Ow = u.O + (long)(wid * QBLK) * u.ldo + r32; LAUNDER(Ow);
#pragma unroll
        for (int r = 0; r < 16; ++r) { const int orow = crow(r, hi);
#pragma unroll
            for (int d0 = 0; d0 < 4; ++d0) Ow[(long)orow * u.ldo + d0 * 32] = f2bf(o[d0][r] * rli[r]); }
    } else if constexpr (EPI == 1) {
        float* Sw = u.S + (long)(wid * QBLK) * 512 + r32; LAUNDER(Sw);
#pragma unroll
        for (int r = 0; r < 16; ++r) { const int orow = crow(r, hi);
#pragma unroll
            for (int d0 = 0; d0 < 4; ++d0) Sw[(long)orow * 512 + d0 * 32] = o[d0][r] * rli[r]; }
    } else {
        const float* Sw = u.S + (long)(wid * QBLK) * 512 + r32; bf16_t* Ow = u.O + (long)(wid * QBLK) * u.ldo + r32; LAUNDER(Sw); LAUNDER(Ow);
        float gg[4];
#pragma unroll
        for (int d0 = 0; d0 < 4; ++d0) gg[d0] = u.gsub[d0 * 32 + r32] * u.osc;
#pragma unroll
        for (int r = 0; r < 16; ++r) { const int orow = crow(r, hi); float v[4]; float ss = 0.f;
#pragma unroll
            for (int d0 = 0; d0 < 4; ++d0) { v[d0] = Sw[(long)orow * 512 + d0 * 32] - u.lam * (o[d0][r] * rli[r]); ss += v[d0] * v[d0]; }
            ss = half_sum(ss);
            const float rstd = __builtin_amdgcn_rsqf(ss * (1.0f / 128.0f) + EPS);
#pragma unroll
            for (int d0 = 0; d0 < 4; ++d0) Ow[(long)orow * u.ldo + d0 * 32] = f2bf(v[d0] * rstd * gg[d0]); asm volatile("" ::: "memory"); }
    }
    asm volatile("s_waitcnt vmcnt(0) lgkmcnt(0)" ::: "memory");
    __builtin_amdgcn_s_barrier();
    asm volatile("" ::: "memory");
#undef TROW
#undef DMA_TILE
#undef VWAIT
#undef PBAR
}
}

__device__ __forceinline__ int q_pop(unsigned* ctr, char* lds, int tid_) {
    volatile int* slot = (volatile int*)(lds + att::SHM_TOTAL);
    __syncthreads();
    if (tid_ == 0) *slot = (int)__hip_atomic_fetch_add(ctr, 1u, __ATOMIC_RELAXED, __HIP_MEMORY_SCOPE_AGENT);
    __syncthreads();
    return *slot;
}
__device__ __forceinline__ void phase_attn(int wid_k, int l, char* lds, int rep) {
    PHASE_ENTER(cin)
    unsigned* qctr = (unsigned*)(c.ws + WS_CTL + 16384) + (l + 4 * rep) * 256;
    bf16_t* const oa_ = rep ? (bf16_t*)(c.ws + WS_ACT) : c.oa(); bf16_t* const ob_ = oa_ + 1024; bf16_t* const oc_ = oa_ + 1536; float* const ocs_ = rep ? (float*)(c.ws + WS_ACT + (size_t)MT * 2048 * 2) : c.ocs();
    const bool last = (l == DEPTH - 1);
    const float lam = c.lam()[l], osc = 1.0f - (0.8f - 0.6f * expf(-0.3f * (float)l));
    float shA, shB, shC;
    {
        const int lane = tid_ & 63;
        const float mA = 11.313708f * vmax_abs(c.in[I_GQA] + l * 128, 128, lane) * vmax_abs(c.in[I_GKA] + l * 128, 128, lane) * 1.4426950f;
        const float mB = (11.313708f * vmax_abs(c.in[I_GQB] + l * 128, 128, lane) * vmax_abs(c.in[I_GKB] + l * 128, 128, lane) + vmax_abs(c.in[I_RPB] + (size_t)l * 4 * att::BIAS_N, 4 * att::BIAS_N, lane)) * 1.4426950f;
        const float mC = 8.0f * vmax_abs(c.in[I_GQC] + l * 64, 64, lane) * vmax_abs(c.in[I_GKC] + l * 64, 64, lane) * 1.4426950f;
#define SGPR_F(x_) __uint_as_float(__builtin_amdgcn_readfirstlane(__float_as_uint(x_)))
        shA = SGPR_F(fmaxf(0.f, mA - 100.f)); shB = SGPR_F(fmaxf(0.f, mB - 100.f)); shC = SGPR_F(fmaxf(0.f, mC - 100.f));
#undef SGPR_F
    }
    for (;;) {
        const int id = q_pop(qctr + 0, lds, tid_);
        if (id >= 128 + (last ? 0 : 4)) break;
        att::Unit u{}; u.tmask = (rep && MK_ATT_VARIANT == 1) ? 0 : ~0; u.var = rep ? MK_ATT_VARIANT : 0; int head, qrow0;
        if (id < 128) { head = id >> 5; qrow0 = (id & 31) * 256; u.nt = MT / 64; u.key0 = 0; }
        else { head = id - 128; qrow0 = SEQ; u.nt = CTX / 64; u.key0 = SEQ; }
        u.Q = c.P() + (size_t)qrow0 * DIN + C_QC + head * 128; u.K = c.P() + C_KC + head * 128; u.V = c.P() + C_VC + head * 128;
        u.O = oc_ + (size_t)qrow0 * 2048 + head * 128; u.ldo = 2048; u.S = ocs_ + (size_t)qrow0 * 512 + head * 128;
        u.gsub = c.in[I_GSUB] + l * 128; u.lam = lam; u.osc = osc; u.shift = shC;
        if (__builtin_expect(shC != 0.f, 0)) { att::attn_body<4, 0, false, 1, true>(u, lds, tid_); att::attn_body<4, 4, false, 2, true>(u, lds, tid_); }
        else { att::attn_body<4, 0, false, 1, false>(u, lds, tid_); att::attn_body<4, 4, false, 2, false>(u, lds, tid_); }
    }
    for (;;) {
        const int id = q_pop(qctr + 64, lds, tid_);
        if (id >= 256 + (last ? 0 : 12)) break;
        att::Unit u{}; u.tmask = (rep && MK_ATT_VARIANT == 1) ? 0 : ~0; u.var = rep ? MK_ATT_VARIANT : 0;
        if (id < 256) { const int head = id >> 5, qb = id & 31;
            u.Q = c.P() + (size_t)(qb * 256) * DIN + C_QA + head * 128; u.K = c.P() + C_KA + (head >> 2) * 128; u.V = c.P() + C_VA + (head >> 2) * 128;
            u.nt = MT / 64; u.key0 = 0; u.O = oa_ + (size_t)(qb * 256) * 2048 + head * 128; u.ldo = 2048; }
        else if (id < 264) { const int head = id - 256;
            u.Q = c.P() + (size_t)SEQ * DIN + C_QA + head * 128; u.K = c.P() + C_KA + (head >> 2) * 128; u.V = c.P() + C_VA + (head >> 2) * 128;
            u.nt = CTX / 64; u.key0 = SEQ; u.O = oa_ + (size_t)SEQ * 2048 + head * 128; u.ldo = 2048; }
        else { const int head = id - 264;
            u.Q = c.P() + (size_t)SEQ * DIN + C_QB + head * 128; u.K = c.P() + C_KB + head * 128; u.V = c.P() + C_VB + head * 128;
            u.nt = CTX / 64; u.key0 = SEQ; u.O = ob_ + (size_t)SEQ * 2048 + head * 128; u.ldo = 2048; }
        u.shift = id < 264 ? shA : shB;
        if (__builtin_expect(u.shift != 0.f, 0)) att::attn_body<8, 0, false, 0, true>(u, lds, tid_); else att::attn_body<8, 0, false, 0, false>(u, lds, tid_);
        if (!rep && l + 1 < DEPTH && CONV_NATT > 0 && id < 256) { const int ch = q_pop(qctr + 192, lds, tid_of(wid_k));
            if (ch < CONV_NATT / CONV_CHUNK) { __syncthreads(); conv_run(c, lds, tid_of(wid_k), ch * CONV_CHUNK, ch * CONV_CHUNK + CONV_CHUNK, 1, 1, l + 1); } }
    }
    for (;;) {
        const int id = q_pop(qctr + 128, lds, tid_);
        if (id >= 128) break;
        const int head = id >> 5, qb = id & 31, r0 = qb * 4;
        float* bt = (float*)(lds + att::OFF_BIAS);
        for (int i = tid_; i < 2 * att::BIAS_PAD + 480; i += 512) { const int k = i - att::BIAS_PAD; bt[i] = (k >= 0 && k < att::BIAS_N) ? c.in[I_RPB][((size_t)l * 4 + head) * att::BIAS_N + k] * 1.4426950408889634f : 0.f; }
        __syncthreads();
        att::Unit u{}; u.tmask = (rep && MK_ATT_VARIANT == 1) ? 0 : ~0; u.var = rep ? MK_ATT_VARIANT : 0;
        u.Q = c.P() + (size_t)(qb * 256) * DIN + C_QB + head * 128; u.K = c.P() + C_KB + head * 128; u.V = c.P() + C_VB + head * 128;
        u.nt = 16; u.r0 = r0; u.rsA = min(max(r0 - 4, 0), 116);
        u.O = ob_ + (size_t)(qb * 256) * 2048 + head * 128; u.ldo = 2048; u.shift = shB;
        att::attn_body<8, 0, true, 0, true>(u, lds, tid_);
    }
    if (!rep && l + 1 < DEPTH && CONV_NATT > 0) {
        for (;;) {
            const int ch = q_pop(qctr + 192, lds, tid_);
            if (ch >= CONV_NATT / CONV_CHUNK) break;
            __syncthreads();
            conv_run(c, lds, tid_of(wid_k), ch * CONV_CHUNK, ch * CONV_CHUNK + CONV_CHUNK, 1, 1, l + 1);
        }
    }
}

constexpr int PH_PER_LAYER = 10, PH_FINAL = 1 + DEPTH * PH_PER_LAYER, N_PHASES = PH_FINAL + 1;

__global__ void __launch_bounds__(512, 2) fwd(Args a) {
    extern __shared__ __attribute__((aligned(16))) unsigned char lds_raw[];
    char* lds = (char*)lds_raw;
    volatile LAS unsigned* xbw = (volatile LAS unsigned*)(LAS unsigned char*)(lds_raw) + (LDS_BYTES - 16) / 4;
    const int wid_k = __builtin_amdgcn_readfirstlane(threadIdx.x >> 6);
    if (tid_of(wid_k) == 0) { xbw[0] = 0u; xbw[1] = 0u; xbw[2] = 0u; xbw[3] = 0u; }
    __syncthreads();
    const int lo = a.ph_lo, hi = a.ph_hi;
    if (hi - lo > 1) { Ctx c = make_ctx(); (void)xcd_barrier_post((unsigned*)(c.ws + WS_CTL), xbw, tid_of(wid_k)); }
#define IN(k) (lo <= (k) && (k) < hi)
#define SEAM(k) do { if (IN((k) + 1)) { Ctx cb_ = make_ctx(); XcdBarrier b2_; b2_.bar = (unsigned*)(cb_.ws + WS_CTL); b2_.x = xb_xcc_id(); b2_.st = xbw; xcd_barrier(b2_, tid_of(wid_k)); if (MK_PROBE == 10) xcd_barrier(b2_, tid_of(wid_k)); } } while (0)

    if (IN(0)) { phase_prologue(wid_k, lds); if (MK_PROBE == 1) { __syncthreads(); phase_prologue(wid_k, lds); } SEAM(0); }
    for (int l = 0; l < DEPTH; ++l) {
        const int pb = 1 + l * PH_PER_LAYER; const bool lastl = (l == DEPTH - 1);
#define FRESH() Ctx c = make_ctx(); int tid_ = tid_of(wid_k); PG8_LAS unsigned char* ldsL = (PG8_LAS unsigned char*)lds_raw; (void)tid_; (void)ldsL; \
        const bf16_t* wl = c.wt() + (size_t)l * LAYER_ELEMS; const float* modx = c.mod() + ((size_t)l * 2 + 0) * NMOD; const float* modc = c.mod() + ((size_t)l * 2 + 1) * NMOD; (void)wl; (void)modx; (void)modc;
        if (IN(pb + 0)) { phase_norm(wid_k, l, 0); if (MK_PROBE == 4) phase_norm(wid_k, l, 0); SEAM(pb + 0); }
#define FASTG(Aptr, Bptr, MM, NN, KK, EPI) do { pg8::Gemm g_{Aptr, Bptr, MM, NN, KK}; pg8::StaticOrder S_; S_.init(MM, NN, (int)gridDim.x, (int)blockIdx.x); pg8::gemm_phase(ldsL, g_, S_, EPI, tid_); } while (0)
#if MK_FAST_GEMM
        if (IN(pb + 1)) { FRESH(); pg8::EpiWin e{c.P(), c.in[I_GQA] + l * 128, c.in[I_GKA] + l * 128, c.in[I_GQB] + l * 128, c.in[I_GKB] + l * 128, c.in[I_GQC] + l * 64, c.in[I_GKC] + l * 64, (LAS float*)(ldsL + pg8::STAGE_BYTES)};
#if MK_GATE_FP8
            {
                pg8::Gemm gq_{c.u(), wl + O_WIN, MT, C_G, DM}; pg8::StaticOrder Sq_; Sq_.init(MT, C_G, (int)gridDim.x, (int)blockIdx.x); pg8::gemm_phase(ldsL, gq_, Sq_, e, tid_);
                pg8::EpiGate eg{c.P()};
                pg8::Gemm gg_{(const bf16_t*)(c.ws + WS_U8), (const bf16_t*)(c.ws + WS_WG8 + (size_t)l * NGATE * DM), MT, NGATE, DM / 2};
                pg8::GateOrder Sg_; Sg_.init((int)blockIdx.x, (int)gridDim.x); pg8::gemm_phase<pg8::EpiGate, pg8::GateOrder, true>(ldsL, gg_, Sg_, eg, tid_);
            }
#else
            FASTG(c.u(), wl + O_WIN, MT, DIN, DM, e);
#endif
            if (IN(pb + 3)) SEAM(pb + 2); }
#else
        if (IN(pb + 1)) { FRESH(); SEpiWin e{c.R(), c.P()}; simple_gemm(wid_k, c.u(), wl + O_WIN, MT, DIN, DM, e); SEAM(pb + 1); }
#endif
#if !MK_FAST_GEMM
        if (IN(pb + 2)) { phase_qknorm(wid_k, l); SEAM(pb + 2); }
#endif
        if (IN(pb + 3)) { phase_attn(wid_k, l, lds, 0); if (MK_PROBE == 2) { __syncthreads(); phase_attn(wid_k, l, lds, 1); } SEAM(pb + 3); }
        if (IN(pb + 4)) {
            for (int rp_ = 0; rp_ < (MK_PROBE == 7 ? 2 : 1); ++rp_) { FRESH(); pg8::EpiBrChain e{c.mb(), c.P()};
                pg8::StaticOrder S_; S_.init(SEQ, DM, (int)gridDim.x, (int)blockIdx.x); pg8::Unit u_;
                for (int ui_ = 0; S_.next(ui_, u_); ++ui_) {
                    pg8::OneUnit O_{u_}; f32x4 acc_[2][2][4][2];
                    { pg8::Gemm g_{c.oa(), wl + O_BRA, SEQ, DM, 1024, DM, DM}; pg8::gemm_phase_core<pg8::EpiBrChain, pg8::OneUnit, false, true>(ldsL, g_, O_, e, tid_, acc_); }
                    e.scale<0>(acc_, u_, tid_);
                    { pg8::Gemm g_{c.ob(), wl + O_BRA + 1024, SEQ, DM, 512, DM, DM}; pg8::gemm_phase_core<pg8::EpiBrChain, pg8::OneUnit, true, true>(ldsL, g_, O_, e, tid_, acc_); }
                    e.scale<1>(acc_, u_, tid_);
                    { pg8::Gemm g_{c.oc(), wl + O_BRA + 1536, SEQ, DM, 512, DM, DM}; pg8::gemm_phase_core<pg8::EpiBrChain, pg8::OneUnit, true, false>(ldsL, g_, O_, e, tid_, acc_); }
                } }
            if (!lastl) { FRESH(); SEpiBr4 e{c.mb(), c.P()}; slab_gemm5<true>(wid_k, lds, c.oa(), DM, wl + O_BRA, DM, SEQ, CTX, DM, DM, e); }
            SEAM(pb + 4);
        }
#if MK_FAST_GEMM
        if (IN(pb + 5)) { FRESH(); pg8::EpiRes e{l == 0 ? c.in[I_X] : c.h(), modx + 2 * DM, modc + 2 * DM, c.h()}; FASTG(c.mb(), wl + O_WO, SEQ, DM, DM, e); if (MK_PROBE == 8) { pg8::EpiRes e2{c.mf(), modx + 2 * DM, modc + 2 * DM, c.mf()}; FASTG(c.mb(), wl + O_WO, SEQ, DM, DM, e2); }
            if (!lastl) { SEpiRes4 es{c.h(), modx + 2 * DM, modc + 2 * DM, l == 0 ? c.in[I_CTX] - (size_t)SEQ * DM : c.h()}; slab_gemm5<false>(wid_k, lds, c.mb(), DM, wl + O_WO, DM, SEQ, CTX, DM, DM, es); } SEAM(pb + 5); }
#else
        if (IN(pb + 5)) { FRESH(); SEpiRes e{c.h(), modx + 2 * DM, modc + 2 * DM, c.h()}; simple_gemm(wid_k, c.mb(), wl + O_WO, MT, DM, DM, e); SEAM(pb + 5); }
#endif
        if (IN(pb + 6)) { phase_norm(wid_k, l, 1); if (MK_PROBE == 4) phase_norm(wid_k, l, 1); SEAM(pb + 6); }
#if MK_FAST_GEMM
        if (IN(pb + 7)) { FRESH(); pg8::EpiUp e{c.act(), c.edge(), c.in[I_CONVW] + (size_t)l * 3 * DUP, c.in[I_CONVB] + (size_t)l * DUP}; FASTG(c.u(), wl + O_WUP, (lastl ? SEQ : MT), DUP, DM, e); if (MK_PROBE == 6) FASTG(c.u(), wl + O_WUP, (lastl ? SEQ : MT), DUP, DM, e);
            if (!lastl && MK_CONV_NUP > 0) {
                unsigned* fq_ = (unsigned*)(c.ws + WS_CTL + 16384) + l * 256 + 224;
                for (;;) { const int ch = q_pop(fq_, lds, tid_of(wid_k)); if (ch >= MK_CONV_NUP / CONV_CHUNK) break; __syncthreads();
                    conv_run(c, lds, tid_of(wid_k), CONV_NATT + ch * CONV_CHUNK, CONV_NATT + ch * CONV_CHUNK + CONV_CHUNK, 1, 1, l + 1); } }
            SEAM(pb + 7); }
#else
        if (IN(pb + 7)) { FRESH(); SEpiY e{c.Y()}; simple_gemm(wid_k, c.u(), wl + O_WUP, MT, DUP, DM, e); SEAM(pb + 7); }
#endif
#if MK_FAST_GEMM
        if (IN(pb + 8)) { phase_convfix(wid_k, l); if (MK_PROBE == 3) phase_convfix(wid_k, l); SEAM(pb + 8); }
#else
        if (IN(pb + 8)) { phase_conv(wid_k, l); SEAM(pb + 8); }
#endif
#if MK_FAST_GEMM
        if (IN(pb + 9)) { FRESH(); pg8::EpiRes e{c.h(), modx + 5 * DM, modc + 5 * DM, lastl ? c.out : c.h()}; FASTG(c.act(), wl + O_WDN, SEQ, DM, DFF, e); if (MK_PROBE == 9) { pg8::EpiRes e2{c.mf(), modx + 5 * DM, modc + 5 * DM, c.mf()}; FASTG(c.act(), wl + O_WDN, SEQ, DM, DFF, e2); }
            if (!lastl) { SEpiRes4 es{c.h(), modx + 5 * DM, modc + 5 * DM, c.h()}; slab_gemm5<false>(wid_k, lds, c.act(), DFF, wl + O_WDN, DFF, SEQ, CTX, DM, DFF, es); SEAM(pb + 9); } }
#else
        if (IN(pb + 9)) { FRESH(); SEpiRes e{c.h(), modx + 5 * DM, modc + 5 * DM, c.h()}; simple_gemm(wid_k, c.act(), wl + O_WDN, MT, DM, DFF, e); SEAM(pb + 9); }
#endif
#undef FASTG
#undef FRESH
    }
#if !MK_FAST_GEMM
    if (IN(PH_FINAL)) phase_copy_out(wid_k);
#endif
#undef IN
#undef SEAM
}

extern "C" void kernel_launch(void* const* d_in, const int* in_sizes, int n_in, void* d_out, int out_size, void* d_ws, size_t ws_size, hipStream_t stream) {
    static int grid = 0;
    if (grid == 0) {
        if (n_in != 29 || out_size != SEQ * DM || ws_size < WS_END) { fprintf(stderr, "kernel_launch: unexpected shapes: n_in %d out %d ws %zu (need %zu)\n", n_in, out_size, ws_size, (size_t)WS_END); grid = -1; return; }
        int dev = 0, cus = 0, per_cu = 0;
        if (hipGetDevice(&dev) != hipSuccess || hipDeviceGetAttribute(&cus, hipDeviceAttributeMultiprocessorCount, dev) != hipSuccess) { grid = -1; return; }
        if (hipFuncSetAttribute((const void*)fwd, hipFuncAttributeMaxDynamicSharedMemorySize, LDS_BYTES) != hipSuccess) { fprintf(stderr, "kernel_launch: hipFuncSetAttribute failed\n"); grid = -1; return; }
        if (hipOccupancyMaxActiveBlocksPerMultiprocessor(&per_cu, (const void*)fwd, 512, LDS_BYTES) != hipSuccess || per_cu < 1) fprintf(stderr, "kernel_launch: occupancy query reports %d\n", per_cu);
        (void)hipGetLastError();
        grid = cus;
    }
    if (grid < 0) return;
    (void)hipMemsetAsync((char*)d_ws + WS_CTL, 0, CTL_BYTES, stream);
    Args a{};
    for (int i = 0; i < 29; ++i) a.in[i] = (const float*)d_in[i];
    a.out = (float*)d_out; a.ws = (unsigned char*)d_ws;
#if MK_ONE_LAUNCH
    a.ph_lo = 0; a.ph_hi = N_PHASES;
    hipLaunchKernelGGL(fwd, dim3(grid), dim3(512), LDS_BYTES, stream, a);
#else
    for (int p = 0; p < N_PHASES; ++p) { a.ph_lo = p; a.ph_hi = p + 1; hipLaunchKernelGGL(fwd, dim3(grid), dim3(512), LDS_BYTES, stream, a); }
#endif
    const hipError_t le = hipPeekAtLastError();
    if (le != hipSuccess) fprintf(stderr, "kernel_launch: launch failed: %s\n", hipGetErrorName(le));
}
```

```cpp
#include <hip/hip_runtime.h>
#include <cstdio>
#include <cstdint>
#include <cstddef>

#define LAS __attribute__((address_space(3)))
typedef unsigned short bf16_t;
typedef short bf16x8 __attribute__((ext_vector_type(8)));
typedef short s16x4 __attribute__((ext_vector_type(4)));
typedef float f32x4 __attribute__((ext_vector_type(4)));
typedef float f32x16 __attribute__((ext_vector_type(16)));
typedef unsigned u32x4 __attribute__((ext_vector_type(4)));
typedef unsigned u32x2 __attribute__((ext_vector_type(2)));

#ifndef MK_FAST_GEMM
#define MK_FAST_GEMM 1
#endif
#ifndef MK_PROBE
#define MK_PROBE 0
#endif
#ifndef MK_ATT_VARIANT
#define MK_ATT_VARIANT 0
#endif
#ifndef MK_GATE_FP8
#define MK_GATE_FP8 1
#endif
#ifndef MK_ATT_1BAR
#define MK_ATT_1BAR 1
#endif
#ifndef MK_ONE_LAUNCH
#define MK_ONE_LAUNCH 1
#endif

constexpr int DM = 2048, SEQ = 8192, CTX = 256, MT = SEQ + CTX, DEPTH = 4;
constexpr int DIN = 10752, DFF = 5504, DUP = 2 * DFF, NMOD = 6 * DM;
constexpr int RW = 3328;
constexpr int C_QA = 0, C_KA = 1024, C_VA = 1280, C_QB = 1536, C_KB = 2048, C_VB = 2560, C_QC = 3072, C_KC = 3584, C_VC = 4096, C_G = 4608;
constexpr float EPS = 1e-6f;

constexpr size_t O_WIN = 0, O_BRA = O_WIN + (size_t)DIN * DM, O_BRB = O_BRA + (size_t)DM * 1024, O_BRC = O_BRB + (size_t)DM * 512,
                 O_WO = O_BRC + (size_t)DM * 512, O_WUP = O_WO + (size_t)DM * DM, O_WDN = O_WUP + (size_t)DUP * DM, LAYER_ELEMS = O_WDN + (size_t)DM * DFF;

constexpr size_t al256(size_t x) { return (x + 255) / 256 * 256; }
constexpr size_t WS_CTL = 0, CTL_BYTES = 65536;
constexpr size_t WS_MOD = WS_CTL + CTL_BYTES;
constexpr size_t WS_LAM = al256(WS_MOD + (size_t)DEPTH * 2 * NMOD * 4);
constexpr size_t WS_H = al256(WS_LAM + 256);
constexpr size_t WS_U = al256(WS_H + (size_t)MT * DM * 4);
constexpr size_t WS_WT = al256(WS_U + (size_t)MT * DM * 2);
constexpr size_t WS_P = al256(WS_WT + (size_t)DEPTH * LAYER_ELEMS * 2);
constexpr size_t WS_R = al256(WS_P + (size_t)MT * DIN * 2);
constexpr size_t WS_U8 = WS_R;
constexpr size_t WS_WG8 = al256(WS_U8 + (size_t)MT * DM);
constexpr int NGATE = 3 * DM;
static_assert(WS_WG8 + (size_t)DEPTH * NGATE * DM <= WS_R + (size_t)MT * RW * 4, "fp8 buffers fit the R region");
constexpr size_t WS_OA = al256(WS_R + (size_t)MT * RW * 4);
constexpr size_t WS_OB = al256(WS_OA + (size_t)MT * 1024 * 2);
constexpr size_t WS_OC = al256(WS_OB + (size_t)MT * 512 * 2);
constexpr size_t WS_OCS = al256(WS_OC + (size_t)MT * 512 * 2);
constexpr size_t WS_MF = al256(WS_OCS + (size_t)MT * 512 * 4);
constexpr size_t WS_MB = al256(WS_MF + (size_t)MT * DM * 4);
constexpr size_t WS_PEND = al256(WS_MB + (size_t)MT * DM * 2);
constexpr size_t WS_Y = WS_P;
static_assert(WS_Y + (size_t)MT * DUP * 4 <= WS_PEND, "Y alias");
constexpr int NBLK64 = MT / 64;
constexpr size_t WS_EDGE = WS_P;
constexpr size_t WS_ACT = WS_PEND;
constexpr size_t WS_END = al256(WS_ACT + (size_t)MT * DFF * 2);

constexpr int LDS_BYTES = 147456;

__device__ __forceinline__ unsigned cvt_pk_bf16(float lo, float hi) { unsigned r; asm volatile("s_nop 0\n\tv_cvt_pk_bf16_f32 %0, %1, %2" : "=v"(r) : "v"(lo), "v"(hi)); return r; }
__device__ __forceinline__ bf16_t f2bf(float x) { return (bf16_t)(cvt_pk_bf16(x, 0.f) & 0xffffu); }
__device__ __forceinline__ float sat8(float x) { return __builtin_amdgcn_fmed3f(x, -448.0f, 448.0f); }
__device__ __forceinline__ unsigned pk4_fp8(float a, float b, float c, float d) { unsigned w = __builtin_amdgcn_cvt_pk_fp8_f32(sat8(a), sat8(b), 0u, false); return __builtin_amdgcn_cvt_pk_fp8_f32(sat8(c), sat8(d), w, true); }
__device__ __forceinline__ float bf2f(bf16_t b) { return __uint_as_float(((unsigned)b) << 16); }
template <int O> __device__ __forceinline__ float swz_xor(float v) { return __int_as_float(__builtin_amdgcn_ds_swizzle(__float_as_int(v), (O << 10) | 0x1f)); }
__device__ __forceinline__ float half_sum(float v) { v += swz_xor<16>(v); v += swz_xor<8>(v); v += swz_xor<4>(v); v += swz_xor<2>(v); v += swz_xor<1>(v); return v; }
__device__ __forceinline__ float wave_sum(float v) {
    v = half_sum(v);
    auto rr = __builtin_amdgcn_permlane32_swap(__float_as_uint(v), __float_as_uint(v), false, false);
    return __uint_as_float(rr[0]) + __uint_as_float(rr[1]);
}
__device__ __forceinline__ float wave_max(float v) {
    v = fmaxf(v, swz_xor<16>(v)); v = fmaxf(v, swz_xor<8>(v)); v = fmaxf(v, swz_xor<4>(v)); v = fmaxf(v, swz_xor<2>(v)); v = fmaxf(v, swz_xor<1>(v));
    auto rr = __builtin_amdgcn_permlane32_swap(__float_as_uint(v), __float_as_uint(v), false, false);
    return fmaxf(__uint_as_float(rr[0]), __uint_as_float(rr[1]));
}
__device__ __forceinline__ float vmax_abs(const float* v, int n, int lane) {
    float m = 0.f; for (int i = lane; i < n; i += 64) m = fmaxf(m, fabsf(v[i]));
    return __uint_as_float(__builtin_amdgcn_readfirstlane(__float_as_uint(wave_max(m))));
}
__device__ __forceinline__ float siluf(float x) { return x * __builtin_amdgcn_rcpf(1.0f + __builtin_amdgcn_exp2f(x * -1.4426950408889634f)); }
__device__ __forceinline__ float sigmoidf(float x) { return __builtin_amdgcn_rcpf(1.0f + __builtin_amdgcn_exp2f(x * -1.4426950408889634f)); }

__device__ __forceinline__ int tid_of(int wid_k) { int z; asm volatile("s_mov_b32 %0, 0" : "=s"(z)); return wid_k * 64 + (int)__builtin_amdgcn_mbcnt_hi(~0u, __builtin_amdgcn_mbcnt_lo(~0u, (unsigned)z)); }

#define XB_TMO      128
#define XB_XCNT(j)  (256  + 64 * (j))
#define XB_XSUB(j)  (1280 + 64 * (j))
#define XB_XGEN(j)  (2304 + 64 * (j))
#define XB_TOP      3328
#define XB_TOPGEN   3392
#define XCD_BAR_WORDS 3456
#define XB_SPIN_CAP (1u << 18)
__device__ __forceinline__ unsigned xb_ld(unsigned* p)              { return __hip_atomic_load(p, __ATOMIC_RELAXED, __HIP_MEMORY_SCOPE_AGENT); }
__device__ __forceinline__ unsigned xb_add(unsigned* p, unsigned v) { return __hip_atomic_fetch_add(p, v, __ATOMIC_RELAXED, __HIP_MEMORY_SCOPE_AGENT); }
__device__ __forceinline__ unsigned xb_xcc_id() { return (unsigned)__builtin_amdgcn_s_getreg((3 << 11) | 20) & 0xFu; }
#define XB_SPIN(cond, bar) do { unsigned _sp = 0; while (cond) { __builtin_amdgcn_s_sleep(1); \
    if ((++_sp & 255u) == 0u) { if (xb_ld(&(bar)[XB_TMO])) break; if (_sp > XB_SPIN_CAP) { atomicAdd(&(bar)[XB_TMO], 1u); break; } } } } while (0)
struct XcdBarrier { unsigned* bar; unsigned x; volatile LAS unsigned* st; };
__device__ __forceinline__ XcdBarrier xcd_barrier_post(unsigned* bar, volatile LAS unsigned* st, int tid) {
    XcdBarrier b; b.bar = bar; b.x = xb_xcc_id(); b.st = st;
    if (tid == 0) (void)xb_add(&bar[XB_XCNT(b.x)], 1u);
    return b;
}
__device__ __forceinline__ void xcd_barrier_complete(unsigned* bar, unsigned x, unsigned& nloc, unsigned& nx) {
    const unsigned G = gridDim.x * gridDim.y * gridDim.z;
    unsigned sum, cnt, mine, sp = 0u;
    for (;;) {
        sum = 0u; cnt = 0u; mine = 0u;
#pragma unroll
        for (unsigned j = 0; j < 16; ++j) { const unsigned c = xb_ld(&bar[XB_XCNT(j)]); sum += c; cnt += (c > 0u) ? 1u : 0u; }
        mine = xb_ld(&bar[XB_XCNT(x)]);
        if (sum == G) break;
        __builtin_amdgcn_s_sleep(1);
        if ((++sp & 255u) == 0u) { if (xb_ld(&bar[XB_TMO])) break; if (sp > XB_SPIN_CAP) { atomicAdd(&bar[XB_TMO], 1u); break; } }
    }
    nloc = mine > 0u ? mine : 1u; nx = cnt > 0u ? cnt : 1u;
}
__device__ __forceinline__ void xcd_barrier(const XcdBarrier& b, int tid) {
    asm volatile("s_waitcnt vmcnt(0)" ::: "memory");
    __syncthreads();
    if (tid == 0) {
        unsigned* bar = b.bar;
        __builtin_amdgcn_s_waitcnt(0);
        unsigned nloc = b.st[0], nx = b.st[1];
        if (nloc == 0u) { xcd_barrier_complete(bar, b.x, nloc, nx); b.st[0] = nloc; b.st[1] = nx; }
        const unsigned old = xb_add(&bar[XB_XSUB(b.x)], 1u);
        const unsigned gen = old / nloc;
        if (old + 1u == (gen + 1u) * nloc) {
            __builtin_amdgcn_fence(__ATOMIC_RELEASE, "agent");
            asm volatile("s_waitcnt vmcnt(0)" ::: "memory");
            const unsigned og = xb_add(&bar[XB_TOP], 1u);
            const unsigned tg = og / nx;
            if (og + 1u == (tg + 1u) * nx) xb_add(&bar[XB_TOPGEN], 1u);
            else XB_SPIN(xb_ld(&bar[XB_TOPGEN]) == tg, bar);
            __builtin_amdgcn_fence(__ATOMIC_ACQUIRE, "agent");
            xb_add(&bar[XB_XGEN(b.x)], 1u);
            asm volatile("s_waitcnt vmcnt(0)" ::: "memory");
        } else {
            XB_SPIN(xb_ld(&bar[XB_XGEN(b.x)]) == gen, bar);
            __builtin_amdgcn_fence(__ATOMIC_ACQUIRE, "agent");
            asm volatile("s_waitcnt vmcnt(0)" ::: "memory");
        }
    }
    __syncthreads();
}

template <class T> __device__ __forceinline__ T* launder_uniform(T* p) {
    const unsigned long long v = (unsigned long long)p; unsigned lo = (unsigned)v, hi = (unsigned)(v >> 32);
    asm volatile("" : "+v"(lo), "+v"(hi));
    lo = __builtin_amdgcn_readfirstlane(lo); hi = __builtin_amdgcn_readfirstlane(hi);
    return (T*)(((unsigned long long)hi << 32) | lo);
}
struct Args { const float* in[29]; float* out; unsigned char* ws; int ph_lo, ph_hi; };
enum { I_X = 0, I_C, I_CTX, I_CCTX, I_WMOD, I_BMOD, I_GN1, I_WIN, I_GQA, I_GKA, I_GQB, I_GKB, I_RPB, I_GQC, I_GKC, I_LQ1, I_LK1, I_LQ2, I_LK2, I_GSUB,
       I_WBRA, I_WBRB, I_WBRC, I_WO, I_GN2, I_WUP, I_CONVW, I_CONVB, I_WDN };
struct Ctx {
    const float* const* in; float* out; unsigned char* ws;
    __device__ __forceinline__ float* mod() const { return (float*)(ws + WS_MOD); }
    __device__ __forceinline__ float* lam() const { return (float*)(ws + WS_LAM); }
    __device__ __forceinline__ float* h() const { return (float*)(ws + WS_H); }
    __device__ __forceinline__ bf16_t* u() const { return (bf16_t*)(ws + WS_U); }
    __device__ __forceinline__ bf16_t* wt() const { return (bf16_t*)(ws + WS_WT); }
    __device__ __forceinline__ bf16_t* P() const { return (bf16_t*)(ws + WS_P); }
    __device__ __forceinline__ float* R() const { return (float*)(ws + WS_R); }
    __device__ __forceinline__ bf16_t* oa() const { return (bf16_t*)(ws + WS_OA); }
    __device__ __forceinline__ bf16_t* ob() const { return (bf16_t*)(ws + WS_OA) + 1024; }
    __device__ __forceinline__ bf16_t* oc() const { return (bf16_t*)(ws + WS_OA) + 1536; }
    __device__ __forceinline__ float* ocs() const { return (float*)(ws + WS_OCS); }
    __device__ __forceinline__ float* mf() const { return (float*)(ws + WS_MF); }
    __device__ __forceinline__ bf16_t* mb() const { return (bf16_t*)(ws + WS_MB); }
    __device__ __forceinline__ float* Y() const { return (float*)(ws + WS_Y); }
    __device__ __forceinline__ float* edge() const { return (float*)(ws + WS_EDGE); }
    __device__ __forceinline__ bf16_t* act() const { return (bf16_t*)(ws + WS_ACT); }
};
__device__ __forceinline__ unsigned long long kernarg_u64(int off) {
    unsigned long long v; auto kp = __builtin_amdgcn_kernarg_segment_ptr();
    asm volatile("s_load_dwordx2 %0, %1, %2\n\ts_waitcnt lgkmcnt(0)" : "=s"(v) : "s"(kp), "i"(off));
    return v;
}
__device__ __forceinline__ Ctx make_ctx() {
    Ctx c; c.in = (const float* const*)__builtin_amdgcn_kernarg_segment_ptr();
    c.out = (float*)kernarg_u64(29 * 8); c.ws = (unsigned char*)kernarg_u64(30 * 8);
    return c;
}
#define PHASE_ENTER(cin) Ctx c = make_ctx(); int tid_ = tid_of(wid_k);

__device__ __forceinline__ int win_src_col(int j) {
    if (j < C_VA) { const int s = j & 127, hb = j - s, grp = s >> 6, sp = s & 63, i = sp >> 3, jj = sp & 7; return hb + 64 * grp + (jj < 4 ? 4 * i + jj : 32 + 4 * i + (jj - 4)); }
    if (j >= C_QC && j < C_VC) { const int s = j & 63, hb = j - s, grp = s >> 5, sp = s & 31, i = sp >> 3, jj = sp & 7; return hb + 32 * grp + (jj < 4 ? 4 * i + jj : 16 + 4 * i + (jj - 4)); }
    return j;
}
__device__ __forceinline__ int wup_src_col(int j) { const int pn = j >> 8, bj = (j >> 7) & 1, s = j & 127; return bj * DFF + 128 * pn + s; }

constexpr int T_WIN = (DIN / 256) * (DM / 64), T_BRA = (DM / 256) * (1024 / 64), T_BRB = (DM / 256) * (512 / 64), T_WO = (DM / 256) * (DM / 64), T_WUP = (DUP / 256) * (DM / 64), T_WDN = (DM / 256) * (DFF / 64);
constexpr int T_LAYER = T_WIN + T_BRA + 2 * T_BRB + T_WO + T_WUP + T_WDN;
#ifndef MK_CONV_NDEF
#define MK_CONV_NDEF 3848
#endif
#ifndef MK_CONV_NUP
#define MK_CONV_NUP 1536
#endif
constexpr int CONV_NDEF = MK_CONV_NDEF, CONV_CHUNK = 8, CONV_NP = T_LAYER + (DEPTH - 1) * (T_LAYER - CONV_NDEF), CONV_NATT = CONV_NDEF - MK_CONV_NUP;
static_assert(MK_CONV_NUP >= 0 && MK_CONV_NUP <= MK_CONV_NDEF && MK_CONV_NUP % 8 == 0, "w_up share of the deferred tiles");
static_assert(CONV_NDEF >= 0 && CONV_NDEF < T_LAYER && CONV_NDEF % CONV_CHUNK == 0, "deferred tile count");
__device__ __forceinline__ void conv_run(const Ctx& c, char* lds, int tid, int p0, int pend, int pstep, int mode, int L) {
        asm volatile("" : "+v"(tid));
        float* tile = (float*)lds;
        struct WD { const float* src; bf16_t* dst; int K, N, kind, ldd, l, j0, k0; };
#define WDEC(t_, d_) do { const int l_ = (t_) / T_LAYER; int r_ = (t_) % T_LAYER; bf16_t* wl_ = c.wt() + (size_t)l_ * LAYER_ELEMS; d_.l = l_; d_.kind = 0; d_.ldd = 0; \
            if (r_ < T_WIN) { d_.src = c.in[I_WIN] + (size_t)l_ * DM * DIN; d_.dst = wl_ + O_WIN; d_.K = DM; d_.N = DIN; d_.kind = 1; } \
            else if ((r_ -= T_WIN) < T_BRA) { d_.src = c.in[I_WBRA] + (size_t)l_ * 1024 * DM; d_.dst = wl_ + O_BRA; d_.K = 1024; d_.N = DM; d_.ldd = DM; }             \
            else if ((r_ -= T_BRA) < T_BRB) { d_.src = c.in[I_WBRB] + (size_t)l_ * 512 * DM; d_.dst = wl_ + O_BRA + 1024; d_.K = 512; d_.N = DM; d_.ldd = DM; }      \
            else if ((r_ -= T_BRB) < T_BRB) { d_.src = c.in[I_WBRC] + (size_t)l_ * 512 * DM; d_.dst = wl_ + O_BRA + 1536; d_.K = 512; d_.N = DM; d_.ldd = DM; }      \
            else if ((r_ -= T_BRB) < T_WO) { d_.src = c.in[I_WO] + (size_t)l_ * DM * DM; d_.dst = wl_ + O_WO; d_.K = DM; d_.N = DM; } \
            else if ((r_ -= T_WO) < T_WUP) { d_.src = c.in[I_WUP] + (size_t)l_ * DM * DUP; d_.dst = wl_ + O_WUP; d_.K = DM; d_.N = DUP; d_.kind = 2; } \
            else { r_ -= T_WUP; d_.src = c.in[I_WDN] + (size_t)l_ * DFF * DM; d_.dst = wl_ + O_WDN; d_.K = DFF; d_.N = DM; } \
            const int nkt_ = d_.K / 64; d_.j0 = (r_ / nkt_) * 256; d_.k0 = (r_ % nkt_) * 64; } while (0)
#define WLOAD(d_) do { _Pragma("unroll") for (int s = 0; s < 4; ++s) { const int j = d_.j0 + 64 * s + j4; const int sc = d_.kind == 1 ? win_src_col(j) : (d_.kind == 2 ? wup_src_col(j) : j); \
            _Pragma("unroll") for (int i = 0; i < 2; ++i) v[s][i] = *(const f32x4*)(d_.src + (size_t)(d_.k0 + (tid >> 4) + 32 * i) * d_.N + sc); } } while (0)
        const int j4 = (tid & 15) * 4; f32x4 v[4][2];
#define TMAP(p_) (mode ? L * T_LAYER + (p_) : ((p_) < T_LAYER ? (p_) : (1 + ((p_) - T_LAYER) / (T_LAYER - CONV_NDEF)) * T_LAYER + CONV_NDEF + ((p_) - T_LAYER) % (T_LAYER - CONV_NDEF)))
        WD cur, nxt; int p = p0;
        if (p < pend) { const int t = TMAP(p); WDEC(t, cur); WLOAD(cur); }
        for (; p < pend; p += pstep) {
#pragma unroll
            for (int s = 0; s < 4; ++s)
#pragma unroll
                for (int i = 0; i < 2; ++i) { float* tp = tile + s * (64 * 65) + ((tid >> 4) + 32 * i) * 65 + j4; tp[0] = v[s][i][0]; tp[1] = v[s][i][1]; tp[2] = v[s][i][2]; tp[3] = v[s][i][3]; }
            __syncthreads();
            nxt = cur;
            if (p + pstep < pend) { const int t = TMAP(p + pstep); WDEC(t, nxt); WLOAD(nxt); }
            {
                const int jj = tid >> 3, kk = (tid & 7) * 8;
#pragma unroll
                for (int s = 0; s < 4; ++s) { const float* ts = tile + s * (64 * 65);
                    if (MK_GATE_FP8 && MK_FAST_GEMM && cur.kind == 1 && cur.j0 + 64 * s >= C_G) {
                        u32x2 w8;
                        w8.x = pk4_fp8(ts[(kk + 0) * 65 + jj] * 32.f, ts[(kk + 1) * 65 + jj] * 32.f, ts[(kk + 2) * 65 + jj] * 32.f, ts[(kk + 3) * 65 + jj] * 32.f);
                        w8.y = pk4_fp8(ts[(kk + 4) * 65 + jj] * 32.f, ts[(kk + 5) * 65 + jj] * 32.f, ts[(kk + 6) * 65 + jj] * 32.f, ts[(kk + 7) * 65 + jj] * 32.f);
                        *(u32x2*)(c.ws + WS_WG8 + ((size_t)cur.l * NGATE + (cur.j0 + 64 * s + jj - C_G)) * DM + cur.k0 + kk) = w8;
                        continue; }
                    u32x4 w;
                    w.x = cvt_pk_bf16(ts[(kk + 0) * 65 + jj], ts[(kk + 1) * 65 + jj]); w.y = cvt_pk_bf16(ts[(kk + 2) * 65 + jj], ts[(kk + 3) * 65 + jj]);
                    w.z = cvt_pk_bf16(ts[(kk + 4) * 65 + jj], ts[(kk + 5) * 65 + jj]); w.w = cvt_pk_bf16(ts[(kk + 6) * 65 + jj], ts[(kk + 7) * 65 + jj]);
                    *(u32x4*)(cur.dst + (size_t)(cur.j0 + 64 * s + jj) * (cur.ldd ? cur.ldd : cur.K) + cur.k0 + kk) = w; }
            }
            __syncthreads();
            cur = nxt;
        }
#undef WDEC
#undef WLOAD
#undef TMAP
}

__device__ __forceinline__ void phase_prologue(int wid_k, char* lds) {
    PHASE_ENTER(cin)
    const int tid = tid_, lane = tid & 63, wid = tid >> 6, G = gridDim.x, b = blockIdx.x;
    if (!MK_FAST_GEMM) {
        const f32x4* x4 = (const f32x4*)c.in[I_X]; const f32x4* c4 = (const f32x4*)c.in[I_CTX]; f32x4* h4 = (f32x4*)c.h();
        const size_t nx = (size_t)SEQ * DM / 4, nc = (size_t)CTX * DM / 4;
        for (size_t i = (size_t)b * 512 + tid; i < nx + nc; i += (size_t)G * 512) h4[i] = i < nx ? x4[i] : c4[i - nx];
    }
    if (b == 0 && wid < DEPTH) {
        const int l = wid;
        const float p1 = wave_sum(c.in[I_LQ1][l * 64 + lane] * c.in[I_LK1][l * 64 + lane]);
        const float p2 = wave_sum(c.in[I_LQ2][l * 64 + lane] * c.in[I_LK2][l * 64 + lane]);
        if (lane == 0) c.lam()[l] = expf(p1) - expf(p2) + (0.8f - 0.6f * expf(-0.3f * (float)l));
    }
    {
        float* sc0 = (float*)lds; float* sc1 = sc0 + DM; float* part = sc1 + DM;
        for (int k = tid; k < DM; k += 512) { sc0[k] = siluf(c.in[I_C][k]); sc1[k] = siluf(c.in[I_CCTX][k]); }
        __syncthreads();
        for (int blk = b; blk < DEPTH * NMOD / 64; blk += G) {
            const int l = blk / (NMOD / 64), j = (blk % (NMOD / 64)) * 64 + lane;
            const float* w = c.in[I_WMOD] + (size_t)l * DM * NMOD + j;
            float a0 = 0.f, a1 = 0.f;
            const int kb = wid * 256;
#pragma unroll 32
            for (int k = 0; k < 256; ++k) { const float wv = w[(size_t)(kb + k) * NMOD]; a0 += sc0[kb + k] * wv; a1 += sc1[kb + k] * wv; }
            part[(wid * 64 + lane) * 2 + 0] = a0; part[(wid * 64 + lane) * 2 + 1] = a1;
            __syncthreads();
            if (wid < 2) {
                float s = c.in[I_BMOD][l * NMOD + j];
#pragma unroll
                for (int w8 = 0; w8 < 8; ++w8) s += part[(w8 * 64 + lane) * 2 + wid];
                c.mod()[((size_t)l * 2 + wid) * NMOD + j] = s;
            }
            __syncthreads();
        }
    }
    conv_run(c, lds, tid, b, CONV_NP, G, 0, 0);
}

__device__ __forceinline__ void phase_norm(int wid_k, int l, int which) {
    PHASE_ENTER(cin)
    const int lane = tid_ & 63, wid = tid_ >> 6;
    const float* g = c.in[which ? I_GN2 : I_GN1] + l * DM;
#define NORM_ROWPTR(r_) ((MK_FAST_GEMM && l == 0 && which == 0) ? ((r_) < SEQ ? c.in[I_X] + (size_t)(r_) * DM : c.in[I_CTX] + (size_t)((r_) - SEQ) * DM) : c.h() + (size_t)(r_) * DM)
    const int row0 = blockIdx.x * 8 + wid, rstep = gridDim.x * 8;
    f32x4 v[8], vn[8];
    if (row0 < MT) { const float* hr = NORM_ROWPTR(row0);
#pragma unroll
        for (int i = 0; i < 8; ++i) v[i] = *(const f32x4*)(hr + i * 256 + lane * 4); }
    for (int row = row0; row < MT; row += rstep) {
        if (row + rstep < MT) { const float* hn = NORM_ROWPTR(row + rstep);
#pragma unroll
            for (int i = 0; i < 8; ++i) vn[i] = *(const f32x4*)(hn + i * 256 + lane * 4); }
        const float* md = c.mod() + ((size_t)l * 2 + (row >= SEQ ? 1 : 0)) * NMOD;
        const float* sh = md + (which ? 3 : 0) * DM; const float* sc = md + (which ? 4 : 1) * DM;
        float ss = 0.f;
#pragma unroll
        for (int i = 0; i < 8; ++i) ss += v[i][0] * v[i][0] + v[i][1] * v[i][1] + v[i][2] * v[i][2] + v[i][3] * v[i][3];
        ss = wave_sum(ss);
        const float rstd = __builtin_amdgcn_rsqf(ss * (1.0f / DM) + EPS);
#pragma unroll
        for (int i = 0; i < 8; ++i) {
            const int col = i * 256 + lane * 4;
            const f32x4 gg = *(const f32x4*)(g + col), s1 = *(const f32x4*)(sc + col), s0 = *(const f32x4*)(sh + col);
            f32x4 o;
#pragma unroll
            for (int e = 0; e < 4; ++e) o[e] = (v[i][e] * rstd * gg[e]) * (1.0f + s1[e]) + s0[e];
            u32x2 w; w.x = cvt_pk_bf16(o[0], o[1]); w.y = cvt_pk_bf16(o[2], o[3]);
            *(u32x2*)(c.u() + (size_t)row * DM + col) = w;
            if (MK_GATE_FP8 && MK_FAST_GEMM && which == 0) *(unsigned*)(c.ws + WS_U8 + (size_t)row * DM + col) = pk4_fp8(o[0], o[1], o[2], o[3]);
        }
#pragma unroll
        for (int i = 0; i < 8; ++i) v[i] = vn[i];
    }
#undef NORM_ROWPTR
}

__device__ __forceinline__ void rope_cs(float pos, int f, float inv_nf, float& cs, float& sn) {
    const float inv = __builtin_amdgcn_exp2f(-(float)f * inv_nf * 13.287712379549449f);
    const float ang = pos * inv;
    float rev = ang * 0.15915494309189535f; rev -= floorf(rev);
    cs = __builtin_amdgcn_cosf(rev); sn = __builtin_amdgcn_sinf(rev);
}
__device__ __forceinline__ void phase_qknorm(int wid_k, int l) {
    PHASE_ENTER(cin)
    const int lane = tid_ & 63, wid = tid_ >> 6;
    const int i = lane >> 2, j = lane & 3;
    const long nitems = (long)MT * 26;
    for (long it = (long)blockIdx.x * 8 + wid; it < nitems; it += (long)gridDim.x * 8) {
        const int row = (int)(it / 26), g = (int)(it % 26);
        const int rc = g * 128, pc = rc < 1280 ? rc : (rc < 2304 ? rc + 256 : rc + 768);
        const float* rp = c.R() + (size_t)row * RW + rc;
        const float x1 = rp[8 * i + j], x2 = rp[8 * i + 4 + j];
        float ss = x1 * x1 + x2 * x2;
        int type; const float* gv;
        if (g < 8) { type = 0; gv = c.in[I_GQA] + l * 128; } else if (g < 10) { type = 0; gv = c.in[I_GKA] + l * 128; }
        else if (g < 14) { type = 1; gv = c.in[I_GQB] + l * 128; } else if (g < 18) { type = 1; gv = c.in[I_GKB] + l * 128; }
        else if (g < 22) { type = 2; gv = c.in[I_GQC] + l * 64; } else { type = 2; gv = c.in[I_GKC] + l * 64; }
        ss = half_sum(ss);
        if (type != 2) { auto rr = __builtin_amdgcn_permlane32_swap(__float_as_uint(ss), __float_as_uint(ss), false, false); ss = __uint_as_float(rr[0]) + __uint_as_float(rr[1]); }
        const float rstd = 1.0f / sqrtf(ss * (type == 2 ? 1.0f / 64.0f : 1.0f / 128.0f) + EPS);
        float y1, y2;
        if (type == 1) { y1 = x1 * rstd * gv[8 * i + j]; y2 = x2 * rstd * gv[8 * i + 4 + j]; }
        else {
            int d1, d2, f; float inv_nf; int grp;
            if (type == 0) { grp = i >> 3; f = 4 * (i & 7) + j; d1 = 64 * grp + f; d2 = d1 + 32; inv_nf = 1.0f / 32.0f; }
            else { const int ip = i & 7; grp = ip >> 2; f = 4 * (ip & 3) + j; d1 = 32 * grp + f; d2 = d1 + 16; inv_nf = 1.0f / 16.0f; }
            y1 = x1 * rstd * gv[d1]; y2 = x2 * rstd * gv[d2];
            if (row < SEQ) {
                const float pos = (float)(grp ? (row & 63) : (row >> 6));
                float cs, sn; rope_cs(pos, f, inv_nf, cs, sn);
                const float o1 = y1 * cs - y2 * sn, o2 = y2 * cs + y1 * sn; y1 = o1; y2 = o2;
            }
        }
        const float qs = (g < 8 || (g >= 10 && g < 14)) ? 0.12751743f : ((g >= 18 && g < 22) ? 0.18033688f : 1.0f);
        bf16_t* pp = c.P() + (size_t)row * DIN + pc;
        pp[8 * i + j] = f2bf(y1 * qs); pp[8 * i + 4 + j] = f2bf(y2 * qs);
    }
}

__device__ __forceinline__ void phase_conv(int wid_k, int l) {
    PHASE_ENTER(cin)
    const float* cw = c.in[I_CONVW] + (size_t)l * 3 * DUP; const float* cb = c.in[I_CONVB] + (size_t)l * DUP;
    const long n = (long)MT * DFF;
    for (long idx = (long)blockIdx.x * 512 + tid_; idx < n; idx += (long)gridDim.x * 512) {
        const int row = (int)(idx / DFF), col = (int)(idx % DFF);
        const int ya = 256 * (col >> 7) + (col & 127), yg = ya + 128;
        const bool up = (row != 0 && row != SEQ), dn = (row != SEQ - 1 && row != MT - 1);
        const float* y = c.Y() + (size_t)row * DUP;
        float ha = cb[col] + cw[DUP + col] * y[ya], hg = cb[DFF + col] + cw[DUP + DFF + col] * y[yg];
        if (up) { ha += cw[col] * y[ya - DUP]; hg += cw[DFF + col] * y[yg - DUP]; }
        if (dn) { ha += cw[2 * DUP + col] * y[ya + DUP]; hg += cw[2 * DUP + DFF + col] * y[yg + DUP]; }
        c.act()[idx] = f2bf(siluf(hg) * ha);
    }
}


__device__ __forceinline__ void phase_convfix(int wid_k, int l) {
    PHASE_ENTER(cin)
    const float* cw = c.in[I_CONVW] + (size_t)l * 3 * DUP; const float* cb = c.in[I_CONVB] + (size_t)l * DUP; const float* E = c.edge();
    const int nrows = (l == DEPTH - 1 ? SEQ / 64 : NBLK64) * 2;
    const long n = (long)nrows * (DFF / 4);
    for (long idx = (long)blockIdx.x * 512 + tid_; idx < n; idx += (long)gridDim.x * 512) {
        const int br = (int)(idx / (DFF / 4)), ch = (int)(idx % (DFF / 4)) * 4, b = br >> 1, lastrow = br & 1, row = 64 * b + (lastrow ? 63 : 0);
        const int ya = 256 * (ch >> 7) + (ch & 127), yg = ya + 128;
        const float* eb = E + (size_t)b * 4 * DUP;
        f32x4 ua = {0.f, 0.f, 0.f, 0.f}, ug = ua, da = ua, dg = ua, ma, mg;
        if (!lastrow) {
            if (row != 0 && row != SEQ) { ua = *(const f32x4*)(eb - DUP + ya); ug = *(const f32x4*)(eb - DUP + yg); }
            ma = *(const f32x4*)(eb + ya); mg = *(const f32x4*)(eb + yg); da = *(const f32x4*)(eb + DUP + ya); dg = *(const f32x4*)(eb + DUP + yg);
        } else {
            ua = *(const f32x4*)(eb + 2 * DUP + ya); ug = *(const f32x4*)(eb + 2 * DUP + yg); ma = *(const f32x4*)(eb + 3 * DUP + ya); mg = *(const f32x4*)(eb + 3 * DUP + yg);
            if (row != SEQ - 1 && row != MT - 1) { da = *(const f32x4*)(eb + 4 * DUP + ya); dg = *(const f32x4*)(eb + 4 * DUP + yg); }
        }
        const f32x4 wa0 = *(const f32x4*)(cw + ch), wa1 = *(const f32x4*)(cw + DUP + ch), wa2 = *(const f32x4*)(cw + 2 * DUP + ch), ba = *(const f32x4*)(cb + ch);
        const f32x4 wg0 = *(const f32x4*)(cw + DFF + ch), wg1 = *(const f32x4*)(cw + DUP + DFF + ch), wg2 = *(const f32x4*)(cw + 2 * DUP + DFF + ch), bg = *(const f32x4*)(cb + DFF + ch);
        f32x4 o;
#pragma unroll
        for (int e = 0; e < 4; ++e) { const float ha = ba[e] + wa0[e] * ua[e] + wa1[e] * ma[e] + wa2[e] * da[e], hg = bg[e] + wg0[e] * ug[e] + wg1[e] * mg[e] + wg2[e] * dg[e]; o[e] = siluf(hg) * ha; }
        u32x2 w; w.x = cvt_pk_bf16(o[0], o[1]); w.y = cvt_pk_bf16(o[2], o[3]);
        *(u32x2*)(c.act() + (size_t)row * DFF + ch) = w;
    }
}

__device__ __forceinline__ void phase_copy_out(int wid_k) {
    PHASE_ENTER(cin)
    const f32x4* h4 = (const f32x4*)c.h(); f32x4* o4 = (f32x4*)c.out; const size_t n = (size_t)SEQ * DM / 4;
    for (size_t i = (size_t)blockIdx.x * 512 + tid_; i < n; i += (size_t)gridDim.x * 512) o4[i] = h4[i];
}

template <class Epi>
__device__ __forceinline__ void simple_gemm(int wid_k, const bf16_t* A, const bf16_t* Bt, int M, int N, int K, const Epi& epi) {
    int tid_ = tid_of(wid_k); A = launder_uniform(A); Bt = launder_uniform(Bt);
    const int lane = tid_ & 63, wid = tid_ >> 6, wm = wid >> 2, wn = wid & 3, fr = lane & 15, fq = lane >> 4;
    const int ntn = N / 128, ntiles = (M / 128) * ntn;
    for (int t = blockIdx.x; t < ntiles; t += gridDim.x) {
        const int tm = t / ntn, tn = t % ntn, row0 = tm * 128 + wm * 64, col0 = tn * 128 + wn * 32;
        f32x4 acc[4][2];
#pragma unroll
        for (int m = 0; m < 4; ++m)
#pragma unroll
            for (int n = 0; n < 2; ++n) acc[m][n] = (f32x4){0.f, 0.f, 0.f, 0.f};
        const bf16_t* ap = A + (size_t)(row0 + fr) * K + fq * 8; const bf16_t* bp = Bt + (size_t)(col0 + fr) * K + fq * 8;
        for (int k0 = 0; k0 < K; k0 += 32) {
            bf16x8 a[4], b[2];
#pragma unroll
            for (int m = 0; m < 4; ++m) a[m] = *(const bf16x8*)(ap + (size_t)m * 16 * K + k0);
#pragma unroll
            for (int n = 0; n < 2; ++n) b[n] = *(const bf16x8*)(bp + (size_t)n * 16 * K + k0);
#pragma unroll
            for (int m = 0; m < 4; ++m)
#pragma unroll
                for (int n = 0; n < 2; ++n) acc[m][n] = __builtin_amdgcn_mfma_f32_16x16x32_bf16(a[m], b[n], acc[m][n], 0, 0, 0);
        }
#pragma unroll
        for (int m = 0; m < 4; ++m)
#pragma unroll
            for (int n = 0; n < 2; ++n)
#pragma unroll
                for (int j = 0; j < 4; ++j) epi(row0 + m * 16 + fq * 4 + j, col0 + n * 16 + fr, acc[m][n][j]);
    }
}

template <class Epi>
__device__ __forceinline__ void slab_gemm(int wid_k, const bf16_t* A, int lda, const bf16_t* Bt, int ldb, int row_base, int M, int N, int K, const Epi& epi) {
    int tid_ = tid_of(wid_k); A = launder_uniform(A); Bt = launder_uniform(Bt);
    const int lane = tid_ & 63, wid = tid_ >> 6, fr = lane & 15, fq = lane >> 4;
    const int ntn = N / 16, ntiles = (M / 128) * ntn;
    for (int t = blockIdx.x; t < ntiles; t += gridDim.x) {
        const int tm = t / ntn, tn = t % ntn, row0 = row_base + tm * 128 + wid * 16, col0 = tn * 16;
        f32x4 acc0 = {0.f, 0.f, 0.f, 0.f}, acc1 = acc0;
        const bf16_t* ap = A + (size_t)(row0 + fr) * lda + fq * 8; const bf16_t* bp = Bt + (size_t)(col0 + fr) * ldb + fq * 8;
#pragma unroll 8
        for (int k0 = 0; k0 < K; k0 += 64) {
            const bf16x8 a0 = *(const bf16x8*)(ap + k0), b0 = *(const bf16x8*)(bp + k0), a1 = *(const bf16x8*)(ap + k0 + 32), b1 = *(const bf16x8*)(bp + k0 + 32);
            acc0 = __builtin_amdgcn_mfma_f32_16x16x32_bf16(a0, b0, acc0, 0, 0, 0);
            acc1 = __builtin_amdgcn_mfma_f32_16x16x32_bf16(a1, b1, acc1, 0, 0, 0);
        }
#pragma unroll
        for (int j = 0; j < 4; ++j) epi(row0 + fq * 4 + j, col0 + fr, acc0[j] + acc1[j]);
    }
}

template <class Epi4>
__device__ __forceinline__ void slab_gemm4(int wid_k, char* lds, const bf16_t* A, int lda, const bf16_t* Bt, int ldb, int row_base, int M, int N, int K, const Epi4& epi) {
    int tid_ = tid_of(wid_k); A = launder_uniform(A); Bt = launder_uniform(Bt);
    const int lane = tid_ & 63, wid = __builtin_amdgcn_readfirstlane(tid_ >> 6), r32 = lane & 31, hi = lane >> 5, ch = wid & 1, kq = wid >> 1, kl = K >> 2;
    float* part = (float*)lds;
    const int ntn = N / 64, ntiles = (M / 32) * ntn;
    typedef const __attribute__((address_space(1))) bf16x8 gfrag;
    for (int t = blockIdx.x; t < ntiles; t += gridDim.x) {
        const int tm = t / ntn, tn = t % ntn, row0 = row_base + tm * 32, col0 = tn * 64 + ch * 32;
        const bf16_t* ap = A + (size_t)(row0 + r32) * lda + kq * kl + hi * 8; const bf16_t* bp = Bt + (size_t)(col0 + r32) * ldb + kq * kl + hi * 8;
        f32x16 acc = {};
        bf16x8 fa0[8], fb0[8], fa1[8], fb1[8];
#define SLAB_LD(FA, FB, kb_) do { _Pragma("unroll") for (int i = 0; i < 8; ++i) { const int kk_ = (kb_) + 16 * i; if (kk_ < kl) { FA[i] = *(gfrag*)(ap + kk_); FB[i] = *(gfrag*)(bp + kk_); } else { FA[i] = (bf16x8){0, 0, 0, 0, 0, 0, 0, 0}; FB[i] = FA[i]; } } } while (0)
#define SLAB_MM(FA, FB) do { _Pragma("unroll") for (int i = 0; i < 8; ++i) acc = __builtin_amdgcn_mfma_f32_32x32x16_bf16(FA[i], FB[i], acc, 0, 0, 0); } while (0)
        SLAB_LD(fa0, fb0, 0);
        for (int k0 = 0; k0 < kl; k0 += 256) {
            if (k0 + 128 < kl) SLAB_LD(fa1, fb1, k0 + 128);
            SLAB_MM(fa0, fb0);
            if (k0 + 256 < kl) SLAB_LD(fa0, fb0, k0 + 256);
            if (k0 + 128 < kl) SLAB_MM(fa1, fb1);
        }
#undef SLAB_LD
#undef SLAB_MM
        float* pw = part + ((kq * 2 + ch) * 32) * 32 + r32;
#pragma unroll
        for (int i = 0; i < 16; ++i) pw[((i & 3) + 8 * (i >> 2) + 4 * hi) * 32] = acc[i];
        __syncthreads();
#pragma unroll
        for (int j = 0; j < 4; ++j) { const int o = (tid_ & 255) + 256 * j, c2 = tid_ >> 8, rr = o >> 5, cc = o & 31;
            const float* pp = part + (c2 * 32 + rr) * 32 + cc;
            epi(row_base + tm * 32 + rr, tn * 64 + c2 * 32 + cc, pp[0], pp[2 * 1024], pp[4 * 1024], pp[6 * 1024]); }
        __syncthreads();
    }
}
template <bool QUART, class Epi4>
__device__ __forceinline__ void slab_gemm5(int wid_k, char* lds, const bf16_t* A, int lda, const bf16_t* Bt, int ldb, int row_base, int M, int N, int K, const Epi4& epi) {
    int tid_ = tid_of(wid_k); A = launder_uniform(A); Bt = launder_uniform(Bt);
    const int lane = tid_ & 63, wid = __builtin_amdgcn_readfirstlane(tid_ >> 6), r32 = lane & 31, hi = lane >> 5, ch = wid & 1, kq = wid >> 1, kl = K >> 2, ns = K >> 7;
    constexpr int STG = 24576, NSTG = 5;
    float* part = (float*)lds;
    LAS unsigned char* ldsL = (LAS unsigned char*)(unsigned)(uintptr_t)lds;
    const int ntn = N / 64, ntiles = (M / 32) * ntn;
    for (int t = blockIdx.x; t < ntiles; t += gridDim.x) {
        const int tm = t / ntn, tn = t % ntn, row0 = row_base + tm * 32, col0 = tn * 64;
        const __amdgpu_buffer_rsrc_t rA5 = __builtin_amdgcn_make_buffer_rsrc((void*)A, 0, 0x7fffffff, 0x00020000), rB5 = __builtin_amdgcn_make_buffer_rsrc((void*)Bt, 0, 0x7fffffff, 0x00020000);
        unsigned goff[3];
#pragma unroll
        for (int j = 0; j < 3; ++j) { const int J = 3 * wid + j, isA = J < 8, G = (isA ? J : J - 8) * 64 + lane, row = G >> 4, lc = (G & 15) ^ (row & 15);
            goff[j] = (unsigned)(row * (isA ? lda : ldb) + (QUART ? (lc >> 2) * kl + (lc & 3) * 8 : lc * 8)) * 2u; }
        const int tA = row0 * lda * 2, tB = col0 * ldb * 2;
        const int sstep = QUART ? 64 : 256;
#define S5_DMA(st_, si_) do { _Pragma("unroll") for (int j = 0; j < 3; ++j) { const bool isA_ = 3 * wid + j < 8; \
            __builtin_amdgcn_raw_ptr_buffer_load_lds(isA_ ? rA5 : rB5, (LAS void*)(ldsL + (st_) * STG + (3 * wid + j) * 1024), 16, goff[j], (isA_ ? tA : tB) + (si_) * sstep, 0, 0); } } while (0)
        int aoff[2], boff[2];
#pragma unroll
        for (int m = 0; m < 2; ++m) { const int lc = QUART ? 4 * kq + 2 * m + hi : 2 * kq + 8 * m + hi;
            aoff[m] = r32 * 256 + ((lc ^ (r32 & 15)) << 4); boff[m] = 8192 + (ch * 32 + r32) * 256 + ((lc ^ (r32 & 15)) << 4); }
        f32x16 acc = {};
#pragma unroll
        for (int s = 0; s < NSTG - 1; ++s) if (s < ns) S5_DMA(s, s);
        int st = 0;
        for (int s = 0; s < ns; ++s) {
            const int rem = ns - 1 - s;
            if (rem >= 3) asm volatile("s_waitcnt vmcnt(9)" ::: "memory"); else if (rem == 2) asm volatile("s_waitcnt vmcnt(6)" ::: "memory");
            else if (rem == 1) asm volatile("s_waitcnt vmcnt(3)" ::: "memory"); else asm volatile("s_waitcnt vmcnt(0)" ::: "memory");
            __builtin_amdgcn_s_barrier(); asm volatile("" ::: "memory");
            if (s + NSTG - 1 < ns) { const int sn = st == 0 ? NSTG - 1 : st - 1; S5_DMA(sn, s + NSTG - 1); }
            const LAS unsigned char* sb = ldsL + st * STG;
            const bf16x8 a0 = *(const LAS bf16x8*)(sb + aoff[0]), b0 = *(const LAS bf16x8*)(sb + boff[0]), a1 = *(const LAS bf16x8*)(sb + aoff[1]), b1 = *(const LAS bf16x8*)(sb + boff[1]);
            acc = __builtin_amdgcn_mfma_f32_32x32x16_bf16(a0, b0, acc, 0, 0, 0);
            acc = __builtin_amdgcn_mfma_f32_32x32x16_bf16(a1, b1, acc, 0, 0, 0);
            st = st == NSTG - 1 ? 0 : st + 1;
        }
#undef S5_DMA
        asm volatile("s_waitcnt lgkmcnt(0)" ::: "memory"); __builtin_amdgcn_s_barrier(); asm volatile("" ::: "memory");
        float* pw = part + ((kq * 2 + ch) * 32) * 32 + r32;
#pragma unroll
        for (int i = 0; i < 16; ++i) pw[((i & 3) + 8 * (i >> 2) + 4 * hi) * 32] = acc[i];
        __syncthreads();
#pragma unroll
        for (int j = 0; j < 4; ++j) { const int o = (tid_ & 255) + 256 * j, c2 = tid_ >> 8, rr = o >> 5, cc = o & 31;
            const float* pp = part + (c2 * 32 + rr) * 32 + cc;
            epi(row_base + tm * 32 + rr, tn * 64 + c2 * 32 + cc, pp[0], pp[2 * 1024], pp[4 * 1024], pp[6 * 1024]); }
        __syncthreads();
    }
}
struct SEpiRes4 {
    float* h; const float* gx; const float* gc; const float* src;
    __device__ __forceinline__ void operator()(int row, int col, float p0, float p1, float p2, float p3) const { const size_t o = (size_t)row * DM + col; h[o] = src[o] + (row < SEQ ? gx[col] : gc[col]) * ((p0 + p1) + (p2 + p3)); }
};
struct SEpiBr4 {
    bf16_t* mb; const bf16_t* P;
    __device__ __forceinline__ void operator()(int row, int col, float p0, float p1, float p2, float p3) const { const bf16_t* g = P + (size_t)row * DIN + C_G + col;
        mb[(size_t)row * DM + col] = f2bf(bf2f(g[0]) * (p0 + p1) + bf2f(g[DM]) * p2 + bf2f(g[2 * DM]) * p3); }
};
struct SEpiWin {
    float* R; bf16_t* P;
    __device__ __forceinline__ void operator()(int row, int col, float v) const {
        const bool isv = (col >= C_VA && col < C_QB) || (col >= C_VB && col < C_QC) || (col >= C_VC);
        if (!isv) { const int rc = col < C_VA ? col : (col < C_VB ? col - 256 : col - 768); R[(size_t)row * RW + rc] = v; }
        else P[(size_t)row * DIN + col] = f2bf(col >= C_G ? sigmoidf(v) : v);
    }
};
template <int STEP> struct SEpiBr {
    float* mf; bf16_t* mb; const bf16_t* P;
    __device__ __forceinline__ void operator()(int row, int col, float v) const {
        const float g = bf2f(P[(size_t)row * DIN + C_G + STEP * DM + col]);
        const size_t o = (size_t)row * DM + col;
        if (STEP == 0) mf[o] = g * v; else if (STEP == 1) mf[o] += g * v; else mb[o] = f2bf(mf[o] + g * v);
    }
};
struct SEpiRes {
    float* h; const float* gx; const float* gc; const float* src;
    __device__ __forceinline__ void operator()(int row, int col, float v) const { const size_t o = (size_t)row * DM + col; h[o] = src[o] + (row < SEQ ? gx[col] : gc[col]) * v; }
};
struct SEpiY { float* Y; __device__ __forceinline__ void operator()(int row, int col, float v) const { Y[(size_t)row * DUP + col] = v; } };

namespace pg8 {
#define PG8_LAS __attribute__((address_space(3)))
constexpr int BM = 256, BK = 64, HALF = 128, HTB = HALF * BK * 2  , STAGE_BYTES = 8 * HTB, NXCD = 8, WGM = 8;
__host__ __device__ __forceinline__ int lds_byte(int r, int c) { const int st = (r >> 4) * 2 + (c >> 5), rr = r & 15, cc = c & 31, ob = rr * 64 + cc * 2; return st * 1024 + (ob ^ (((ob >> 9) & 1) << 5)); }
__host__ __device__ __forceinline__ void stage_rc(int b, int& R, int& C) { const int st = b / 1024, sb = b % 1024, swz = sb ^ (((sb >> 9) & 1) << 5); R = (st >> 1) * 16 + swz / 64; C = (st & 1) * 32 + (swz % 64) / 2; }
__host__ __device__ __forceinline__ int perm32(int rho) { const int n = rho >> 4, i = rho & 15; return 8 * (i >> 2) + 4 * n + (i & 3); }
struct Unit { int pm, pn; };
struct Gemm { const bf16_t* A; const bf16_t* Bt; int M, N, K; int lda = 0, ldb = 0; };
struct OneUnit { Unit u; __device__ __forceinline__ bool next(int i, Unit& o) const { o = u; return i == 0; } __device__ __forceinline__ void a_ready(const Unit&) const {} __device__ __forceinline__ void done(const Unit&) const {} };
struct StaticOrder {
    int nM, nN, nwg, G, c;
    __host__ __device__ __forceinline__ void init(int M, int N, int G_, int c_) { nM = M / BM; nN = N / BM; nwg = nM * nN; G = G_; c = c_; }
    __host__ __device__ __forceinline__ bool next(int i, Unit& u) const {
        const long L = (long)i * G + c; if (L >= nwg) return false;
        int wgid = (int)L; { const int q = nwg / NXCD, r = nwg % NXCD, xcd = wgid % NXCD, off = wgid / NXCD; wgid = (xcd < r ? xcd * (q + 1) : r * (q + 1) + (xcd - r) * q) + off; }
        const int nig = WGM * nN, gid = wgid / nig, fm = gid * WGM, gsz = (nM - fm) < WGM ? (nM - fm) : WGM;
        u.pm = fm + ((wgid % nig) % gsz); u.pn = (wgid % nig) / gsz; return true;
    }
    __device__ __forceinline__ void a_ready(const Unit&) const {}
    __device__ __forceinline__ void done(const Unit&) const {}
};
template <class Epi, class Sched, bool KEEP_IN, bool KEEP_OUT, bool F8 = false>
__device__ __forceinline__ void gemm_phase_core(PG8_LAS unsigned char* lds, const Gemm g, const Sched& S, const Epi& E, int tid, f32x4 (&acc)[2][2][4][2]) {
    asm volatile("" : "+v"(tid));
    const int wid = __builtin_amdgcn_readfirstlane(tid >> 6), lane = tid & 63, wr = wid >> 2, wc = wid & 3, fr = lane & 15, fq = lane >> 4;
    const int K = g.K, nt = K / BK, lda = g.lda ? g.lda : K, ldb = g.ldb ? g.ldb : K;
    unsigned voffA[2], voffB[2];
#pragma unroll
    for (int i = 0; i < 2; ++i) { int R, C; stage_rc(tid * 16 + i * 8192, R, C); const int Rb = Epi::PERM ? ((R & ~31) + perm32(R & 31)) : R;
        voffA[i] = (unsigned)(R * lda + C) * 2u; voffB[i] = (unsigned)(Rb * ldb + C) * 2u; }
    const __amdgpu_buffer_rsrc_t rA_ = __builtin_amdgcn_make_buffer_rsrc((void*)g.A, 0, 0x7fffffff, 0x00020000), rB_ = __builtin_amdgcn_make_buffer_rsrc((void*)g.Bt, 0, 0x7fffffff, 0x00020000);
    const size_t kstep = (size_t)(BK * 2);
    const size_t hstepA = (size_t)HALF * lda * 2, hstepB = (size_t)HALF * ldb * 2;
    const size_t tstepA = 2 * hstepA, tstepB = 2 * hstepB;
    const unsigned ldsw = (unsigned)wid * 1024u;
    const int aoff = lds_byte(wr * 64 + fr, fq * 8), boff = lds_byte(wc * 32 + fr, fq * 8);
#define PG8_SA(b, h) (((b) * 2 + (h)) * HTB)
#define PG8_SB(b, h) ((4 + (b) * 2 + (h)) * HTB)
#define PG8_STAGE(bufoff, gbase, voff, R_, BASE_) do { const int so_ = (int)((const char*)(gbase) - (const char*)(BASE_)); _Pragma("unroll") for (int _i = 0; _i < 2; ++_i) \
        __builtin_amdgcn_raw_ptr_buffer_load_lds(R_, (PG8_LAS void*)(lds + (bufoff) + ldsw + _i * 8192), 16, (voff)[_i], so_, 0, 0); } while (0)
#define PG8_LDA(dst, b, h) do { _Pragma("unroll") for (int m = 0; m < 4; ++m) _Pragma("unroll") for (int k = 0; k < 2; ++k) dst[m][k] = *(const PG8_LAS bf16x8*)(lds + PG8_SA(b, h) + aoff + m * 2048 + k * 1024); } while (0)
#define PG8_LDB(dst, b, h) do { _Pragma("unroll") for (int n = 0; n < 2; ++n) _Pragma("unroll") for (int k = 0; k < 2; ++k) dst[n][k] = *(const PG8_LAS bf16x8*)(lds + PG8_SB(b, h) + boff + n * 2048 + k * 1024); } while (0)
#define PG8_MMA(ai, bj, At, Bt) do { __builtin_amdgcn_s_setprio(1); _Pragma("unroll") for (int m = 0; m < 4; ++m) _Pragma("unroll") for (int n = 0; n < 2; ++n) { \
        if constexpr (F8) { typedef int v4i_ __attribute__((ext_vector_type(4))); typedef int v8i_ __attribute__((ext_vector_type(8))); \
            const v8i_ b8_ = __builtin_shufflevector(__builtin_bit_cast(v4i_, Bt[n][0]), __builtin_bit_cast(v4i_, Bt[n][1]), 0, 1, 2, 3, 4, 5, 6, 7); \
            const v8i_ a8_ = __builtin_shufflevector(__builtin_bit_cast(v4i_, At[m][0]), __builtin_bit_cast(v4i_, At[m][1]), 0, 1, 2, 3, 4, 5, 6, 7); \
            asm volatile("v_mfma_scale_f32_16x16x128_f8f6f4 %0, %1, %2, %0, %3, %3 op_sel_hi:[0,0,0]" : "+v"(acc[ai][bj][m][n]) : "v"(b8_), "v"(a8_), "v"(sc8_)); } \
        else { _Pragma("unroll") for (int k = 0; k < 2; ++k) acc[ai][bj][m][n] = __builtin_amdgcn_mfma_f32_16x16x32_bf16(Bt[n][k], At[m][k], acc[ai][bj][m][n], 0, 0, 0); } } \
        __builtin_amdgcn_s_setprio(0); } while (0)
#define PG8_WAIT_V(n) asm volatile("s_waitcnt vmcnt(" #n ")" ::: "memory")
#define PG8_WAIT_L(n) asm volatile("s_waitcnt lgkmcnt(" #n ")" ::: "memory")
#define PG8_BAR __builtin_amdgcn_s_barrier()
#define PG8_SCHED __builtin_amdgcn_sched_barrier(0)
    int sc8_ = 127; if constexpr (F8) asm volatile("" : "+v"(sc8_));
    Unit cur, nxt; int ui = 0;
    if (!S.next(0, cur)) return;
    if constexpr (!KEEP_IN) {
#pragma unroll
    for (int a = 0; a < 2; ++a)
#pragma unroll
        for (int b = 0; b < 2; ++b)
#pragma unroll
            for (int m = 0; m < 4; ++m)
#pragma unroll
                for (int n = 0; n < 2; ++n) acc[a][b][m][n] = (f32x4){0.f, 0.f, 0.f, 0.f};
    }
    bf16x8 At[4][2], B0[2][2], B1[2][2];
    const char* cA = (const char*)g.A + (size_t)cur.pm * tstepA; const char* cB = (const char*)g.Bt + (size_t)cur.pn * tstepB;
    S.a_ready(cur);
    PG8_STAGE(PG8_SB(0, 0), cB, voffB, rB_, g.Bt); PG8_STAGE(PG8_SA(0, 0), cA, voffA, rA_, g.A); PG8_STAGE(PG8_SB(0, 1), cB + hstepB, voffB, rB_, g.Bt); PG8_STAGE(PG8_SA(0, 1), cA + hstepA, voffA, rA_, g.A);
    if (wr == 1) PG8_BAR;
    PG8_WAIT_V(4); PG8_BAR;
    PG8_STAGE(PG8_SB(1, 0), cB + kstep, voffB, rB_, g.Bt); PG8_STAGE(PG8_SA(1, 0), cA + kstep, voffA, rA_, g.A); PG8_STAGE(PG8_SB(1, 1), cB + hstepB + kstep, voffB, rB_, g.Bt);
    PG8_WAIT_V(6); PG8_BAR;
    for (;;) {
        const bool has_next = S.next(ui + 1, nxt);
        const char* nA = has_next ? (const char*)g.A + (size_t)nxt.pm * tstepA : cA; const char* nB = has_next ? (const char*)g.Bt + (size_t)nxt.pn * tstepB : cB;
        for (int t = 0; t < nt; t += 2) {
            const bool last = (t == nt - 2);
            const char* a1 = cA + (size_t)(t + 1) * kstep;
            const char* a2 = last ? nA : cA + (size_t)(t + 2) * kstep; const char* b2 = last ? nB : cB + (size_t)(t + 2) * kstep;
            const char* a3 = a2 + kstep; const char* b3 = b2 + kstep;
            if (last && has_next) S.a_ready(nxt);
            PG8_LDB(B0, 0, 0); PG8_SCHED; PG8_LDA(At, 0, 0); PG8_STAGE(PG8_SA(1, 1), a1 + hstepA, voffA, rA_, g.A);
            PG8_WAIT_L(8); PG8_BAR; PG8_WAIT_L(0); PG8_MMA(0, 0, At, B0); PG8_BAR; PG8_SCHED;
            PG8_LDB(B1, 0, 1); PG8_STAGE(PG8_SB(0, 0), b2, voffB, rB_, g.Bt);
            PG8_BAR; PG8_WAIT_L(0); PG8_MMA(0, 1, At, B1); PG8_BAR;
            PG8_LDA(At, 0, 1); PG8_STAGE(PG8_SA(0, 0), a2, voffA, rA_, g.A);
            PG8_BAR; PG8_WAIT_L(0); PG8_MMA(1, 0, At, B0); PG8_BAR; PG8_SCHED;
            PG8_STAGE(PG8_SB(0, 1), b2 + hstepB, voffB, rB_, g.Bt);
            PG8_WAIT_V(6); PG8_BAR; PG8_MMA(1, 1, At, B1); PG8_BAR;
            PG8_LDB(B0, 1, 0); PG8_SCHED; PG8_LDA(At, 1, 0); PG8_STAGE(PG8_SA(0, 1), a2 + hstepA, voffA, rA_, g.A);
            PG8_WAIT_L(8); PG8_BAR; PG8_WAIT_L(0); PG8_MMA(0, 0, At, B0); PG8_BAR; PG8_SCHED;
            PG8_LDB(B1, 1, 1); PG8_STAGE(PG8_SB(1, 0), b3, voffB, rB_, g.Bt);
            PG8_BAR; PG8_WAIT_L(0); PG8_MMA(0, 1, At, B1); PG8_BAR;
            PG8_LDA(At, 1, 1); PG8_STAGE(PG8_SA(1, 0), a3, voffA, rA_, g.A);
            PG8_BAR; PG8_WAIT_L(0); PG8_MMA(1, 0, At, B0); PG8_BAR; PG8_SCHED;
            PG8_STAGE(PG8_SB(1, 1), b3 + hstepB, voffB, rB_, g.Bt);
            PG8_WAIT_V(6); PG8_BAR; PG8_MMA(1, 1, At, B1); PG8_BAR;
        }
        if constexpr (F8) {
#define PG8_PIN8(ai, bj, TXT) asm volatile(TXT : "+v"(acc[ai][bj][0][0]), "+v"(acc[ai][bj][0][1]), "+v"(acc[ai][bj][1][0]), "+v"(acc[ai][bj][1][1]), "+v"(acc[ai][bj][2][0]), "+v"(acc[ai][bj][2][1]), "+v"(acc[ai][bj][3][0]), "+v"(acc[ai][bj][3][1]))
            PG8_PIN8(0, 0, "s_nop 15\n\ts_nop 15"); PG8_PIN8(0, 1, ""); PG8_PIN8(1, 0, ""); PG8_PIN8(1, 1, "");
#undef PG8_PIN8
        }
        if constexpr (!Epi::AFTER_DRAIN && !KEEP_OUT) { E(acc, cur, wr, wc, fr, fq); S.done(cur); }
        if (!has_next) break;
#pragma unroll
        for (int a = 0; a < 2; ++a)
#pragma unroll
            for (int b = 0; b < 2; ++b)
#pragma unroll
                for (int m = 0; m < 4; ++m)
#pragma unroll
                    for (int n = 0; n < 2; ++n) acc[a][b][m][n] = (f32x4){0.f, 0.f, 0.f, 0.f};
        cur = nxt; cA = nA; cB = nB; ++ui;
    }
    PG8_WAIT_V(0);
    if (wr == 0) PG8_BAR;
    PG8_BAR;
    if constexpr (Epi::AFTER_DRAIN && !KEEP_OUT) { E.fused(acc, cur, wr, wc, fr, fq, lds, wid, lane); S.done(cur); }
#undef PG8_SA
#undef PG8_SB
#undef PG8_STAGE
#undef PG8_LDA
#undef PG8_LDB
#undef PG8_MMA
#undef PG8_WAIT_V
#undef PG8_WAIT_L
#undef PG8_BAR
#undef PG8_SCHED
}
template <class Epi, class Sched, bool F8 = false>
__device__ __forceinline__ void gemm_phase(PG8_LAS unsigned char* lds, const Gemm g, const Sched& S, const Epi& E, int tid) {
    f32x4 acc[2][2][4][2];
    gemm_phase_core<Epi, Sched, false, false, F8>(lds, g, S, E, tid, acc);
}
}

namespace pg8 {
typedef const f32x4 (&AccRef)[2][2][4][2];
__device__ __forceinline__ u32x4 pack8(const f32x4 a, const f32x4 b) {
    unsigned x, y, z, w;
    asm volatile("s_nop 0\n\tv_cvt_pk_bf16_f32 %0, %4, %5\n\tv_cvt_pk_bf16_f32 %1, %6, %7\n\tv_cvt_pk_bf16_f32 %2, %8, %9\n\tv_cvt_pk_bf16_f32 %3, %10, %11"
        : "=&v"(x), "=&v"(y), "=&v"(z), "=&v"(w) : "v"(a[0]), "v"(a[1]), "v"(a[2]), "v"(a[3]), "v"(b[0]), "v"(b[1]), "v"(b[2]), "v"(b[3]));
    return (u32x4){x, y, z, w}; }
__device__ __forceinline__ void unpack8(const u32x4 w, f32x4& a, f32x4& b) {
    a[0] = __uint_as_float(w.x << 16); a[1] = __uint_as_float(w.x & 0xffff0000u); a[2] = __uint_as_float(w.y << 16); a[3] = __uint_as_float(w.y & 0xffff0000u);
    b[0] = __uint_as_float(w.z << 16); b[1] = __uint_as_float(w.z & 0xffff0000u); b[2] = __uint_as_float(w.w << 16); b[3] = __uint_as_float(w.w & 0xffff0000u); }
struct EpiWin {
    static constexpr bool PERM = true, AFTER_DRAIN = false;
    bf16_t* P; const float* gqa; const float* gka; const float* gqb; const float* gkb; const float* gqc; const float* gkc; LAS float* part; float zs = 1.0f;
    __device__ __forceinline__ void operator()(AccRef acc, const Unit& u, int wr, int wc, int fr_, int fq_) const {
        int fr = fr_, fq = fq_; asm volatile("" : "+v"(fr), "+v"(fq));
        const int row0 = u.pm * BM + wr * 64 + fr, pn = u.pn, colt = pn * BM, cw = wc * 32 + 8 * fq;
        const bool isv = (pn == 5) || (pn == 10) || (pn == 11) || (pn >= 16);
        if (isv) {
            const bool gate = pn >= 18;
#pragma unroll
            for (int ai = 0; ai < 2; ++ai)
#pragma unroll
                for (int m = 0; m < 4; ++m) { bf16_t* pp = P + (size_t)(row0 + ai * HALF + m * 16) * DIN + colt + cw;
#pragma unroll
                    for (int bj = 0; bj < 2; ++bj) { f32x4 v0 = acc[ai][bj][m][0], v1 = acc[ai][bj][m][1];
                        if (gate) {
#pragma unroll
                            for (int e = 0; e < 4; ++e) { v0[e] = sigmoidf(v0[e] * zs); v1[e] = sigmoidf(v1[e] * zs); } }
                        *(u32x4*)(pp + bj * HALF) = pack8(v0, v1); } }
            return;
        }
        int type; float qs; f32x4 g1, g2; const int grpA = wc >> 1, fA = 16 * (wc & 1) + 4 * fq, grpC = wc & 1, fC = 4 * fq;
        if (pn < 4) { type = 0; qs = 0.12751743f; g1 = *(const f32x4*)(gqa + 64 * grpA + fA); g2 = *(const f32x4*)(gqa + 64 * grpA + 32 + fA); }
        else if (pn == 4) { type = 0; qs = 1.f; g1 = *(const f32x4*)(gka + 64 * grpA + fA); g2 = *(const f32x4*)(gka + 64 * grpA + 32 + fA); }
        else if (pn < 8) { type = 1; qs = 0.12751743f; g1 = *(const f32x4*)(gqb + cw); g2 = *(const f32x4*)(gqb + cw + 4); }
        else if (pn < 10) { type = 1; qs = 1.f; g1 = *(const f32x4*)(gkb + cw); g2 = *(const f32x4*)(gkb + cw + 4); }
        else if (pn < 14) { type = 2; qs = 0.18033688f; g1 = *(const f32x4*)(gqc + 32 * grpC + fC); g2 = *(const f32x4*)(gqc + 32 * grpC + 16 + fC); }
        else { type = 2; qs = 1.f; g1 = *(const f32x4*)(gkc + 32 * grpC + fC); g2 = *(const f32x4*)(gkc + 32 * grpC + 16 + fC); }
        const int prow = wr * 64 + fr;
#pragma unroll
        for (int ai = 0; ai < 2; ++ai)
#pragma unroll
            for (int m = 0; m < 4; ++m)
#pragma unroll
                for (int bj = 0; bj < 2; ++bj) { const f32x4 a = acc[ai][bj][m][0], b = acc[ai][bj][m][1];
                    float s = (a[0] * a[0] + a[1] * a[1]) + (a[2] * a[2] + a[3] * a[3]) + (b[0] * b[0] + b[1] * b[1]) + (b[2] * b[2] + b[3] * b[3]);
                    s += swz_xor<16>(s);
                    { auto rr = __builtin_amdgcn_permlane32_swap(__float_as_uint(s), __float_as_uint(s), false, false); s = __uint_as_float(rr[0]) + __uint_as_float(rr[1]); }
                    if (fq == 0) part[((ai * HALF + m * 16 + prow) * 2 + bj) * 4 + wc] = s; }
        asm volatile("s_waitcnt lgkmcnt(0)" ::: "memory"); __builtin_amdgcn_s_barrier(); asm volatile("" ::: "memory");
        f32x4 inv = {0.f, 0.f, 0.f, 0.f}; const int grp = type == 0 ? grpA : grpC;
        if (type != 1) { const int f0 = type == 0 ? fA : fC; const float kf = type == 0 ? (13.287712379549449f / 32.0f) : (13.287712379549449f / 16.0f);
#pragma unroll
            for (int e = 0; e < 4; ++e) inv[e] = __builtin_amdgcn_exp2f(-(float)(f0 + e) * kf); }
        const bool rope = (type != 1) && (u.pm * BM < SEQ);
        const float invn = type == 2 ? (1.0f / 64.0f) : (1.0f / 128.0f);
#pragma unroll
        for (int ai = 0; ai < 2; ++ai)
#pragma unroll
            for (int m = 0; m < 4; ++m) {
                f32x4 cs = {1.f, 1.f, 1.f, 1.f}, sn = {0.f, 0.f, 0.f, 0.f};
                if (rope) { const float pos = grp ? (float)(m * 16 + fr) : (float)(4 * u.pm + 2 * ai + wr);
#pragma unroll
                    for (int e = 0; e < 4; ++e) { const float rev = __builtin_amdgcn_fractf(pos * inv[e] * 0.15915494309189535f); cs[e] = __builtin_amdgcn_cosf(rev); sn[e] = __builtin_amdgcn_sinf(rev); } }
                bf16_t* pp = P + (size_t)(row0 + ai * HALF + m * 16) * DIN + colt + cw;
#pragma unroll
                for (int bj = 0; bj < 2; ++bj) {
                    const f32x4 pq = *(const LAS f32x4*)(part + ((ai * HALF + m * 16 + prow) * 2 + bj) * 4);
                    const float tot = type == 2 ? ((wc & 2) ? pq[2] + pq[3] : pq[0] + pq[1]) : (pq[0] + pq[1]) + (pq[2] + pq[3]);
                    const float rstd = qs * __builtin_amdgcn_rsqf(tot * invn + EPS);
                    f32x4 v0, v1;
#pragma unroll
                    for (int e = 0; e < 4; ++e) { const float y1 = acc[ai][bj][m][0][e] * rstd * g1[e], y2 = acc[ai][bj][m][1][e] * rstd * g2[e];
                        v0[e] = y1 * cs[e] - y2 * sn[e]; v1[e] = y2 * cs[e] + y1 * sn[e]; }
                    *(u32x4*)(pp + bj * HALF) = pack8(v0, v1); }
                asm volatile("" ::: "memory"); }
    }
};
struct EpiGate {
    static constexpr bool PERM = true, AFTER_DRAIN = false;
    bf16_t* P;
    __device__ __forceinline__ void operator()(AccRef acc, const Unit& u, int wr, int wc, int fr, int fq) const {
        const int row0 = u.pm * BM + wr * 64 + fr, col0 = C_G + u.pn * BM + wc * 32 + 8 * fq;
#pragma unroll
        for (int ai = 0; ai < 2; ++ai)
#pragma unroll
            for (int m = 0; m < 4; ++m) { bf16_t* pp = P + (size_t)(row0 + ai * HALF + m * 16) * DIN + col0;
#pragma unroll
                for (int bj = 0; bj < 2; ++bj) { f32x4 v0 = acc[ai][bj][m][0], v1 = acc[ai][bj][m][1];
#pragma unroll
                    for (int e = 0; e < 4; ++e) { v0[e] = __builtin_amdgcn_rcpf(1.0f + __builtin_amdgcn_exp2f(v0[e] * (-1.4426950408889634f / 32.0f))); v1[e] = __builtin_amdgcn_rcpf(1.0f + __builtin_amdgcn_exp2f(v1[e] * (-1.4426950408889634f / 32.0f))); }
                    *(u32x4*)(pp + bj * HALF) = pack8(v0, v1); } }
    }
};
struct GateOrder {
    int first, count, stride;
    __device__ __forceinline__ void init(int c, int G) { stride = 1; if (G != 256) { first = c; stride = G; count = (33 * 24 - c + G - 1) / G; } else if (c < 82) { first = 2 * c; count = 2; } else if (c < 188) { first = 164 + 4 * (c - 82); count = 4; } else { first = 588 + 3 * (c - 188); count = 3; } }
    __device__ __forceinline__ bool next(int i, Unit& u) const { if (i >= count) return false; const int g = first + i * stride; u.pm = g / 24; u.pn = g % 24; return true; }
    __device__ __forceinline__ void a_ready(const Unit&) const {}
    __device__ __forceinline__ void done(const Unit&) const {}
};
template <int STEP> struct EpiBr {
    static constexpr bool PERM = true, AFTER_DRAIN = false;
    float* mf; bf16_t* mb; const bf16_t* P;
    __device__ __forceinline__ void operator()(AccRef acc, const Unit& u, int wr, int wc, int fr, int fq) const {
        const int row0 = u.pm * BM + wr * 64 + fr, col0 = u.pn * BM + wc * 32 + 8 * fq;
#pragma unroll
        for (int am = 0; am < 4; ++am) { const int ai = am >> 1, m0 = (am & 1) * 2;
            u32x4 gw[2][2]; f32x4 old0[2][2], old1[2][2];
#pragma unroll
            for (int mm = 0; mm < 2; ++mm)
#pragma unroll
                for (int bj = 0; bj < 2; ++bj) { const size_t row = (size_t)(row0 + ai * HALF + (m0 + mm) * 16); const int col = col0 + bj * HALF;
                    gw[mm][bj] = *(const u32x4*)(P + row * DIN + C_G + STEP * DM + col);
                    if (STEP > 0) { old0[mm][bj] = *(const f32x4*)(mf + row * DM + col); old1[mm][bj] = *(const f32x4*)(mf + row * DM + col + 4); } }
#pragma unroll
            for (int mm = 0; mm < 2; ++mm)
#pragma unroll
                for (int bj = 0; bj < 2; ++bj) { const size_t row = (size_t)(row0 + ai * HALF + (m0 + mm) * 16); const int col = col0 + bj * HALF;
                    f32x4 g0, g1; unpack8(gw[mm][bj], g0, g1);
                    f32x4 v0 = g0 * acc[ai][bj][m0 + mm][0], v1 = g1 * acc[ai][bj][m0 + mm][1];
                    if (STEP > 0) { v0 += old0[mm][bj]; v1 += old1[mm][bj]; }
                    float* mp = mf + row * DM + col;
                    if (STEP < 2) { *(f32x4*)mp = v0; *(f32x4*)(mp + 4) = v1; } else *(u32x4*)(mb + row * DM + col) = pack8(v0, v1); }
            asm volatile("" ::: "memory");
        }
    }
};

struct EpiBrChain {
    static constexpr bool PERM = true, AFTER_DRAIN = false;
    bf16_t* mb; const bf16_t* P;
    template <int GS> __device__ __forceinline__ void scale(f32x4 (&acc)[2][2][4][2], const Unit& u, int tid) const {
        asm volatile("" : "+v"(tid));
        const int wid = __builtin_amdgcn_readfirstlane(tid >> 6), lane = tid & 63, wr = wid >> 2, wc = wid & 3, fr = lane & 15, fq = lane >> 4;
        const bf16_t* gp0 = P + (size_t)(u.pm * BM + wr * 64 + fr) * DIN + C_G + GS * DM + u.pn * BM + wc * 32 + 8 * fq;
        typedef const __attribute__((address_space(1))) u32x4 gq;
        u32x4 cn[2], cd[2], nn[2], nd[2];
#define GLD(n_, d_, g_) do { const bf16_t* gp_ = gp0 + (size_t)(((g_) >> 2) * HALF + ((g_) & 3) * 16) * DIN; _Pragma("unroll") for (int bj = 0; bj < 2; ++bj) { n_[bj] = *(gq*)(gp_ + bj * HALF); d_[bj] = *(gq*)(gp_ + DM + bj * HALF); } } while (0)
        GLD(cn, cd, 0);
#pragma unroll
        for (int g = 0; g < 8; ++g) { const int ai = g >> 2, m = g & 3;
            if (g < 7) GLD(nn, nd, g + 1);
#pragma unroll
            for (int bj = 0; bj < 2; ++bj) { f32x4 n0, n1, d0, d1; unpack8(cn[bj], n0, n1); unpack8(cd[bj], d0, d1);
#pragma unroll
                for (int e = 0; e < 4; ++e) { const float a0 = GS ? fmaxf(n0[e], 1e-15f) : n0[e], a1 = GS ? fmaxf(n1[e], 1e-15f) : n1[e];
                    acc[ai][bj][m][0][e] *= a0 * __builtin_amdgcn_rcpf(fmaxf(d0[e], 1e-15f)); acc[ai][bj][m][1][e] *= a1 * __builtin_amdgcn_rcpf(fmaxf(d1[e], 1e-15f)); } }
            asm volatile("" : "+v"(acc[ai][0][m][0]), "+v"(acc[ai][0][m][1]), "+v"(acc[ai][1][m][0]), "+v"(acc[ai][1][m][1]) :: "memory");
#pragma unroll
            for (int bj = 0; bj < 2; ++bj) { cn[bj] = nn[bj]; cd[bj] = nd[bj]; }
        }
#undef GLD
    }
    __device__ __forceinline__ void operator()(AccRef acc, const Unit& u, int wr, int wc, int fr_, int fq) const {
        int fr = fr_; asm volatile("" : "+v"(fr));
        const int row0 = u.pm * BM + wr * 64 + fr, col0 = u.pn * BM + wc * 32 + 8 * fq;
#pragma unroll
        for (int am = 0; am < 4; ++am) { const int ai = am >> 1, m0 = (am & 1) * 2;
            u32x4 gw[2][2];
#pragma unroll
            for (int mm = 0; mm < 2; ++mm)
#pragma unroll
                for (int bj = 0; bj < 2; ++bj) gw[mm][bj] = *(const __attribute__((address_space(1))) u32x4*)(P + (size_t)(row0 + ai * HALF + (m0 + mm) * 16) * DIN + C_G + 2 * DM + col0 + bj * HALF);
#pragma unroll
            for (int mm = 0; mm < 2; ++mm)
#pragma unroll
                for (int bj = 0; bj < 2; ++bj) { f32x4 g0, g1; unpack8(gw[mm][bj], g0, g1);
#pragma unroll
                    for (int e = 0; e < 4; ++e) { g0[e] = fmaxf(g0[e], 1e-15f); g1[e] = fmaxf(g1[e], 1e-15f); }
                    *(u32x4*)(mb + (size_t)(row0 + ai * HALF + (m0 + mm) * 16) * DM + col0 + bj * HALF) = pack8(g0 * acc[ai][bj][m0 + mm][0], g1 * acc[ai][bj][m0 + mm][1]); }
            asm volatile("" ::: "memory"); }
    }
};
struct EpiRes {
    static constexpr bool PERM = false, AFTER_DRAIN = false;
    const float* h; const float* gx; const float* gc; float* dst;
    __device__ __forceinline__ void operator()(AccRef acc, const Unit& u, int wr, int wc, int fr, int fq) const {
        const int row0 = u.pm * BM + wr * 64 + fr, col0 = u.pn * BM + wc * 32 + 4 * fq;
        const float* gp = (u.pm * BM < SEQ ? gx : gc) + col0;
        f32x4 gv[2][2];
#pragma unroll
        for (int bj = 0; bj < 2; ++bj)
#pragma unroll
            for (int n = 0; n < 2; ++n) gv[bj][n] = *(const f32x4*)(gp + bj * HALF + n * 16);
#pragma unroll
        for (int am = 0; am < 4; ++am) { const int ai = am >> 1, m0 = (am & 1) * 2;
            f32x4 old[2][2][2];
#pragma unroll
            for (int mm = 0; mm < 2; ++mm)
#pragma unroll
                for (int bj = 0; bj < 2; ++bj)
#pragma unroll
                    for (int n = 0; n < 2; ++n) old[mm][bj][n] = *(const f32x4*)(h + (size_t)(row0 + ai * HALF + (m0 + mm) * 16) * DM + col0 + bj * HALF + n * 16);
#pragma unroll
            for (int mm = 0; mm < 2; ++mm)
#pragma unroll
                for (int bj = 0; bj < 2; ++bj)
#pragma unroll
                    for (int n = 0; n < 2; ++n) *(f32x4*)(dst + (size_t)(row0 + ai * HALF + (m0 + mm) * 16) * DM + col0 + bj * HALF + n * 16) = old[mm][bj][n] + gv[bj][n] * acc[ai][bj][m0 + mm][n];
            asm volatile("" ::: "memory"); }
    }
};
__device__ __forceinline__ float dpp_ror1(float v)  { return __int_as_float(__builtin_amdgcn_update_dpp(__float_as_int(v), __float_as_int(v), 0x121, 0xf, 0xf, false)); }
__device__ __forceinline__ float dpp_ror15(float v) { return __int_as_float(__builtin_amdgcn_update_dpp(__float_as_int(v), __float_as_int(v), 0x12f, 0xf, 0xf, false)); }
struct EpiUp {
    static constexpr bool PERM = true, AFTER_DRAIN = false;
    bf16_t* act; float* E; const float* cw; const float* cb;
    __device__ __forceinline__ void operator()(AccRef acc, const Unit& u, int wr, int wc, int fr, int fq) const {
        const int ch0 = u.pn * 128 + wc * 32 + 8 * fq, ycol0 = u.pn * BM + wc * 32 + 8 * fq;
#pragma unroll
        for (int nn = 0; nn < 2; ++nn) {
            const int ch = ch0 + 4 * nn;
            const f32x4 wa0 = *(const f32x4*)(cw + ch), wa1 = *(const f32x4*)(cw + DUP + ch), wa2 = *(const f32x4*)(cw + 2 * DUP + ch), ba = *(const f32x4*)(cb + ch);
            const f32x4 wg0 = *(const f32x4*)(cw + DFF + ch), wg1 = *(const f32x4*)(cw + DUP + DFF + ch), wg2 = *(const f32x4*)(cw + 2 * DUP + DFF + ch), bg = *(const f32x4*)(cb + DFF + ch);
#pragma unroll
            for (int ai = 0; ai < 2; ++ai) {
                const int blk = 4 * u.pm + 2 * ai + wr;
#pragma unroll
                for (int m = 0; m < 4; ++m) {
                    const f32x4 ya = acc[ai][0][m][nn], yg = acc[ai][1][m][nn];
                    const f32x4 pa = acc[ai][0][m > 0 ? m - 1 : 0][nn], pg = acc[ai][1][m > 0 ? m - 1 : 0][nn];
                    const f32x4 na = acc[ai][0][m < 3 ? m + 1 : 3][nn], ng = acc[ai][1][m < 3 ? m + 1 : 3][nn];
                    f32x4 o, ha4, hg4;
#pragma unroll
                    for (int e = 0; e < 4; ++e) {
                        const float ua = dpp_ror1(fr == 15 ? pa[e] : ya[e]), ug = dpp_ror1(fr == 15 ? pg[e] : yg[e]);
                        const float da = dpp_ror15(fr == 0 ? na[e] : ya[e]), dg = dpp_ror15(fr == 0 ? ng[e] : yg[e]);
                        ha4[e] = ba[e] + wa0[e] * ua + wa1[e] * ya[e] + wa2[e] * da;
                        hg4[e] = bg[e] + wg0[e] * ug + wg1[e] * yg[e] + wg2[e] * dg;
                    }
                    {
                        f32x4 t = hg4 * -1.4426950408889634f;
#pragma unroll
                        for (int e = 0; e < 4; ++e) t[e] = __builtin_amdgcn_exp2f(t[e]);
                        t = t + 1.0f;
#pragma unroll
                        for (int e = 0; e < 4; ++e) t[e] = __builtin_amdgcn_rcpf(t[e]);
                        o = (hg4 * ha4) * t;
                    }
                    const int row = u.pm * BM + ai * HALF + wr * 64 + m * 16 + fr;
                    const bool edge = (m == 0 && fr == 0) || (m == 3 && fr == 15);
                    if (!edge) { u32x2 w; w.x = cvt_pk_bf16(o[0], o[1]); w.y = cvt_pk_bf16(o[2], o[3]); *(u32x2*)(act + (size_t)row * DFF + ch) = w; }
                    if ((m == 0 && fr < 2) || (m == 3 && fr >= 14)) {
                        const int slot = (m == 0) ? fr : fr - 12;
                        float* ep = E + ((size_t)blk * 4 + slot) * DUP + ycol0 + 4 * nn; *(f32x4*)ep = ya; *(f32x4*)(ep + HALF) = yg;
                    }
                }
            }
        }
    }
};
struct EpiY {
    static constexpr bool PERM = false, AFTER_DRAIN = false;
    float* Y;
    __device__ __forceinline__ void operator()(AccRef acc, const Unit& u, int wr, int wc, int fr, int fq) const {
        const int row0 = u.pm * BM + wr * 64 + fr, col0 = u.pn * BM + wc * 32 + 4 * fq;
#pragma unroll
        for (int ai = 0; ai < 2; ++ai)
#pragma unroll
            for (int m = 0; m < 4; ++m) { float* yp = Y + (size_t)(row0 + ai * HALF + m * 16) * DUP + col0;
#pragma unroll
                for (int bj = 0; bj < 2; ++bj)
#pragma unroll
                    for (int n = 0; n < 2; ++n) *(f32x4*)(yp + bj * HALF + n * 16) = acc[ai][bj][m][n]; }
    }
};
}

namespace att {
constexpr int D = 128, NW = 8, QBLK = 32, KVBLK = 64, LDP = DIN;
constexpr int SHM_V = KVBLK * D * 2, SHM_K = SHM_V;
constexpr int TILE_B = SHM_K + SHM_V, NRING = 4;
constexpr int OFF_WS = NRING * TILE_B, OFF_BIAS = OFF_WS + NW * 64 * 4, BIAS_PAD = 64, BIAS_N = 15 * 31, SHM_TOTAL = OFF_BIAS + (2 * BIAS_PAD + 480) * 4;
#define KSWZ(row, colB) ((row) * 256 + ((colB) ^ (((row) & 7) << 4)))
#define SBAR() __builtin_amdgcn_sched_barrier(0)
#define LAUNDER(p) asm volatile("" : "+v"(p))
__device__ __forceinline__ int crow(int r, int hi) { return (r & 3) + 8 * (r >> 2) + 4 * hi; }

struct Unit {
    const bf16_t* Q;
    const bf16_t* K;
    const bf16_t* V;
    int nt, key0;
    int rsA, r0;
    bf16_t* O; int ldo;
    float* S;
    const float* gsub; float lam, osc;
    float shift;
    int tmask;
    int var;
};

__device__ __forceinline__ void halfSM(f32x16& p, float& l_reg, bf16x8& paX, bf16x8& paY) {
#pragma unroll
    for (int r = 0; r < 16; ++r) p[r] = __builtin_amdgcn_exp2f(p[r]);
    float ps = 0;
#pragma unroll
    for (int r = 0; r < 16; ++r) ps += p[r];
    l_reg += ps;
#define PK4(P, BASE, OUT) do { unsigned a0, a1, b0, b1; \
    asm volatile("s_nop 0\n\tv_cvt_pk_bf16_f32 %0, %4, %5\n\tv_cvt_pk_bf16_f32 %1, %6, %7\n\tv_cvt_pk_bf16_f32 %2, %8, %9\n\tv_cvt_pk_bf16_f32 %3, %10, %11" \
        : "=&v"(a0), "=&v"(a1), "=&v"(b0), "=&v"(b1) : "v"(P[BASE + 0]), "v"(P[BASE + 1]), "v"(P[BASE + 2]), "v"(P[BASE + 3]), "v"(P[BASE + 4]), "v"(P[BASE + 5]), "v"(P[BASE + 6]), "v"(P[BASE + 7])); \
    auto r0 = __builtin_amdgcn_permlane32_swap(a0, b0, false, false); auto r1 = __builtin_amdgcn_permlane32_swap(a1, b1, false, false); \
    u32x4 w = {r0[0], r1[0], r0[1], r1[1]}; OUT = *reinterpret_cast<bf16x8*>(&w); } while (0)
    PK4(p, 0, paX); PK4(p, 8, paY);
#undef PK4
}
template <int NDQ, int DB, bool SHIFT>
__device__ __forceinline__ void qkt(f32x16& p0, f32x16& p1, const char* Ks, const bf16x8* qr, int r32, int hi, float shift) {
    p0 = f32x16{}; p1 = f32x16{};
#pragma unroll
    for (int d0 = 0; d0 < NDQ; ++d0) { const int cb = ((DB + d0) * 16 + hi * 8) * 2;
        const bf16x8 b0 = *reinterpret_cast<const bf16x8*>(Ks + KSWZ(r32, cb));
        const bf16x8 b1 = *reinterpret_cast<const bf16x8*>(Ks + KSWZ(32 + r32, cb));
        p0 = __builtin_amdgcn_mfma_f32_32x32x16_bf16(b0, qr[d0], p0, 0, 0, 0);
        p1 = __builtin_amdgcn_mfma_f32_32x32x16_bf16(b1, qr[d0], p1, 0, 0, 0); }
    if (SHIFT && shift != 0.f) {
        const short one = hi == 0 ? (short)0x3f80 : (short)0, ms = hi == 0 ? (short)f2bf(-shift) : (short)0;
        const bf16x8 af = {one, 0, 0, 0, 0, 0, 0, 0}, bf = {ms, 0, 0, 0, 0, 0, 0, 0};
        p0 = __builtin_amdgcn_mfma_f32_32x32x16_bf16(af, bf, p0, 0, 0, 0);
        p1 = __builtin_amdgcn_mfma_f32_32x32x16_bf16(af, bf, p1, 0, 0, 0); }
}
__device__ __forceinline__ int v_st(int k, int c) { const int kk = (k & ~0xC) | ((k & 4) << 1) | ((k & 8) >> 1); return ((kk >> 3) * 4 + (c >> 5)) * 512 + ((kk & 7) * 32 + (c & 31)) * 2; }
__device__ __forceinline__ int v_rd_base(int lane) { return ((lane & 3) << 3) | (((lane >> 2) & 3) << 6) | (((lane >> 4) & 1) << 5) | (((lane >> 5) & 1) << 8); }
constexpr int v_rd_off(int d0, int ks, int half) { return d0 * 512 + ks * 4096 + half * 2048; }
template <int OFF> __device__ __forceinline__ s16x4 tr_read(int vb) {
    s16x4 r; asm volatile("ds_read_b64_tr_b16 %0, %1 offset:%2" : "=&v"(r) : "v"(vb), "i"(OFF) : "memory"); return r;
}
template <int D0> __device__ __forceinline__ void pv_one(f32x16& od, int vb, bf16x8 pa0, bf16x8 pa1, bf16x8 pa2, bf16x8 pa3) {
    const s16x4 l0 = tr_read<v_rd_off(D0, 0, 0)>(vb), h0 = tr_read<v_rd_off(D0, 0, 1)>(vb), l1 = tr_read<v_rd_off(D0, 1, 0)>(vb), h1 = tr_read<v_rd_off(D0, 1, 1)>(vb);
    const s16x4 l2 = tr_read<v_rd_off(D0, 2, 0)>(vb), h2 = tr_read<v_rd_off(D0, 2, 1)>(vb), l3 = tr_read<v_rd_off(D0, 3, 0)>(vb), h3 = tr_read<v_rd_off(D0, 3, 1)>(vb);
    asm volatile("s_waitcnt lgkmcnt(0)" ::: "memory"); SBAR();
#define PK(L, H) (bf16x8){L[0], L[1], L[2], L[3], H[0], H[1], H[2], H[3]}
    od = __builtin_amdgcn_mfma_f32_32x32x16_bf16(pa0, PK(l0, h0), od, 0, 0, 0);
    od = __builtin_amdgcn_mfma_f32_32x32x16_bf16(pa1, PK(l1, h1), od, 0, 0, 0);
    od = __builtin_amdgcn_mfma_f32_32x32x16_bf16(pa2, PK(l2, h2), od, 0, 0, 0);
    od = __builtin_amdgcn_mfma_f32_32x32x16_bf16(pa3, PK(l3, h3), od, 0, 0, 0);
#undef PK
}
__device__ __forceinline__ void pv_d0(f32x16* o, int vb, bf16x8 pa0, bf16x8 pa1, bf16x8 pa2, bf16x8 pa3) {
    pv_one<0>(o[0], vb, pa0, pa1, pa2, pa3); pv_one<1>(o[1], vb, pa0, pa1, pa2, pa3); pv_one<2>(o[2], vb, pa0, pa1, pa2, pa3); pv_one<3>(o[3], vb, pa0, pa1, pa2, pa3);
}


template <int OFF> __device__ __forceinline__ bf16x8 k_read(int addr) { bf16x8 r; asm volatile("ds_read_b128 %0, %1 offset:%2" : "=&v"(r) : "v"(addr), "i"(OFF) : "memory"); return r; }
#define LWAIT(n) do { asm volatile("s_waitcnt lgkmcnt(" #n ")" ::: "memory"); SBAR(); } while (0)
template <int D0> __device__ __forceinline__ void v_read8(s16x4 (&v)[8], int vb) {
    v[0] = tr_read<v_rd_off(D0, 0, 0)>(vb); v[1] = tr_read<v_rd_off(D0, 0, 1)>(vb); v[2] = tr_read<v_rd_off(D0, 1, 0)>(vb); v[3] = tr_read<v_rd_off(D0, 1, 1)>(vb);
    v[4] = tr_read<v_rd_off(D0, 2, 0)>(vb); v[5] = tr_read<v_rd_off(D0, 2, 1)>(vb); v[6] = tr_read<v_rd_off(D0, 3, 0)>(vb); v[7] = tr_read<v_rd_off(D0, 3, 1)>(vb);
}
__device__ __forceinline__ void pv_mma(f32x16& od, const s16x4 (&v)[8], bf16x8 pa0, bf16x8 pa1, bf16x8 pa2, bf16x8 pa3) {
#define PK(L, H) (bf16x8){L[0], L[1], L[2], L[3], H[0], H[1], H[2], H[3]}
    od = __builtin_amdgcn_mfma_f32_32x32x16_bf16(pa0, PK(v[0], v[1]), od, 0, 0, 0);
    od = __builtin_amdgcn_mfma_f32_32x32x16_bf16(pa1, PK(v[2], v[3]), od, 0, 0, 0);
    od = __builtin_amdgcn_mfma_f32_32x32x16_bf16(pa2, PK(v[4], v[5]), od, 0, 0, 0);
    od = __builtin_amdgcn_mfma_f32_32x32x16_bf16(pa3, PK(v[6], v[7]), od, 0, 0, 0);
#undef PK
}
template <int NDQ, int DB, bool SHIFT>
__device__ __forceinline__ void x_phase(f32x16& p0, f32x16& p1, f32x16 (&o)[4], const bf16x8* qr, const int (&ka)[4], int kd, int vb, bool do_pv, s16x4 (&va)[8],
                                        bf16x8 pa0, bf16x8 pa1, bf16x8 pa2, bf16x8 pa3, float shift, int hi, int var) {
    bf16x8 kf[2 * NDQ]; s16x4 vbk[8];
    int kb[4];
#pragma unroll
    for (int b = 0; b < 4; ++b) kb[b] = ka[b] + (DB >= 4 ? kd : 0);
    asm volatile("s_waitcnt lgkmcnt(0)" ::: "memory");
    SBAR();
#pragma unroll
    for (int b = 0; b < 4; ++b) { kf[2 * b] = k_read<0>(kb[b]); kf[2 * b + 1] = k_read<8192>(kb[b]); }
    if (do_pv) {
        v_read8<1>(vbk, vb); LWAIT(8); pv_mma(o[0], va, pa0, pa1, pa2, pa3); SBAR();
        v_read8<2>(va, vb);  LWAIT(8); pv_mma(o[1], vbk, pa0, pa1, pa2, pa3); SBAR();
        v_read8<3>(vbk, vb); LWAIT(8); pv_mma(o[2], va, pa0, pa1, pa2, pa3); SBAR();
    }
    if constexpr (NDQ == 8) {
#pragma unroll
        for (int b = 0; b < 4; ++b) { kf[8 + 2 * b] = k_read<0>(ka[b] + kd); kf[8 + 2 * b + 1] = k_read<8192>(ka[b] + kd); }
        if (do_pv) { LWAIT(8); pv_mma(o[3], vbk, pa0, pa1, pa2, pa3); SBAR(); } else LWAIT(8);
    } else { if (do_pv) { LWAIT(0); pv_mma(o[3], vbk, pa0, pa1, pa2, pa3); SBAR(); } else LWAIT(0); }
    p0 = f32x16{}; p1 = f32x16{};
#pragma unroll
    for (int d0 = 0; d0 < 4; ++d0) { p0 = __builtin_amdgcn_mfma_f32_32x32x16_bf16(kf[2 * d0], qr[d0], p0, 0, 0, 0); p1 = __builtin_amdgcn_mfma_f32_32x32x16_bf16(kf[2 * d0 + 1], qr[d0], p1, 0, 0, 0); }
    SBAR();
    if constexpr (NDQ == 8) {
        LWAIT(0);
#pragma unroll
        for (int d0 = 4; d0 < 8; ++d0) { p0 = __builtin_amdgcn_mfma_f32_32x32x16_bf16(kf[2 * d0], qr[d0], p0, 0, 0, 0); p1 = __builtin_amdgcn_mfma_f32_32x32x16_bf16(kf[2 * d0 + 1], qr[d0], p1, 0, 0, 0); }
        SBAR();
    }
    if (SHIFT && shift != 0.f) {
        const short one = hi == 0 ? (short)0x3f80 : (short)0, ms = hi == 0 ? (short)f2bf(-shift) : (short)0;
        const bf16x8 af = {one, 0, 0, 0, 0, 0, 0, 0}, bfr = {ms, 0, 0, 0, 0, 0, 0, 0};
        p0 = __builtin_amdgcn_mfma_f32_32x32x16_bf16(af, bfr, p0, 0, 0, 0); p1 = __builtin_amdgcn_mfma_f32_32x32x16_bf16(af, bfr, p1, 0, 0, 0); SBAR();
    }
}

struct NaCtx { int rsA, rq, rsq, cq, csq; const float* bias; };
template <bool NA, int HALF_>
__device__ __forceinline__ void na_hook(f32x16& p, int t, const NaCtx& n, int hi) {
    if constexpr (NA) {
        if (t >= 4) {
            const int kr = n.rsA + t - 4;
            if (kr < n.rsq || kr >= n.rsq + 8) {
#pragma unroll
                for (int r = 0; r < 16; ++r) p[r] = -1e30f;
            } else {
                const float* brow = n.bias + (kr - n.rq + 7) * 31 + 15 - n.cq + 32 * HALF_;
#pragma unroll
                for (int rg = 0; rg < 16; rg += 8) {
                    float b[8];
#pragma unroll
                    for (int r = 0; r < 8; ++r) b[r] = brow[crow(rg + r, hi)];
                    asm volatile("s_waitcnt lgkmcnt(0)" ::: "memory");
#pragma unroll
                    for (int r = 0; r < 8; ++r) { const int kc = crow(rg + r, hi) + 32 * HALF_; p[rg + r] = (kc >= n.csq && kc < n.csq + 16) ? p[rg + r] + b[r] : -1e30f; }
                }
            }
        }
    }
}

template <int NDQ, int DB, bool NA, int EPI, bool SHIFT>
__device__ __forceinline__ void attn_body(const Unit& u, char* lds, int tid) {
    asm volatile("" : "+v"(tid));
    const int wid = __builtin_amdgcn_readfirstlane(tid >> 6), lane = tid & 63, r32 = lane & 31, hi = lane >> 5;
    const bool trail = wid >= 4;
    float* li_l = (float*)(lds + OFF_WS) + wid * 64;
    float l_reg = 0; f32x16 o[4] = {}; bf16x8 qr[NDQ]; const float shift = u.shift;
    typedef __attribute__((address_space(1))) const bf16x8 gbf16x8;
    const bf16_t* Qw = u.Q + (long)(wid * QBLK + r32) * LDP + hi * 8 + DB * 16;
#pragma unroll
    for (int d0 = 0; d0 < NDQ; ++d0) qr[d0] = *(gbf16x8*)(Qw + d0 * 16);
    const int vb0 = (int)(uintptr_t)lds + SHM_K + v_rd_base(lane);
    int ka0[4];
#pragma unroll
    for (int b = 0; b < 4; ++b) ka0[b] = (int)(uintptr_t)lds + r32 * 256 + 16 * ((2 * b) ^ (hi ^ (r32 & 7))) + 128 * ((r32 >> 3) & 1);
    const int kd = 128 - 256 * ((r32 >> 3) & 1);
    NaCtx na;
    if constexpr (NA) { na.rsA = u.rsA; na.rq = u.r0 + (wid >> 1); na.rsq = min(max(na.rq - 4, 0), 120); na.cq = 32 * (wid & 1) + r32; na.csq = min(max(na.cq - 8, 0), 48); na.bias = (const float*)(lds + OFF_BIAS) + BIAS_PAD; }
    unsigned koff[2], voff[2];
#pragma unroll
    for (int i = 0; i < 2; ++i) { const int G = wid * 128 + i * 64 + lane;
        { const int row = G >> 4, g = (G & 15) ^ (row & 15); koff[i] = (unsigned)(row * LDP + g * 8) * 2u; }
        { const int sub = G >> 5, r8 = (G >> 2) & 7, c4 = G & 3, kk = (sub >> 2) * 8 + r8, cg = (sub & 3) * 4 + c4, k = (kk & ~0xC) | ((kk & 4) << 1) | ((kk & 8) >> 1); voff[i] = (unsigned)(k * LDP + cg * 8) * 2u; } }
    const char* Kg = (const char*)u.K; const char* Vg = (const char*)u.V;
    LAS unsigned char* ldsL = (LAS unsigned char*)(unsigned)(uintptr_t)lds;
#define TROW(t) (NA ? ((t) < 4 ? SEQ + 64 * ((t) & u.tmask) : (u.rsA + (((t) - 4) & u.tmask)) * 64) : u.key0 + 64 * ((t) & u.tmask))
    const __amdgpu_buffer_rsrc_t rK_ = __builtin_amdgcn_make_buffer_rsrc((void*)launder_uniform(Kg), 0, 0x7fffffff, 0x00020000);
    const __amdgpu_buffer_rsrc_t rV_ = __builtin_amdgcn_make_buffer_rsrc((void*)launder_uniform(Vg), 0, 0x7fffffff, 0x00020000);
#define DMA_TILE(t, boff) do { const int rb_ = __builtin_amdgcn_readfirstlane((TROW(t)) * (LDP * 2)); _Pragma("unroll") for (int i_ = 0; i_ < 2; ++i_) { \
        __builtin_amdgcn_raw_ptr_buffer_load_lds(rK_, (LAS void*)(ldsL + (boff) + wid * 2048 + i_ * 1024), 16, koff[i_], rb_, 0, 0); \
        __builtin_amdgcn_raw_ptr_buffer_load_lds(rV_, (LAS void*)(ldsL + (boff) + SHM_K + wid * 2048 + i_ * 1024), 16, voff[i_], rb_, 0, 0); } } while (0)
#define VWAIT() asm volatile("s_waitcnt vmcnt(0)" ::: "memory")
#define PBAR() do { asm volatile("s_waitcnt lgkmcnt(0)" ::: "memory"); __builtin_amdgcn_s_barrier(); asm volatile("" ::: "memory"); } while (0)
    bf16x8 pa0, pa1, pa2, pa3; f32x16 p0, p1; s16x4 va[8]; const int NT = u.nt;
#if MK_ATT_1BAR
#define SLOT(t) (((t) & (NRING - 1)) * TILE_B)
#define ENDI(k) do { if ((k) + 2 < NT) asm volatile("s_waitcnt vmcnt(4)" ::: "memory"); else VWAIT(); PBAR(); } while (0)
    DMA_TILE(0, 0); DMA_TILE(1, TILE_B); VWAIT(); PBAR();
    if (trail && 2 < NT) DMA_TILE(2, 2 * TILE_B);
    int b_prev = 3 * TILE_B, b_cur = 0;
    for (int i = 0; i < NT; ++i) {
        { int ka[4];
#pragma unroll
          for (int b = 0; b < 4; ++b) ka[b] = ka0[b] + b_cur;
          x_phase<NDQ, DB, SHIFT>(p0, p1, o, qr, ka, kd, vb0 + b_prev, i >= 1, va, pa0, pa1, pa2, pa3, shift, hi, 0); }
        if (trail) ENDI(i);
        { const int td = trail ? i + 3 : i + 2; if (td < NT) DMA_TILE(td, SLOT(td)); }
        na_hook<NA, 0>(p0, i, na, hi); halfSM(p0, l_reg, pa0, pa1); SBAR();
        na_hook<NA, 1>(p1, i, na, hi); halfSM(p1, l_reg, pa2, pa3);
        asm volatile("" : "+v"(l_reg));
        SBAR(); v_read8<0>(va, vb0 + b_cur);
        if (!trail) ENDI(i); else { asm volatile("" ::: "memory"); SBAR(); }
        b_prev = b_cur; b_cur = (b_cur + TILE_B) & (NRING * TILE_B - 1);
    }
#undef SLOT
#undef ENDI
#else
    DMA_TILE(0, 0); DMA_TILE(1, TILE_B); VWAIT(); PBAR();
    if (trail) PBAR();
    int b_prev = 3 * TILE_B, b_cur = 0;
    for (int i = 0; i < NT; ++i) {
        { int ka[4];
#pragma unroll
          for (int b = 0; b < 4; ++b) ka[b] = ka0[b] + b_cur;
          x_phase<NDQ, DB, SHIFT>(p0, p1, o, qr, ka, kd, vb0 + b_prev, i >= 1, va, pa0, pa1, pa2, pa3, shift, hi, u.var); }
        VWAIT();
        PBAR();
        if (i + 2 < NT && !(u.var & 8)) DMA_TILE(i + 2, (b_cur + 2 * TILE_B) & (NRING * TILE_B - 1));
        if (!(u.var & 2)) { na_hook<NA, 0>(p0, i, na, hi); halfSM(p0, l_reg, pa0, pa1); SBAR();
        na_hook<NA, 1>(p1, i, na, hi); halfSM(p1, l_reg, pa2, pa3); }
        asm volatile("" : "+v"(l_reg));
        SBAR(); if (!(u.var & 16)) v_read8<0>(va, vb0 + b_cur);
        PBAR();
        b_prev = b_cur; b_cur = (b_cur + TILE_B) & (NRING * TILE_B - 1);
    }
#endif
    {
        s16x4 vbk[8];
        v_read8<1>(vbk, vb0 + b_prev); LWAIT(8); pv_mma(o[0], va, pa0, pa1, pa2, pa3); SBAR();
        v_read8<2>(va, vb0 + b_prev);  LWAIT(8); pv_mma(o[1], vbk, pa0, pa1, pa2, pa3); SBAR();
        v_read8<3>(vbk, vb0 + b_prev); LWAIT(8); pv_mma(o[2], va, pa0, pa1, pa2, pa3); SBAR();
        LWAIT(0); pv_mma(o[3], vbk, pa0, pa1, pa2, pa3); SBAR();
    }
#if !MK_ATT_1BAR
    if (!trail) PBAR();
#endif
    { auto rr = __builtin_amdgcn_permlane32_swap(__float_as_uint(l_reg), __float_as_uint(l_reg), false, false); l_reg = __uint_as_float(rr[0]) + __uint_as_float(rr[1]); }
    if (hi == 0) li_l[r32] = l_reg; asm volatile("s_waitcnt lgkmcnt(0)" ::: "memory");
    float rli[16];
#pragma unroll
    for (int r = 0; r < 16; ++r) rli[r] = __builtin_amdgcn_rcpf(li_l[crow(r, hi)]);
    if constexpr (EPI == 0) {
        bf16_t* Ow = u.O + (long)(wid * QBLK) * u.ldo + r32; LAUNDER(Ow);
#pragma unroll
        for (int r = 0; r < 16; ++r) { const int orow = crow(r, hi);
#pragma unroll
            for (int d0 = 0; d0 < 4; ++d0) Ow[(long)orow * u.ldo + d0 * 32] = f2bf(o[d0][r] * rli[r]); }
    } else if constexpr (EPI == 1) {
        float* Sw = u.S + (long)(wid * QBLK) * 512 + r32; LAUNDER(Sw);
#pragma unroll
        for (int r = 0; r < 16; ++r) { const int orow = crow(r, hi);
#pragma unroll
            for (int d0 = 0; d0 < 4; ++d0) Sw[(long)orow * 512 + d0 * 32] = o[d0][r] * rli[r]; }
    } else {
        const float* Sw = u.S + (long)(wid * QBLK) * 512 + r32; bf16_t* Ow = u.O + (long)(wid * QBLK) * u.ldo + r32; LAUNDER(Sw); LAUNDER(Ow);
        float gg[4];
#pragma unroll
        for (int d0 = 0; d0 < 4; ++d0) gg[d0] = u.gsub[d0 * 32 + r32] * u.osc;
#pragma unroll
        for (int r = 0; r < 16; ++r) { const int orow = crow(r, hi); float v[4]; float ss = 0.f;
#pragma unroll
            for (int d0 = 0; d0 < 4; ++d0) { v[d0] = Sw[(long)orow * 512 + d0 * 32] - u.lam * (o[d0][r] * rli[r]); ss += v[d0] * v[d0]; }
            ss = half_sum(ss);
            const float rstd = __builtin_amdgcn_rsqf(ss * (1.0f / 128.0f) + EPS);
#pragma unroll
            for (int d0 = 0; d0 < 4; ++d0) Ow[(long)orow * u.ldo + d0 * 32] = f2bf(v[d0] * rstd * gg[d0]); asm volatile("" ::: "memory"); }
    }
    asm volatile("s_waitcnt vmcnt(0) lgkmcnt(0)" ::: "memory");
    __builtin_amdgcn_s_barrier();
    asm volatile("" ::: "memory");
#undef TROW
#undef DMA_TILE
#undef VWAIT
#undef PBAR
}
}

__device__ __forceinline__ int q_pop(unsigned* ctr, char* lds, int tid_) {
    volatile int* slot = (volatile int*)(lds + att::SHM_TOTAL);
    __syncthreads();
    if (tid_ == 0) *slot = (int)__hip_atomic_fetch_add(ctr, 1u, __ATOMIC_RELAXED, __HIP_MEMORY_SCOPE_AGENT);
    __syncthreads();
    return *slot;
}
__device__ __forceinline__ void phase_attn(int wid_k, int l, char* lds, int rep) {
    PHASE_ENTER(cin)
    unsigned* qctr = (unsigned*)(c.ws + WS_CTL + 16384) + (l + 4 * rep) * 256;
    bf16_t* const oa_ = rep ? (bf16_t*)(c.ws + WS_ACT) : c.oa(); bf16_t* const ob_ = oa_ + 1024; bf16_t* const oc_ = oa_ + 1536; float* const ocs_ = rep ? (float*)(c.ws + WS_ACT + (size_t)MT * 2048 * 2) : c.ocs();
    const bool last = (l == DEPTH - 1);
    const float lam = c.lam()[l], osc = 1.0f - (0.8f - 0.6f * expf(-0.3f * (float)l));
    float shA, shB, shC;
    {
        const int lane = tid_ & 63;
        const float mA = 11.313708f * vmax_abs(c.in[I_GQA] + l * 128, 128, lane) * vmax_abs(c.in[I_GKA] + l * 128, 128, lane) * 1.4426950f;
        const float mB = (11.313708f * vmax_abs(c.in[I_GQB] + l * 128, 128, lane) * vmax_abs(c.in[I_GKB] + l * 128, 128, lane) + vmax_abs(c.in[I_RPB] + (size_t)l * 4 * att::BIAS_N, 4 * att::BIAS_N, lane)) * 1.4426950f;
        const float mC = 8.0f * vmax_abs(c.in[I_GQC] + l * 64, 64, lane) * vmax_abs(c.in[I_GKC] + l * 64, 64, lane) * 1.4426950f;
#define SGPR_F(x_) __uint_as_float(__builtin_amdgcn_readfirstlane(__float_as_uint(x_)))
        shA = SGPR_F(fmaxf(0.f, mA - 100.f)); shB = SGPR_F(fmaxf(0.f, mB - 100.f)); shC = SGPR_F(fmaxf(0.f, mC - 100.f));
#undef SGPR_F
    }
    for (;;) {
        const int id = q_pop(qctr + 0, lds, tid_);
        if (id >= 128 + (last ? 0 : 4)) break;
        att::Unit u{}; u.tmask = (rep && MK_ATT_VARIANT == 1) ? 0 : ~0; u.var = rep ? MK_ATT_VARIANT : 0; int head, qrow0;
        if (id < 128) { head = id >> 5; qrow0 = (id & 31) * 256; u.nt = MT / 64; u.key0 = 0; }
        else { head = id - 128; qrow0 = SEQ; u.nt = CTX / 64; u.key0 = SEQ; }
        u.Q = c.P() + (size_t)qrow0 * DIN + C_QC + head * 128; u.K = c.P() + C_KC + head * 128; u.V = c.P() + C_VC + head * 128;
        u.O = oc_ + (size_t)qrow0 * 2048 + head * 128; u.ldo = 2048; u.S = ocs_ + (size_t)qrow0 * 512 + head * 128;
        u.gsub = c.in[I_GSUB] + l * 128; u.lam = lam; u.osc = osc; u.shift = shC;
        if (__builtin_expect(shC != 0.f, 0)) { att::attn_body<4, 0, false, 1, true>(u, lds, tid_); att::attn_body<4, 4, false, 2, true>(u, lds, tid_); }
        else { att::attn_body<4, 0, false, 1, false>(u, lds, tid_); att::attn_body<4, 4, false, 2, false>(u, lds, tid_); }
    }
    for (;;) {
        const int id = q_pop(qctr + 64, lds, tid_);
        if (id >= 256 + (last ? 0 : 12)) break;
        att::Unit u{}; u.tmask = (rep && MK_ATT_VARIANT == 1) ? 0 : ~0; u.var = rep ? MK_ATT_VARIANT : 0;
        if (id < 256) { const int head = id >> 5, qb = id & 31;
            u.Q = c.P() + (size_t)(qb * 256) * DIN + C_QA + head * 128; u.K = c.P() + C_KA + (head >> 2) * 128; u.V = c.P() + C_VA + (head >> 2) * 128;
            u.nt = MT / 64; u.key0 = 0; u.O = oa_ + (size_t)(qb * 256) * 2048 + head * 128; u.ldo = 2048; }
        else if (id < 264) { const int head = id - 256;
            u.Q = c.P() + (size_t)SEQ * DIN + C_QA + head * 128; u.K = c.P() + C_KA + (head >> 2) * 128; u.V = c.P() + C_VA + (head >> 2) * 128;
            u.nt = CTX / 64; u.key0 = SEQ; u.O = oa_ + (size_t)SEQ * 2048 + head * 128; u.ldo = 2048; }
        else { const int head = id - 264;
            u.Q = c.P() + (size_t)SEQ * DIN + C_QB + head * 128; u.K = c.P() + C_KB + head * 128; u.V = c.P() + C_VB + head * 128;
            u.nt = CTX / 64; u.key0 = SEQ; u.O = ob_ + (size_t)SEQ * 2048 + head * 128; u.ldo = 2048; }
        u.shift = id < 264 ? shA : shB;
        if (__builtin_expect(u.shift != 0.f, 0)) att::attn_body<8, 0, false, 0, true>(u, lds, tid_); else att::attn_body<8, 0, false, 0, false>(u, lds, tid_);
    }
    for (;;) {
        const int id = q_pop(qctr + 128, lds, tid_);
        if (id >= 128) break;
        const int head = id >> 5, qb = id & 31, r0 = qb * 4;
        float* bt = (float*)(lds + att::OFF_BIAS);
        for (int i = tid_; i < 2 * att::BIAS_PAD + 480; i += 512) { const int k = i - att::BIAS_PAD; bt[i] = (k >= 0 && k < att::BIAS_N) ? c.in[I_RPB][((size_t)l * 4 + head) * att::BIAS_N + k] * 1.4426950408889634f : 0.f; }
        __syncthreads();
        att::Unit u{}; u.tmask = (rep && MK_ATT_VARIANT == 1) ? 0 : ~0; u.var = rep ? MK_ATT_VARIANT : 0;
        u.Q = c.P() + (size_t)(qb * 256) * DIN + C_QB + head * 128; u.K = c.P() + C_KB + head * 128; u.V = c.P() + C_VB + head * 128;
        u.nt = 16; u.r0 = r0; u.rsA = min(max(r0 - 4, 0), 116);
        u.O = ob_ + (size_t)(qb * 256) * 2048 + head * 128; u.ldo = 2048; u.shift = shB;
        att::attn_body<8, 0, true, 0, true>(u, lds, tid_);
    }
    if (!rep && l + 1 < DEPTH && CONV_NATT > 0) {
        for (;;) {
            const int ch = q_pop(qctr + 192, lds, tid_);
            if (ch >= CONV_NATT / CONV_CHUNK) break;
            __syncthreads();
            conv_run(c, lds, tid_of(wid_k), ch * CONV_CHUNK, ch * CONV_CHUNK + CONV_CHUNK, 1, 1, l + 1);
        }
    }
}

constexpr int PH_PER_LAYER = 10, PH_FINAL = 1 + DEPTH * PH_PER_LAYER, N_PHASES = PH_FINAL + 1;

__global__ void __launch_bounds__(512, 2) fwd(Args a) {
    extern __shared__ __attribute__((aligned(16))) unsigned char lds_raw[];
    char* lds = (char*)lds_raw;
    volatile LAS unsigned* xbw = (volatile LAS unsigned*)(LAS unsigned char*)(lds_raw) + (LDS_BYTES - 16) / 4;
    const int wid_k = __builtin_amdgcn_readfirstlane(threadIdx.x >> 6);
    if (tid_of(wid_k) == 0) { xbw[0] = 0u; xbw[1] = 0u; xbw[2] = 0u; xbw[3] = 0u; }
    __syncthreads();
    const int lo = a.ph_lo, hi = a.ph_hi;
    if (hi - lo > 1) { Ctx c = make_ctx(); (void)xcd_barrier_post((unsigned*)(c.ws + WS_CTL), xbw, tid_of(wid_k)); }
#define IN(k) (lo <= (k) && (k) < hi)
#define SEAM(k) do { if (IN((k) + 1)) { Ctx cb_ = make_ctx(); XcdBarrier b2_; b2_.bar = (unsigned*)(cb_.ws + WS_CTL); b2_.x = xb_xcc_id(); b2_.st = xbw; xcd_barrier(b2_, tid_of(wid_k)); if (MK_PROBE == 10) xcd_barrier(b2_, tid_of(wid_k)); } } while (0)

    if (IN(0)) { phase_prologue(wid_k, lds); if (MK_PROBE == 1) { __syncthreads(); phase_prologue(wid_k, lds); } SEAM(0); }
    for (int l = 0; l < DEPTH; ++l) {
        const int pb = 1 + l * PH_PER_LAYER; const bool lastl = (l == DEPTH - 1);
#define FRESH() Ctx c = make_ctx(); int tid_ = tid_of(wid_k); PG8_LAS unsigned char* ldsL = (PG8_LAS unsigned char*)lds_raw; (void)tid_; (void)ldsL; \
        const bf16_t* wl = c.wt() + (size_t)l * LAYER_ELEMS; const float* modx = c.mod() + ((size_t)l * 2 + 0) * NMOD; const float* modc = c.mod() + ((size_t)l * 2 + 1) * NMOD; (void)wl; (void)modx; (void)modc;
        if (IN(pb + 0)) { phase_norm(wid_k, l, 0); if (MK_PROBE == 4) phase_norm(wid_k, l, 0); SEAM(pb + 0); }
#define FASTG(Aptr, Bptr, MM, NN, KK, EPI) do { pg8::Gemm g_{Aptr, Bptr, MM, NN, KK}; pg8::StaticOrder S_; S_.init(MM, NN, (int)gridDim.x, (int)blockIdx.x); pg8::gemm_phase(ldsL, g_, S_, EPI, tid_); } while (0)
#if MK_FAST_GEMM
        if (IN(pb + 1)) { FRESH(); pg8::EpiWin e{c.P(), c.in[I_GQA] + l * 128, c.in[I_GKA] + l * 128, c.in[I_GQB] + l * 128, c.in[I_GKB] + l * 128, c.in[I_GQC] + l * 64, c.in[I_GKC] + l * 64, (LAS float*)(ldsL + pg8::STAGE_BYTES)};
#if MK_GATE_FP8
            {
                pg8::Gemm gq_{c.u(), wl + O_WIN, MT, C_G, DM}; pg8::StaticOrder Sq_; Sq_.init(MT, C_G, (int)gridDim.x, (int)blockIdx.x); pg8::gemm_phase(ldsL, gq_, Sq_, e, tid_);
                pg8::EpiGate eg{c.P()};
                pg8::Gemm gg_{(const bf16_t*)(c.ws + WS_U8), (const bf16_t*)(c.ws + WS_WG8 + (size_t)l * NGATE * DM), MT, NGATE, DM / 2};
                pg8::GateOrder Sg_; Sg_.init((int)blockIdx.x, (int)gridDim.x); pg8::gemm_phase<pg8::EpiGate, pg8::GateOrder, true>(ldsL, gg_, Sg_, eg, tid_);
            }
#else
            FASTG(c.u(), wl + O_WIN, MT, DIN, DM, e);
#endif
            if (IN(pb + 3)) SEAM(pb + 2); }
#else
        if (IN(pb + 1)) { FRESH(); SEpiWin e{c.R(), c.P()}; simple_gemm(wid_k, c.u(), wl + O_WIN, MT, DIN, DM, e); SEAM(pb + 1); }
#endif
#if !MK_FAST_GEMM
        if (IN(pb + 2)) { phase_qknorm(wid_k, l); SEAM(pb + 2); }
#endif
        if (IN(pb + 3)) { phase_attn(wid_k, l, lds, 0); if (MK_PROBE == 2) { __syncthreads(); phase_attn(wid_k, l, lds, 1); } SEAM(pb + 3); }
        if (IN(pb + 4)) {
            for (int rp_ = 0; rp_ < (MK_PROBE == 7 ? 2 : 1); ++rp_) { FRESH(); pg8::EpiBrChain e{c.mb(), c.P()};
                pg8::StaticOrder S_; S_.init(SEQ, DM, (int)gridDim.x, (int)blockIdx.x); pg8::Unit u_;
                for (int ui_ = 0; S_.next(ui_, u_); ++ui_) {
                    pg8::OneUnit O_{u_}; f32x4 acc_[2][2][4][2];
                    { pg8::Gemm g_{c.oa(), wl + O_BRA, SEQ, DM, 1024, DM, DM}; pg8::gemm_phase_core<pg8::EpiBrChain, pg8::OneUnit, false, true>(ldsL, g_, O_, e, tid_, acc_); }
                    e.scale<0>(acc_, u_, tid_);
                    { pg8::Gemm g_{c.ob(), wl + O_BRA + 1024, SEQ, DM, 512, DM, DM}; pg8::gemm_phase_core<pg8::EpiBrChain, pg8::OneUnit, true, true>(ldsL, g_, O_, e, tid_, acc_); }
                    e.scale<1>(acc_, u_, tid_);
                    { pg8::Gemm g_{c.oc(), wl + O_BRA + 1536, SEQ, DM, 512, DM, DM}; pg8::gemm_phase_core<pg8::EpiBrChain, pg8::OneUnit, true, false>(ldsL, g_, O_, e, tid_, acc_); }
                } }
            if (!lastl) { FRESH(); SEpiBr4 e{c.mb(), c.P()}; slab_gemm5<true>(wid_k, lds, c.oa(), DM, wl + O_BRA, DM, SEQ, CTX, DM, DM, e); }
            SEAM(pb + 4);
        }
#if MK_FAST_GEMM
        if (IN(pb + 5)) { FRESH(); pg8::EpiRes e{l == 0 ? c.in[I_X] : c.h(), modx + 2 * DM, modc + 2 * DM, c.h()}; FASTG(c.mb(), wl + O_WO, SEQ, DM, DM, e); if (MK_PROBE == 8) { pg8::EpiRes e2{c.mf(), modx + 2 * DM, modc + 2 * DM, c.mf()}; FASTG(c.mb(), wl + O_WO, SEQ, DM, DM, e2); }
            if (!lastl) { SEpiRes4 es{c.h(), modx + 2 * DM, modc + 2 * DM, l == 0 ? c.in[I_CTX] - (size_t)SEQ * DM : c.h()}; slab_gemm5<false>(wid_k, lds, c.mb(), DM, wl + O_WO, DM, SEQ, CTX, DM, DM, es); } SEAM(pb + 5); }
#else
        if (IN(pb + 5)) { FRESH(); SEpiRes e{c.h(), modx + 2 * DM, modc + 2 * DM, c.h()}; simple_gemm(wid_k, c.mb(), wl + O_WO, MT, DM, DM, e); SEAM(pb + 5); }
#endif
        if (IN(pb + 6)) { phase_norm(wid_k, l, 1); if (MK_PROBE == 4) phase_norm(wid_k, l, 1); SEAM(pb + 6); }
#if MK_FAST_GEMM
        if (IN(pb + 7)) { FRESH(); pg8::EpiUp e{c.act(), c.edge(), c.in[I_CONVW] + (size_t)l * 3 * DUP, c.in[I_CONVB] + (size_t)l * DUP}; FASTG(c.u(), wl + O_WUP, (lastl ? SEQ : MT), DUP, DM, e); if (MK_PROBE == 6) FASTG(c.u(), wl + O_WUP, (lastl ? SEQ : MT), DUP, DM, e);
            if (!lastl && MK_CONV_NUP > 0) {
                unsigned* fq_ = (unsigned*)(c.ws + WS_CTL + 16384) + l * 256 + 224;
                for (;;) { const int ch = q_pop(fq_, lds, tid_of(wid_k)); if (ch >= MK_CONV_NUP / CONV_CHUNK) break; __syncthreads();
                    conv_run(c, lds, tid_of(wid_k), CONV_NATT + ch * CONV_CHUNK, CONV_NATT + ch * CONV_CHUNK + CONV_CHUNK, 1, 1, l + 1); } }
            SEAM(pb + 7); }
#else
        if (IN(pb + 7)) { FRESH(); SEpiY e{c.Y()}; simple_gemm(wid_k, c.u(), wl + O_WUP, MT, DUP, DM, e); SEAM(pb + 7); }
#endif
#if MK_FAST_GEMM
        if (IN(pb + 8)) { phase_convfix(wid_k, l); if (MK_PROBE == 3) phase_convfix(wid_k, l); SEAM(pb + 8); }
#else
        if (IN(pb + 8)) { phase_conv(wid_k, l); SEAM(pb + 8); }
#endif
#if MK_FAST_GEMM
        if (IN(pb + 9)) { FRESH(); pg8::EpiRes e{c.h(), modx + 5 * DM, modc + 5 * DM, lastl ? c.out : c.h()}; FASTG(c.act(), wl + O_WDN, SEQ, DM, DFF, e); if (MK_PROBE == 9) { pg8::EpiRes e2{c.mf(), modx + 5 * DM, modc + 5 * DM, c.mf()}; FASTG(c.act(), wl + O_WDN, SEQ, DM, DFF, e2); }
            if (!lastl) { SEpiRes4 es{c.h(), modx + 5 * DM, modc + 5 * DM, c.h()}; slab_gemm5<false>(wid_k, lds, c.act(), DFF, wl + O_WDN, DFF, SEQ, CTX, DM, DFF, es); SEAM(pb + 9); } }
#else
        if (IN(pb + 9)) { FRESH(); SEpiRes e{c.h(), modx + 5 * DM, modc + 5 * DM, c.h()}; simple_gemm(wid_k, c.act(), wl + O_WDN, MT, DM, DFF, e); SEAM(pb + 9); }
#endif
#undef FASTG
#undef FRESH
    }
#if !MK_FAST_GEMM
    if (IN(PH_FINAL)) phase_copy_out(wid_k);
#endif
#undef IN
#undef SEAM
}

extern "C" void kernel_launch(void* const* d_in, const int* in_sizes, int n_in, void* d_out, int out_size, void* d_ws, size_t ws_size, hipStream_t stream) {
    static int grid = 0;
    if (grid == 0) {
        if (n_in != 29 || out_size != SEQ * DM || ws_size < WS_END) { fprintf(stderr, "kernel_launch: unexpected shapes: n_in %d out %d ws %zu (need %zu)\n", n_in, out_size, ws_size, (size_t)WS_END); grid = -1; return; }
        int dev = 0, cus = 0, per_cu = 0;
        if (hipGetDevice(&dev) != hipSuccess || hipDeviceGetAttribute(&cus, hipDeviceAttributeMultiprocessorCount, dev) != hipSuccess) { grid = -1; return; }
        if (hipFuncSetAttribute((const void*)fwd, hipFuncAttributeMaxDynamicSharedMemorySize, LDS_BYTES) != hipSuccess) { fprintf(stderr, "kernel_launch: hipFuncSetAttribute failed\n"); grid = -1; return; }
        if (hipOccupancyMaxActiveBlocksPerMultiprocessor(&per_cu, (const void*)fwd, 512, LDS_BYTES) != hipSuccess || per_cu < 1) fprintf(stderr, "kernel_launch: occupancy query reports %d\n", per_cu);
        (void)hipGetLastError();
        grid = cus;
    }
    if (grid < 0) return;
    (void)hipMemsetAsync((char*)d_ws + WS_CTL, 0, CTL_BYTES, stream);
    Args a{};
    for (int i = 0; i < 29; ++i) a.in[i] = (const float*)d_in[i];
    a.out = (float*)d_out; a.ws = (unsigned char*)d_ws;
#if MK_ONE_LAUNCH
    a.ph_lo = 0; a.ph_hi = N_PHASES;
    hipLaunchKernelGGL(fwd, dim3(grid), dim3(512), LDS_BYTES, stream, a);
#else
    for (int p = 0; p < N_PHASES; ++p) { a.ph_lo = p; a.ph_hi = p + 1; hipLaunchKernelGGL(fwd, dim3(grid), dim3(512), LDS_BYTES, stream, a); }
#endif
    const hipError_t le = hipPeekAtLastError();
    if (le != hipSuccess) fprintf(stderr, "kernel_launch: launch failed: %s\n", hipGetErrorName(le));
}
```
